# Optimizing an MI355X kernel written in HIP

```python
import jax, jax.numpy as jnp
from jax import lax
import numpy as np

D_MODEL = 1024
BATCH = 4
SEQ = 8192
DEPTH = 2

N_META = 16
BLOCK_Q = 128
HEAD_DIM = 128
FOX_HEADS = 4
SB_HEADS = 4
FOX_WIDTH = FOX_HEADS * HEAD_DIM
SB_WIDTH = SB_HEADS * HEAD_DIM
LRU_WIDTH = 512
LRU_BLOCKS = 8
LRU_BLOCK_DIM = LRU_WIDTH // LRU_BLOCKS
LRU_C = 8.0
CONV_WIDTH = 4
N_BRANCH = 3
D_FF = 2816
N_EXPERTS = 8
TOP_K = 2
D_FF_EXPERT = 3584
N_DENSE = (DEPTH + 1) // 2
N_MOE = DEPTH // 2
RMS_EPS = 1e-6
NEG = -1e30
SPLIT_SIZES = (3 * FOX_WIDTH, FOX_HEADS, 3 * SB_WIDTH, LRU_WIDTH, LRU_WIDTH, N_BRANCH * D_MODEL)
IN_COLS = 3 * FOX_WIDTH + FOX_HEADS + 3 * SB_WIDTH + 2 * LRU_WIDTH + N_BRANCH * D_MODEL

kernel_name = 'hybrid_fox_stickbreak_rglru_moe'


def rms_norm(x, g):
    xf = x.astype(jnp.float32)
    y = xf * lax.rsqrt(jnp.mean(xf * xf, axis=-1, keepdims=True) + RMS_EPS)
    return (y * g.astype(jnp.float32)).astype(x.dtype)


def _to_blocks(t, nblk):
    b, h, _ = t.shape[:3]
    t = t.reshape((b, h, nblk, BLOCK_Q) + t.shape[3:])
    return jnp.moveaxis(t, 2, 0)


def _from_blocks(o):
    nblk, b, h, bq, dh = o.shape
    return o.transpose(1, 0, 3, 2, 4).reshape(b, nblk * bq, h * dh)


def _front_pad(t, pad):
    return jnp.pad(t, ((0, 0), (pad, 0)) + ((0, 0),) * (t.ndim - 2))


def forgetting_attention(q, k, v, log_f):
    b, l, h, dh = q.shape
    pad = (-l) % BLOCK_Q
    lp = l + pad
    nblk = lp // BLOCK_Q
    c = jnp.cumsum(log_f.astype(jnp.float32), axis=1)
    q, k, v = [_front_pad(t, pad).transpose(0, 2, 1, 3) for t in (q, k, v)]
    c = _front_pad(c, pad).transpose(0, 2, 1)
    kpos = jnp.arange(lp)
    scale = dh ** -0.5

    def block(args):
        qi, ci, i = args
        qpos = i * BLOCK_Q + jnp.arange(BLOCK_Q)
        s = (jnp.einsum('bhqd,bhkd->bhqk', qi, k).astype(jnp.float32) * scale
             + ci[..., None] - c[:, :, None, :])
        mask = (kpos[None, :] <= qpos[:, None]) & (kpos[None, :] >= pad)
        p = jax.nn.softmax(jnp.where(mask, s, NEG), axis=-1)
        return jnp.einsum('bhqk,bhkd->bhqd', p.astype(v.dtype), v)

    o = lax.map(block, (_to_blocks(q, nblk), _to_blocks(c, nblk), jnp.arange(nblk)))
    return _from_blocks(o)[:, pad:]


def stick_breaking_attention(q, k, v):
    b, l, h, dh = q.shape
    pad = (-l) % BLOCK_Q
    lp = l + pad
    nblk = lp // BLOCK_Q
    q, k, v = [_front_pad(t, pad).transpose(0, 2, 1, 3) for t in (q, k, v)]
    kpos = jnp.arange(lp)
    scale = dh ** -0.5

    def block(args):
        qi, i = args
        qpos = i * BLOCK_Q + jnp.arange(BLOCK_Q)
        z = jnp.einsum('bhqd,bhkd->bhqk', qi, k).astype(jnp.float32) * scale
        mask = (kpos[None, :] < qpos[:, None]) & (kpos[None, :] >= pad)
        m = jnp.where(mask, jax.nn.log_sigmoid(-z), 0.0)
        later = lax.cumsum(m, axis=3, reverse=True) - m
        a = jnp.where(mask, jnp.exp(jax.nn.log_sigmoid(z) + later), 0.0)
        return jnp.einsum('bhqk,bhkd->bhqd', a.astype(v.dtype), v)

    o = lax.map(block, (_to_blocks(q, nblk), jnp.arange(nblk)))
    return _from_blocks(o)[:, pad:]


def recurrent_branch(x_in, x_gate, conv_w, conv_b, wa, ba, wx, bx, lam):
    b, l, w = x_in.shape
    u = lax.conv_general_dilated(x_in, conv_w[:, None, :].astype(x_in.dtype), window_strides=(1,),
                                 padding=[(CONV_WIDTH - 1, 0)],
                                 dimension_numbers=('NWC', 'WIO', 'NWC'),
                                 feature_group_count=w) + conv_b
    ub = u.reshape(b, l, LRU_BLOCKS, LRU_BLOCK_DIM)
    r = jax.nn.sigmoid(jnp.einsum('blni,nij->blnj', ub, wa).reshape(b, l, w) + ba)
    gi = jax.nn.sigmoid(jnp.einsum('blni,nij->blnj', ub, wx).reshape(b, l, w) + bx)
    log_a = -LRU_C * r.astype(jnp.float32) * jax.nn.softplus(-lam.astype(jnp.float32))
    a = jnp.exp(log_a)
    inp = jnp.sqrt(-jnp.expm1(2.0 * log_a)) * (gi * u).astype(jnp.float32)

    def combine(e1, e2):
        a1, b1 = e1
        a2, b2 = e2
        return a1 * a2, a2 * b1 + b2

    _, hseq = lax.associative_scan(combine, (a, inp), axis=1)
    return hseq.astype(x_in.dtype) * jax.nn.gelu(x_gate)


def mixer(xn, w_in, b_forget, b_gate, conv_w, conv_b, wa, ba, wx, bx, lam,
          w_fox_o, w_sb_o, w_lru_o, w_out):
    b, l, d = xn.shape
    proj = xn @ w_in
    idx = [int(v) for v in np.cumsum(SPLIT_SIZES)[:-1]]
    fox_qkv, fox_f, sb_qkv, lru_x, lru_g, gates = jnp.split(proj, idx, axis=-1)
    fox_qkv = fox_qkv.reshape(b, l, 3, FOX_HEADS, HEAD_DIM)
    sb_qkv = sb_qkv.reshape(b, l, 3, SB_HEADS, HEAD_DIM)
    log_f = jax.nn.log_sigmoid((fox_f + b_forget).astype(jnp.float32))
    y_fox = forgetting_attention(fox_qkv[:, :, 0], fox_qkv[:, :, 1], fox_qkv[:, :, 2], log_f) @ w_fox_o
    y_sb = stick_breaking_attention(sb_qkv[:, :, 0], sb_qkv[:, :, 1], sb_qkv[:, :, 2]) @ w_sb_o
    y_lru = recurrent_branch(lru_x, lru_g, conv_w, conv_b, wa, ba, wx, bx, lam) @ w_lru_o
    g = jax.nn.sigmoid(gates + b_gate).reshape(b, l, N_BRANCH, d)
    merged = g[:, :, 0] * y_fox + g[:, :, 1] * y_sb + g[:, :, 2] * y_lru
    return merged @ w_out


def swiglu(x, wg, wu, wd):
    return (jax.nn.silu(x @ wg) * (x @ wu)) @ wd


def moe_swiglu(x, router_w, wg, wu, wd):
    b, l, d = x.shape
    xt = x.reshape(-1, d)
    logits = (xt @ router_w).astype(jnp.float32)
    top_v, top_i = lax.top_k(logits, TOP_K)
    top_w = jax.nn.softmax(top_v, axis=-1)
    comb = jnp.sum(jax.nn.one_hot(top_i, N_EXPERTS, dtype=jnp.float32) * top_w[..., None], axis=1)
    comb = comb.astype(x.dtype)
    out = jnp.zeros_like(xt)
    for e in range(N_EXPERTS):
        out = out + comb[:, e:e + 1] * swiglu(xt, wg[e], wu[e], wd[e])
    return out.reshape(b, l, d)


def setup_inputs(seed: int = 0) -> dict:
    key = jax.random.key(seed)
    ks = iter(jax.random.split(key, 40))
    f32 = jnp.float32

    def nrm(shape, scale):
        return jax.random.normal(next(ks), shape, f32) * scale

    u = jax.random.uniform(next(ks), (DEPTH, LRU_WIDTH), f32, 0.9, 0.999)
    a_base = u ** (1.0 / LRU_C)
    lru_lambda = jnp.log(a_base) - jnp.log1p(-a_base)
    return {
        'x': nrm((BATCH, SEQ, D_MODEL), 1.0),
        'meta_tokens': nrm((N_META, D_MODEL), 1.0),
        'g_mix': 1.0 + nrm((DEPTH, D_MODEL), 0.02),
        'w_in': nrm((DEPTH, D_MODEL, IN_COLS), D_MODEL ** -0.5),
        'b_forget': 3.0 + nrm((DEPTH, FOX_HEADS), 0.5),
        'b_gate': nrm((DEPTH, N_BRANCH * D_MODEL), 0.02),
        'conv_w': nrm((DEPTH, CONV_WIDTH, LRU_WIDTH), CONV_WIDTH ** -0.5),
        'conv_b': nrm((DEPTH, LRU_WIDTH), 0.02),
        'lru_wa': nrm((DEPTH, LRU_BLOCKS, LRU_BLOCK_DIM, LRU_BLOCK_DIM), LRU_BLOCK_DIM ** -0.5),
        'lru_ba': nrm((DEPTH, LRU_WIDTH), 0.02),
        'lru_wx': nrm((DEPTH, LRU_BLOCKS, LRU_BLOCK_DIM, LRU_BLOCK_DIM), LRU_BLOCK_DIM ** -0.5),
        'lru_bx': nrm((DEPTH, LRU_WIDTH), 0.02),
        'lru_lambda': lru_lambda,
        'w_fox_o': nrm((DEPTH, FOX_WIDTH, D_MODEL), FOX_WIDTH ** -0.5),
        'w_sb_o': nrm((DEPTH, SB_WIDTH, D_MODEL), SB_WIDTH ** -0.5),
        'w_lru_o': nrm((DEPTH, LRU_WIDTH, D_MODEL), LRU_WIDTH ** -0.5),
        'w_out': nrm((DEPTH, D_MODEL, D_MODEL), D_MODEL ** -0.5),
        'g_ffn': 1.0 + nrm((DEPTH, D_MODEL), 0.02),
        'ffn_w_gate': nrm((N_DENSE, D_MODEL, D_FF), D_MODEL ** -0.5),
        'ffn_w_up': nrm((N_DENSE, D_MODEL, D_FF), D_MODEL ** -0.5),
        'ffn_w_down': nrm((N_DENSE, D_FF, D_MODEL), D_FF ** -0.5),
        'router_w': nrm((N_MOE, D_MODEL, N_EXPERTS), D_MODEL ** -0.5),
        'moe_w_gate': nrm((N_MOE, N_EXPERTS, D_MODEL, D_FF_EXPERT), D_MODEL ** -0.5),
        'moe_w_up': nrm((N_MOE, N_EXPERTS, D_MODEL, D_FF_EXPERT), D_MODEL ** -0.5),
        'moe_w_down': nrm((N_MOE, N_EXPERTS, D_FF_EXPERT, D_MODEL), D_FF_EXPERT ** -0.5),
        'g_final': 1.0 + nrm((D_MODEL,), 0.02),
    }


def reference(x, meta_tokens, g_mix, w_in, b_forget, b_gate, conv_w, conv_b, lru_wa, lru_ba,
              lru_wx, lru_bx, lru_lambda, w_fox_o, w_sb_o, w_lru_o, w_out, g_ffn,
              ffn_w_gate, ffn_w_up, ffn_w_down, router_w, moe_w_gate, moe_w_up, moe_w_down,
              g_final):
    b = x.shape[0]
    meta = jnp.broadcast_to(meta_tokens[None].astype(x.dtype), (b, N_META, x.shape[-1]))
    h = jnp.concatenate([meta, x], axis=1)
    for layer in range(DEPTH):
        h = h + mixer(rms_norm(h, g_mix[layer]), w_in[layer], b_forget[layer], b_gate[layer],
                      conv_w[layer], conv_b[layer], lru_wa[layer], lru_ba[layer],
                      lru_wx[layer], lru_bx[layer], lru_lambda[layer],
                      w_fox_o[layer], w_sb_o[layer], w_lru_o[layer], w_out[layer])
        hn = rms_norm(h, g_ffn[layer])
        j = layer // 2
        if layer % 2 == 0:
            h = h + swiglu(hn, ffn_w_gate[j], ffn_w_up[j], ffn_w_down[j])
        else:
            h = h + moe_swiglu(hn, router_w[j], moe_w_gate[j], moe_w_up[j], moe_w_down[j])
    return rms_norm(h, g_final)[:, N_META:]
```

```cpp
#include <hip/hip_runtime.h>
#include <cstdio>
#include <cstdint>

#ifndef N_LAUNCH_MODE
#define N_LAUNCH_MODE 0
#endif

typedef unsigned short bf16_t;
#define LAS __attribute__((address_space(3)))

constexpr int D = 1024, NB = 4, S = 8192, NM = 16, R = NB * S, RT = R + NM;
constexpr int INC = 7172;
constexpr int PC = 4096;
constexpr int C_FQ = 0, C_FK = 512, C_FV = 1024, C_SQ = 1536, C_SK = 2048, C_SV = 2560, C_LX = 3072, C_LG = 3584, C_MRG = 512;
constexpr int WI_GATES = 4100;
constexpr int DFF = 2816, DFE = 3584, NE = 8;
constexpr int LCH = 64, NLC = S / LCH;
constexpr int MOE_CH = 16384;
constexpr int MOE_NCH = 5;
constexpr int NTHR = 512;
constexpr float RMS_EPS = 1e-6f;

constexpr size_t MiB = 1ull << 20;
constexpr size_t WS_BAR = 0;
constexpr size_t WS_CNT = 16384;
constexpr size_t WS_ZERO_BYTES = 16384 + 4096;
constexpr size_t WS_HMETA = 32768;
constexpr size_t WS_LF = 1 * MiB;
constexpr size_t WS_C = 2 * MiB;
constexpr size_t WS_SUMP = 3 * MiB;
constexpr size_t WS_SUME = 4 * MiB + 65536;
constexpr size_t WS_LIST = 6 * MiB;
constexpr size_t WS_PAIR = 7 * MiB;
constexpr size_t WS_TOPW = 7 * MiB + 512 * 1024;
constexpr size_t WS_XN = 8 * MiB;
constexpr size_t WS_PROJ = 73 * MiB;
constexpr size_t WS_HIDC_OFF = 0;
constexpr size_t WS_Y_OFF = 112 * MiB;
constexpr size_t WS_END = 331 * MiB;

__device__ __forceinline__ float bf2f(bf16_t v) { return __uint_as_float(((unsigned)v) << 16); }
__device__ __forceinline__ float bflo(unsigned v) { return __uint_as_float(v << 16); }
__device__ __forceinline__ float bfhi(unsigned v) { return __uint_as_float(v & 0xFFFF0000u); }
__device__ __forceinline__ bf16_t f2bf(float f) { unsigned u = __float_as_uint(f); u += 0x7FFFu + ((u >> 16) & 1u); return (bf16_t)(u >> 16); }
__device__ __forceinline__ unsigned pack2(float a, float b) { return (unsigned)f2bf(a) | ((unsigned)f2bf(b) << 16); }
__device__ __forceinline__ float wave_sum(float v) {
#pragma unroll
    for (int o = 32; o; o >>= 1) v += __shfl_xor(v, o);
    return v;
}
__device__ __forceinline__ float wave_max(float v) {
#pragma unroll
    for (int o = 32; o; o >>= 1) v = fmaxf(v, __shfl_xor(v, o));
    return v;
}
__device__ __forceinline__ float sigmoidf_(float x) { return 1.f / (1.f + expf(-x)); }
__device__ __forceinline__ float softplusf_(float x) { return fmaxf(x, 0.f) + log1pf(expf(-fabsf(x))); }
__device__ __forceinline__ float logsigf_(float x) { return fminf(x, 0.f) - log1pf(expf(-fabsf(x))); }
__device__ __forceinline__ float gelu_tanh(float x) { return 0.5f * x * (1.f + tanhf(0.7978845608028654f * (x + 0.044715f * x * x * x))); }

#define XB_TMO      128
#define XB_XCNT(j)  (256  + 64 * (j))
#define XB_XSUB(j)  (1280 + 64 * (j))
#define XB_XGEN(j)  (2304 + 64 * (j))
#define XB_TOP      3328
#define XB_TOPGEN   3392
#define XCD_BAR_WORDS 3456
#define XB_SPIN_CAP (1u << 24)
__device__ __forceinline__ unsigned xb_ld(unsigned* p)              { return __hip_atomic_load(p, __ATOMIC_RELAXED, __HIP_MEMORY_SCOPE_AGENT); }
__device__ __forceinline__ unsigned xb_add(unsigned* p, unsigned v) { return __hip_atomic_fetch_add(p, v, __ATOMIC_RELAXED, __HIP_MEMORY_SCOPE_AGENT); }
__device__ __forceinline__ unsigned xb_xcc_id() { return (unsigned)__builtin_amdgcn_s_getreg((3 << 11) | 20) & 0xFu; }
#define XB_SPIN(cond, bar) do { unsigned _sp = 0; while (cond) { __builtin_amdgcn_s_sleep(1); \
    if ((++_sp & 255u) == 0u) { if (xb_ld(&(bar)[XB_TMO])) break; if (_sp > XB_SPIN_CAP) { atomicAdd(&(bar)[XB_TMO], 1u); break; } } } } while (0)
struct XcdBarrier { unsigned* bar; unsigned x; volatile LAS unsigned* st; };
__device__ __forceinline__ XcdBarrier xcd_barrier_post(unsigned* bar, volatile LAS unsigned* st) {
    XcdBarrier b; b.bar = bar; b.x = xb_xcc_id(); b.st = st;
    if (threadIdx.x == 0) (void)xb_add(&bar[XB_XCNT(b.x)], 1u);
    return b;
}
__device__ __forceinline__ void xcd_barrier_complete(unsigned* bar, unsigned x, unsigned& nloc, unsigned& nx) {
    const unsigned G = gridDim.x * gridDim.y * gridDim.z;
    unsigned sum, cnt, mine, sp = 0u;
    for (;;) {
        sum = 0u; cnt = 0u; mine = 0u;
#pragma unroll
        for (unsigned j = 0; j < 16; ++j) { const unsigned c = xb_ld(&bar[XB_XCNT(j)]); sum += c; cnt += (c > 0u) ? 1u : 0u; mine = (j == x) ? c : mine; }
        if (sum == G) break;
        __builtin_amdgcn_s_sleep(1);
        if ((++sp & 255u) == 0u) { if (xb_ld(&bar[XB_TMO])) break; if (sp > XB_SPIN_CAP) { atomicAdd(&bar[XB_TMO], 1u); break; } }
    }
    nloc = mine > 0u ? mine : 1u; nx = cnt > 0u ? cnt : 1u;
}
__device__ __forceinline__ void xcd_barrier(const XcdBarrier& b) {
    asm volatile("s_waitcnt vmcnt(0)" ::: "memory");
    __syncthreads();
    if (threadIdx.x == 0) {
        unsigned* bar = b.bar;
        __builtin_amdgcn_s_waitcnt(0);
        unsigned nloc = b.st[0], nx = b.st[1];
        if (nloc == 0u) { xcd_barrier_complete(bar, b.x, nloc, nx); b.st[0] = nloc; b.st[1] = nx; }
        const unsigned old = xb_add(&bar[XB_XSUB(b.x)], 1u);
        const unsigned gen = old / nloc;
        if (old + 1u == (gen + 1u) * nloc) {
            __builtin_amdgcn_fence(__ATOMIC_RELEASE, "agent");
            asm volatile("s_waitcnt vmcnt(0)" ::: "memory");
            const unsigned og = xb_add(&bar[XB_TOP], 1u);
            const unsigned tg = og / nx;
            if (og + 1u == (tg + 1u) * nx) xb_add(&bar[XB_TOPGEN], 1u);
            else XB_SPIN(xb_ld(&bar[XB_TOPGEN]) == tg, bar);
            __builtin_amdgcn_fence(__ATOMIC_ACQUIRE, "agent");
            xb_add(&bar[XB_XGEN(b.x)], 1u);
            asm volatile("s_waitcnt vmcnt(0)" ::: "memory");
        } else {
            XB_SPIN(xb_ld(&bar[XB_XGEN(b.x)]) == gen, bar);
            __builtin_amdgcn_fence(__ATOMIC_ACQUIRE, "agent");
            asm volatile("s_waitcnt vmcnt(0)" ::: "memory");
        }
    }
    __syncthreads();
}

struct Args { const float* in[26]; float* out; unsigned char* ws; int ph_lo, ph_hi; };

struct Ctx {
    const Args* a; float* smem; int tid, lane, wave;
    __device__ __forceinline__ const float* x() const { return a->in[0]; }
    __device__ __forceinline__ const float* meta() const { return a->in[1]; }
    __device__ __forceinline__ const float* g_mix() const { return a->in[2]; }
    __device__ __forceinline__ const float* w_in() const { return a->in[3]; }
    __device__ __forceinline__ const float* b_forget() const { return a->in[4]; }
    __device__ __forceinline__ const float* b_gate() const { return a->in[5]; }
    __device__ __forceinline__ const float* conv_w() const { return a->in[6]; }
    __device__ __forceinline__ const float* conv_b() const { return a->in[7]; }
    __device__ __forceinline__ const float* wa() const { return a->in[8]; }
    __device__ __forceinline__ const float* ba() const { return a->in[9]; }
    __device__ __forceinline__ const float* wx() const { return a->in[10]; }
    __device__ __forceinline__ const float* bx() const { return a->in[11]; }
    __device__ __forceinline__ const float* lam() const { return a->in[12]; }
    __device__ __forceinline__ const float* w_fox_o() const { return a->in[13]; }
    __device__ __forceinline__ const float* w_sb_o() const { return a->in[14]; }
    __device__ __forceinline__ const float* w_lru_o() const { return a->in[15]; }
    __device__ __forceinline__ const float* w_out() const { return a->in[16]; }
    __device__ __forceinline__ const float* g_ffn() const { return a->in[17]; }
    __device__ __forceinline__ const float* ffn_wg() const { return a->in[18]; }
    __device__ __forceinline__ const float* ffn_wu() const { return a->in[19]; }
    __device__ __forceinline__ const float* ffn_wd() const { return a->in[20]; }
    __device__ __forceinline__ const float* router_w() const { return a->in[21]; }
    __device__ __forceinline__ const float* moe_wg() const { return a->in[22]; }
    __device__ __forceinline__ const float* moe_wu() const { return a->in[23]; }
    __device__ __forceinline__ const float* moe_wd() const { return a->in[24]; }
    __device__ __forceinline__ const float* g_final() const { return a->in[25]; }
    __device__ __forceinline__ float* out() const { return a->out; }
    __device__ __forceinline__ float* hmeta() const { return (float*)(a->ws + WS_HMETA); }
    __device__ __forceinline__ float* LF() const { return (float*)(a->ws + WS_LF); }
    __device__ __forceinline__ float* C() const { return (float*)(a->ws + WS_C); }
    __device__ __forceinline__ float* SUMP() const { return (float*)(a->ws + WS_SUMP); }
    __device__ __forceinline__ float* SUME() const { return (float*)(a->ws + WS_SUME); }
    __device__ __forceinline__ int* LIST() const { return (int*)(a->ws + WS_LIST); }
    __device__ __forceinline__ int* PAIR() const { return (int*)(a->ws + WS_PAIR); }
    __device__ __forceinline__ float* TOPW() const { return (float*)(a->ws + WS_TOPW); }
    __device__ __forceinline__ int* CNT() const { return (int*)(a->ws + WS_CNT); }
    __device__ __forceinline__ bf16_t* XN() const { return (bf16_t*)(a->ws + WS_XN); }
    __device__ __forceinline__ bf16_t* PROJ() const { return (bf16_t*)(a->ws + WS_PROJ); }
    __device__ __forceinline__ bf16_t* HIDC() const { return (bf16_t*)(a->ws + WS_PROJ + WS_HIDC_OFF); }
    __device__ __forceinline__ bf16_t* Y() const { return (bf16_t*)(a->ws + WS_PROJ + WS_Y_OFF); }
};

__device__ __forceinline__ const float* hsrc_row(const Ctx& c, int layer, int rr) {
    if (layer == 0) return rr < R ? c.x() + (size_t)rr * D : c.meta() + (size_t)(rr - R) * D;
    return rr < R ? c.out() + (size_t)rr * D : c.hmeta() + (size_t)(rr - R) * D;
}
__device__ __forceinline__ float* hdst_row(const Ctx& c, int rr) {
    return rr < R ? c.out() + (size_t)rr * D : c.hmeta() + (size_t)(rr - R) * D;
}

template <class AR>
__device__ __forceinline__ void ngemm(float (&acc)[4][8], const AR& arow, int r0, const float* __restrict__ W, int ldw, int c0, int K, float* smem, int tid) {
    float* As = smem; float* Ws = smem + 16 * 132;
    const int ty = tid >> 4, tx = tid & 15;
    const int lr = tid >> 2, lk = (tid & 3) * 4;
    const int wk = tid >> 5, wc = (tid & 31) * 4;
    const bf16_t* ap = arow(r0 + lr);
    for (int k0 = 0; k0 < K; k0 += 16) {
        uint2 av = make_uint2(0u, 0u);
        if (ap) av = *(const uint2*)(ap + k0 + lk);
        const float4 wv = *(const float4*)(W + (size_t)(k0 + wk) * ldw + c0 + wc);
        __syncthreads();
        As[(lk + 0) * 132 + lr] = bflo(av.x); As[(lk + 1) * 132 + lr] = bfhi(av.x);
        As[(lk + 2) * 132 + lr] = bflo(av.y); As[(lk + 3) * 132 + lr] = bfhi(av.y);
        *(float4*)(Ws + wk * 128 + wc) = wv;
        __syncthreads();
#pragma unroll 2
        for (int kk = 0; kk < 16; ++kk) {
            const float4 a = *(const float4*)(As + kk * 132 + ty * 4);
            const float4 w0 = *(const float4*)(Ws + kk * 128 + tx * 4);
            const float4 w1 = *(const float4*)(Ws + kk * 128 + 64 + tx * 4);
            const float av4[4] = {a.x, a.y, a.z, a.w};
            const float wv8[8] = {w0.x, w0.y, w0.z, w0.w, w1.x, w1.y, w1.z, w1.w};
#pragma unroll
            for (int i = 0; i < 4; ++i)
#pragma unroll
                for (int j = 0; j < 8; ++j) acc[i][j] += av4[i] * wv8[j];
        }
    }
}
#define ZERO_ACC(a) _Pragma("unroll") for (int _i = 0; _i < 4; ++_i) _Pragma("unroll") for (int _j = 0; _j < 8; ++_j) a[_i][_j] = 0.f
#define TILE_ROW(r0, ty, i) ((r0) + (ty) * 4 + (i))
#define TILE_COL(c0, tx, j) ((c0) + ((j) < 4 ? (tx) * 4 + (j) : 64 + (tx) * 4 + (j) - 4))

struct RowsStrided {
    const bf16_t* base; int ld; int nrows;
    __device__ __forceinline__ const bf16_t* operator()(int r) const { return r < nrows ? base + (size_t)r * ld : nullptr; }
};

__device__ __forceinline__ void phase_norm(const Ctx& c, int layer, int mode) {
    const int lane = c.lane;
    const float* gain = (mode == 0 ? c.g_mix() : c.g_ffn()) + layer * D;
    const int nrows = (mode == 1 && layer == 1) ? R : RT;
    for (int rr = blockIdx.x * 8 + c.wave; rr < nrows; rr += gridDim.x * 8) {
        const float* src = (mode == 0) ? hsrc_row(c, layer, rr) : hdst_row(c, rr);
        float v[16];
#pragma unroll
        for (int i = 0; i < 4; ++i) { const float4 t = *(const float4*)(src + i * 256 + lane * 4); v[4 * i] = t.x; v[4 * i + 1] = t.y; v[4 * i + 2] = t.z; v[4 * i + 3] = t.w; }
        float ss = 0.f;
#pragma unroll
        for (int k = 0; k < 16; ++k) ss += v[k] * v[k];
        ss = wave_sum(ss);
        const float rstd = rsqrtf(ss * (1.f / D) + RMS_EPS);
#pragma unroll
        for (int i = 0; i < 4; ++i) {
            const float4 g = *(const float4*)(gain + i * 256 + lane * 4);
            v[4 * i] *= rstd * g.x; v[4 * i + 1] *= rstd * g.y; v[4 * i + 2] *= rstd * g.z; v[4 * i + 3] *= rstd * g.w;
            uint2 o; o.x = pack2(v[4 * i], v[4 * i + 1]); o.y = pack2(v[4 * i + 2], v[4 * i + 3]);
            *(uint2*)(c.XN() + (size_t)rr * D + i * 256 + lane * 4) = o;
        }
        if (mode == 0) {
            const float* wf = c.w_in() + (size_t)layer * D * INC + 1536;
            float d0 = 0.f, d1 = 0.f, d2 = 0.f, d3 = 0.f;
#pragma unroll
            for (int i = 0; i < 4; ++i)
#pragma unroll
                for (int j = 0; j < 4; ++j) {
                    const int col = i * 256 + lane * 4 + j;
                    const float4 w = *(const float4*)(wf + (size_t)col * INC);
                    const float y = v[4 * i + j];
                    d0 += y * w.x; d1 += y * w.y; d2 += y * w.z; d3 += y * w.w;
                }
            d0 = wave_sum(d0); d1 = wave_sum(d1); d2 = wave_sum(d2); d3 = wave_sum(d3);
            if (lane < 4) {
                const float dsel = lane == 0 ? d0 : lane == 1 ? d1 : lane == 2 ? d2 : d3;
                c.LF()[(size_t)rr * 4 + lane] = logsigf_(dsel + c.b_forget()[layer * 4 + lane]);
            }
        } else if (layer == 1) {
            float lg[8];
#pragma unroll
            for (int e = 0; e < 8; ++e) lg[e] = 0.f;
#pragma unroll
            for (int i = 0; i < 4; ++i)
#pragma unroll
                for (int j = 0; j < 4; ++j) {
                    const int col = i * 256 + lane * 4 + j;
                    const float4 w0 = *(const float4*)(c.router_w() + (size_t)col * 8);
                    const float4 w1 = *(const float4*)(c.router_w() + (size_t)col * 8 + 4);
                    const float y = v[4 * i + j];
                    lg[0] += y * w0.x; lg[1] += y * w0.y; lg[2] += y * w0.z; lg[3] += y * w0.w;
                    lg[4] += y * w1.x; lg[5] += y * w1.y; lg[6] += y * w1.z; lg[7] += y * w1.w;
                }
#pragma unroll
            for (int e = 0; e < 8; ++e) lg[e] = wave_sum(lg[e]);
            int i1 = 0; float v1 = lg[0];
#pragma unroll
            for (int e = 1; e < 8; ++e) if (lg[e] > v1) { v1 = lg[e]; i1 = e; }
            int i2 = -1; float v2 = -3.0e38f;
#pragma unroll
            for (int e = 0; e < 8; ++e) if (e != i1 && lg[e] > v2) { v2 = lg[e]; i2 = e; }
            const float w1 = 1.f / (1.f + expf(v2 - v1)), w2 = 1.f - w1;
            if (lane == 0) {
                const int p1 = atomicAdd(&c.CNT()[i1], 1); c.LIST()[(size_t)i1 * R + p1] = rr;
                const int p2 = atomicAdd(&c.CNT()[i2], 1); c.LIST()[(size_t)i2 * R + p2] = rr;
                c.PAIR()[(size_t)rr * 2] = (i1 << 20) | p1; c.PAIR()[(size_t)rr * 2 + 1] = (i2 << 20) | p2;
                c.TOPW()[(size_t)rr * 2] = w1; c.TOPW()[(size_t)rr * 2 + 1] = w2;
            }
        }
    }
}

__device__ __forceinline__ void side_cumsum(const Ctx& c) {
    if (blockIdx.x >= NB || c.wave >= 4) return;
    const int b = blockIdx.x, h = c.wave, lane = c.lane;
    float carry;
    {
        float v = lane < NM ? c.LF()[(size_t)(R + lane) * 4 + h] : 0.f;
        float sc = v;
#pragma unroll
        for (int o = 1; o < 64; o <<= 1) { const float t = __shfl_up(sc, o); if (lane >= o) sc += t; }
        if (b == 0 && lane < NM) c.C()[(size_t)(R + lane) * 4 + h] = sc;
        carry = __shfl(sc, 63);
    }
    for (int s0 = 0; s0 < S; s0 += 64) {
        const size_t rr = (size_t)b * S + s0 + lane;
        const float v = c.LF()[rr * 4 + h];
        float sc = v;
#pragma unroll
        for (int o = 1; o < 64; o <<= 1) { const float t = __shfl_up(sc, o); if (lane >= o) sc += t; }
        c.C()[rr * 4 + h] = carry + sc;
        carry += __shfl(sc, 63);
    }
}

__device__ __forceinline__ void phase_proj(const Ctx& c, int layer) {
    side_cumsum(c);
    const int ntr = (RT + 127) / 128, ntc = PC / 128;
    const float* W = c.w_in() + (size_t)layer * D * INC;
    const int ty = c.tid >> 4, tx = c.tid & 15;
    for (int t = blockIdx.x; t < ntr * ntc; t += gridDim.x) {
        const int tr = t / ntc, tc = t % ntc;
        const int r0 = tr * 128, c0 = tc * 128;
        const int wcol = c0 + (c0 >= 1536 ? 4 : 0);
        float acc[4][8]; ZERO_ACC(acc);
        ngemm(acc, RowsStrided{c.XN(), D, RT}, r0, W, INC, wcol, D, c.smem, c.tid);
#pragma unroll
        for (int i = 0; i < 4; ++i) {
            const int rr = TILE_ROW(r0, ty, i);
            if (rr < RT) {
                uint2 o0, o1;
                o0.x = pack2(acc[i][0], acc[i][1]); o0.y = pack2(acc[i][2], acc[i][3]);
                o1.x = pack2(acc[i][4], acc[i][5]); o1.y = pack2(acc[i][6], acc[i][7]);
                *(uint2*)(c.PROJ() + (size_t)rr * PC + c0 + tx * 4) = o0;
                *(uint2*)(c.PROJ() + (size_t)rr * PC + c0 + 64 + tx * 4) = o1;
            }
        }
    }
}

__device__ __forceinline__ int key_row(int b, int g) { return g < NM ? R + g : b * S + g - NM; }

__device__ __forceinline__ float qk_dot(const float* qs, const bf16_t* kp) {
    float dot = 0.f;
#pragma unroll 4
    for (int dd = 0; dd < 16; ++dd) {
        const uint4 kk = *(const uint4*)(kp + dd * 8);
        const float4 qa = *(const float4*)(qs + dd * 8), qb = *(const float4*)(qs + dd * 8 + 4);
        dot += qa.x * bflo(kk.x) + qa.y * bfhi(kk.x) + qa.z * bflo(kk.y) + qa.w * bfhi(kk.y)
             + qb.x * bflo(kk.z) + qb.y * bfhi(kk.z) + qb.z * bflo(kk.w) + qb.w * bfhi(kk.w);
    }
    return dot;
}

__device__ __forceinline__ void attn_query(const Ctx& c, int type, int rr, int h) {
    const int lane = c.lane;
    int b, pg;
    if (rr < R) { b = rr >> 13; pg = NM + (rr & (S - 1)); } else { b = 0; pg = rr - R; }
    const int cq = type == 0 ? C_FQ : C_SQ, ck = type == 0 ? C_FK : C_SK, cv = type == 0 ? C_FV : C_SV;
    bf16_t* qrow = c.PROJ() + (size_t)rr * PC + cq + h * 128;
    float* q = c.smem + c.wave * 128;
    const float scale = 0.08838834764831845f;
    q[lane] = bf2f(qrow[lane]) * scale; q[lane + 64] = bf2f(qrow[lane + 64]) * scale;
    float a0 = 0.f, a1 = 0.f;
    if (type == 0) {
        float m = -1e30f, l = 0.f;
        const float cqv = c.C()[(size_t)rr * 4 + h];
        const int nk = pg + 1;
        for (int g0 = 0; g0 < nk; g0 += 64) {
            const int g = g0 + lane; const bool valid = g < nk;
            const int krow = key_row(b, valid ? g : 0);
            const float dot = qk_dot(q, c.PROJ() + (size_t)krow * PC + ck + h * 128);
            const float sc = valid ? dot + cqv - c.C()[(size_t)krow * 4 + h] : -__builtin_inff();
            const float mn = fmaxf(m, wave_max(sc));
            const float p = valid ? expf(sc - mn) : 0.f;
            const float alpha = expf(m - mn);
            l = l * alpha + wave_sum(p); a0 *= alpha; a1 *= alpha; m = mn;
            const int cnt = min(64, nk - g0);
            for (int j = 0; j < cnt; ++j) {
                const float pj = __shfl(p, j);
                const int vrow = key_row(b, g0 + j);
                const unsigned vv = *(const unsigned*)(c.PROJ() + (size_t)vrow * PC + cv + h * 128 + lane * 2);
                a0 += pj * bflo(vv); a1 += pj * bfhi(vv);
            }
        }
        const float inv = 1.f / l; a0 *= inv; a1 *= inv;
    } else {
        float Rrun = 0.f;
        for (int gtop = pg - 1; gtop >= 0; gtop -= 64) {
            const int g = gtop - lane; const bool valid = g >= 0;
            const int krow = key_row(b, valid ? g : 0);
            const float z = qk_dot(q, c.PROJ() + (size_t)krow * PC + ck + h * 128);
            const float sp = softplusf_(z);
            const float mval = valid ? -sp : 0.f;
            float sc = mval;
#pragma unroll
            for (int o = 1; o < 64; o <<= 1) { const float t = __shfl_up(sc, o); if (lane >= o) sc += t; }
            const float excl = sc - mval;
            const float p = valid ? expf(z - sp + Rrun + excl) : 0.f;
            const int cnt = min(64, gtop + 1);
            for (int j = 0; j < cnt; ++j) {
                const float pj = __shfl(p, j);
                const int vrow = key_row(b, gtop - j);
                const unsigned vv = *(const unsigned*)(c.PROJ() + (size_t)vrow * PC + cv + h * 128 + lane * 2);
                a0 += pj * bflo(vv); a1 += pj * bfhi(vv);
            }
            Rrun += __shfl(sc, 63);
            if (Rrun < -110.f) break;
        }
    }
    *(unsigned*)(qrow + lane * 2) = pack2(a0, a1);
}

__device__ __forceinline__ void lru_item(const Ctx& c, int layer, int seq, int chunk, int n, int pass) {
    float* xs = c.smem;
    float* us = xs + 67 * 64;
    float* as_ = us + 64 * 64;
    float* is_ = as_ + 64 * 64;
    const int tid = c.tid;
    const int len = seq == 4 ? NM : LCH;
    const int gbase = seq == 4 ? 0 : NM + chunk * LCH;
    const int b = seq == 4 ? 0 : seq;
    __syncthreads();
    for (int e = tid; e < (len + 3) * 64; e += NTHR) {
        const int t = e >> 6, ch = e & 63; const int g = gbase - 3 + t;
        float v = 0.f;
        if (g >= 0) v = bf2f(c.PROJ()[(size_t)key_row(b, g) * PC + C_LX + n * 64 + ch]);
        xs[e] = v;
    }
    __syncthreads();
    const float* cw = c.conv_w() + (size_t)layer * 4 * 512 + n * 64;
    const float* cb = c.conv_b() + layer * 512 + n * 64;
    for (int e = tid; e < len * 64; e += NTHR) {
        const int t = e >> 6, ch = e & 63;
        float u = cb[ch];
#pragma unroll
        for (int j = 0; j < 4; ++j) u += cw[j * 512 + ch] * xs[(t + j) * 64 + ch];
        us[e] = u;
    }
    __syncthreads();
    {
        const int j = tid & 63, tg = tid >> 6;
        const float* wa = c.wa() + ((size_t)layer * 8 + n) * 4096;
        const float* wx = c.wx() + ((size_t)layer * 8 + n) * 4096;
        float ar[8], ax[8];
#pragma unroll
        for (int tt = 0; tt < 8; ++tt) { ar[tt] = 0.f; ax[tt] = 0.f; }
        for (int i = 0; i < 64; ++i) {
            const float wai = wa[i * 64 + j], wxi = wx[i * 64 + j];
#pragma unroll
            for (int tt = 0; tt < 8; ++tt) { const float u = us[(tg * 8 + tt) * 64 + i]; ar[tt] += u * wai; ax[tt] += u * wxi; }
        }
        const float bav = c.ba()[layer * 512 + n * 64 + j], bxv = c.bx()[layer * 512 + n * 64 + j];
        const float spl = softplusf_(-c.lam()[layer * 512 + n * 64 + j]);
#pragma unroll
        for (int tt = 0; tt < 8; ++tt) {
            const int t = tg * 8 + tt;
            if (t < len) {
                const float r = sigmoidf_(ar[tt] + bav), gi = sigmoidf_(ax[tt] + bxv);
                const float la = -8.f * r * spl;
                as_[t * 64 + j] = expf(la);
                is_[t * 64 + j] = sqrtf(-expm1f(2.f * la)) * gi * us[t * 64 + j];
            }
        }
    }
    __syncthreads();
    if (tid < 64) {
        const int ch = tid; const int cidx = n * 64 + ch;
        const size_t sidx = (size_t)(seq == 4 ? 4 * NLC : seq * NLC + chunk) * 512 + cidx;
        if (pass == 0) {
            float hst = 0.f, P = 1.f;
            for (int t = 0; t < len; ++t) { const float a = as_[t * 64 + ch]; hst = a * hst + is_[t * 64 + ch]; P *= a; }
            c.SUMP()[sidx] = P; c.SUME()[sidx] = hst;
        } else {
            float hst = 0.f;
            if (seq != 4) {
                hst = c.SUME()[(size_t)(4 * NLC) * 512 + cidx];
                for (int cc = 0; cc < chunk; ++cc) { const size_t si = (size_t)(seq * NLC + cc) * 512 + cidx; hst = c.SUMP()[si] * hst + c.SUME()[si]; }
            }
            for (int t = 0; t < len; ++t) {
                hst = as_[t * 64 + ch] * hst + is_[t * 64 + ch];
                bf16_t* gp = c.PROJ() + (size_t)key_row(b, gbase + t) * PC + C_LG + cidx;
                *gp = f2bf(hst * gelu_tanh(bf2f(*gp)));
            }
        }
    }
}

__device__ __forceinline__ void phase_lru(const Ctx& c, int layer, int pass) {
    const int nitems = NB * NLC * 8 + 8;
    for (int it = blockIdx.x; it < nitems; it += gridDim.x) {
        if (it < NB * NLC * 8) { const int n = it & 7, ch = (it >> 3) % NLC, b = (it >> 3) / NLC; lru_item(c, layer, b, ch, n, pass); }
        else lru_item(c, layer, 4, 0, it - NB * NLC * 8, pass);
    }
}

__device__ __forceinline__ void phase_attn(const Ctx& c, int layer) {
    phase_lru(c, layer, 0);
    const int nitems = RT * 8;
    for (int it = blockIdx.x * 8 + c.wave; it < nitems; it += gridDim.x * 8) {
        const int rr = it % RT, hh = it / RT;
        attn_query(c, hh >> 2, rr, hh & 3);
    }
}

__device__ __forceinline__ void phase_merge(const Ctx& c, int layer) {
    const int ntr = (RT + 127) / 128, ntc = D / 128;
    const int ty = c.tid >> 4, tx = c.tid & 15;
    const float* Wg = c.w_in() + (size_t)layer * D * INC + WI_GATES;
    for (int t = blockIdx.x; t < ntr * ntc; t += gridDim.x) {
        const int tr = t / ntc, tc = t % ntc;
        const int r0 = tr * 128, c0 = tc * 128;
        float macc[4][8]; ZERO_ACC(macc);
#pragma unroll 1
        for (int i3 = 0; i3 < 3; ++i3) {
            const float* Wo = (i3 == 0 ? c.w_fox_o() : i3 == 1 ? c.w_sb_o() : c.w_lru_o()) + (size_t)layer * 512 * D;
            const int acol = i3 == 0 ? C_FQ : i3 == 1 ? C_SQ : C_LG;
            float ya[4][8]; ZERO_ACC(ya);
            ngemm(ya, RowsStrided{c.PROJ() + acol, PC, RT}, r0, Wo, D, c0, 512, c.smem, c.tid);
            float ga[4][8]; ZERO_ACC(ga);
            ngemm(ga, RowsStrided{c.XN(), D, RT}, r0, Wg + i3 * D, INC, c0, D, c.smem, c.tid);
            const float* bg = c.b_gate() + layer * 3 * D + i3 * D;
#pragma unroll
            for (int i = 0; i < 4; ++i)
#pragma unroll
                for (int j = 0; j < 8; ++j) macc[i][j] += sigmoidf_(ga[i][j] + bg[TILE_COL(c0, tx, j)]) * ya[i][j];
        }
#pragma unroll
        for (int i = 0; i < 4; ++i) {
            const int rr = TILE_ROW(r0, ty, i);
            if (rr < RT) {
                uint2 o0, o1;
                o0.x = pack2(macc[i][0], macc[i][1]); o0.y = pack2(macc[i][2], macc[i][3]);
                o1.x = pack2(macc[i][4], macc[i][5]); o1.y = pack2(macc[i][6], macc[i][7]);
                *(uint2*)(c.PROJ() + (size_t)rr * PC + C_MRG + c0 + tx * 4) = o0;
                *(uint2*)(c.PROJ() + (size_t)rr * PC + C_MRG + c0 + 64 + tx * 4) = o1;
            }
        }
    }
}

__device__ __forceinline__ void phase_resid_gemm(const Ctx& c, int layer, int src_layer0, const bf16_t* A, int lda, const float* W, int K) {
    const int ntr = (RT + 127) / 128, ntc = D / 128;
    const int ty = c.tid >> 4, tx = c.tid & 15;
    for (int t = blockIdx.x; t < ntr * ntc; t += gridDim.x) {
        const int tr = t / ntc, tc = t % ntc;
        const int r0 = tr * 128, c0 = tc * 128;
        float acc[4][8]; ZERO_ACC(acc);
        ngemm(acc, RowsStrided{A, lda, RT}, r0, W, D, c0, K, c.smem, c.tid);
#pragma unroll
        for (int i = 0; i < 4; ++i) {
            const int rr = TILE_ROW(r0, ty, i);
            if (rr < RT) {
                const float* src = src_layer0 ? hsrc_row(c, 0, rr) : hdst_row(c, rr);
                float* dst = hdst_row(c, rr);
                const float4 s0 = *(const float4*)(src + c0 + tx * 4), s1 = *(const float4*)(src + c0 + 64 + tx * 4);
                float4 o0, o1;
                o0.x = s0.x + acc[i][0]; o0.y = s0.y + acc[i][1]; o0.z = s0.z + acc[i][2]; o0.w = s0.w + acc[i][3];
                o1.x = s1.x + acc[i][4]; o1.y = s1.y + acc[i][5]; o1.z = s1.z + acc[i][6]; o1.w = s1.w + acc[i][7];
                *(float4*)(dst + c0 + tx * 4) = o0; *(float4*)(dst + c0 + 64 + tx * 4) = o1;
            }
        }
    }
}

__device__ __forceinline__ void phase_ffn_up(const Ctx& c) {
    const int ntr = (RT + 127) / 128, ntc = DFF / 128;
    const int ty = c.tid >> 4, tx = c.tid & 15;
    bf16_t* HID = c.PROJ();
    for (int t = blockIdx.x; t < ntr * ntc; t += gridDim.x) {
        const int tr = t / ntc, tc = t % ntc;
        const int r0 = tr * 128, c0 = tc * 128;
        float ga[4][8]; ZERO_ACC(ga);
        ngemm(ga, RowsStrided{c.XN(), D, RT}, r0, c.ffn_wg(), DFF, c0, D, c.smem, c.tid);
        float ua[4][8]; ZERO_ACC(ua);
        ngemm(ua, RowsStrided{c.XN(), D, RT}, r0, c.ffn_wu(), DFF, c0, D, c.smem, c.tid);
#pragma unroll
        for (int i = 0; i < 4; ++i) {
            const int rr = TILE_ROW(r0, ty, i);
            if (rr < RT) {
                float hv[8];
#pragma unroll
                for (int j = 0; j < 8; ++j) { const float g = ga[i][j]; hv[j] = g * sigmoidf_(g) * ua[i][j]; }
                uint2 o0, o1;
                o0.x = pack2(hv[0], hv[1]); o0.y = pack2(hv[2], hv[3]); o1.x = pack2(hv[4], hv[5]); o1.y = pack2(hv[6], hv[7]);
                *(uint2*)(HID + (size_t)rr * DFF + c0 + tx * 4) = o0;
                *(uint2*)(HID + (size_t)rr * DFF + c0 + 64 + tx * 4) = o1;
            }
        }
    }
}

struct MoeMap { int ebase[9]; int cnt[8]; };
__device__ __forceinline__ void moe_map(const Ctx& c, MoeMap& m) {
    int acc = 0;
#pragma unroll
    for (int e = 0; e < 8; ++e) { m.cnt[e] = c.CNT()[e]; m.ebase[e] = acc; acc += (m.cnt[e] + 127) & ~127; }
    m.ebase[8] = acc;
}
struct RowsMoe {
    const bf16_t* XN; const int* list; int ebase, cnt;
    __device__ __forceinline__ const bf16_t* operator()(int slot) const { const int pos = slot - ebase; return pos < cnt ? XN + (size_t)list[pos] * D : nullptr; }
};
__device__ __forceinline__ void phase_moe_up(const Ctx& c, int chunk) {
    MoeMap m; moe_map(c, m);
    const int total = m.ebase[8];
    const int ntr = MOE_CH / 128, ntc = DFE / 128;
    const int ty = c.tid >> 4, tx = c.tid & 15;
    for (int t = blockIdx.x; t < ntr * ntc; t += gridDim.x) {
        const int tr = t / ntc, tc = t % ntc;
        const int slot0 = chunk * MOE_CH + tr * 128, c0 = tc * 128;
        if (slot0 >= total) continue;
        int e = 0;
#pragma unroll
        for (int k = 1; k < 8; ++k) if (slot0 >= m.ebase[k]) e = k;
        int eb = 0, ec = 0;
#pragma unroll
        for (int k = 0; k < 8; ++k) if (k == e) { eb = m.ebase[k]; ec = m.cnt[k]; }
        const RowsMoe rows{c.XN(), c.LIST() + (size_t)e * R, eb, ec};
        float ga[4][8]; ZERO_ACC(ga);
        ngemm(ga, rows, slot0, c.moe_wg() + (size_t)e * D * DFE, DFE, c0, D, c.smem, c.tid);
        float ua[4][8]; ZERO_ACC(ua);
        ngemm(ua, rows, slot0, c.moe_wu() + (size_t)e * D * DFE, DFE, c0, D, c.smem, c.tid);
#pragma unroll
        for (int i = 0; i < 4; ++i) {
            const int lr = tr * 128 + ty * 4 + i;
            float hv[8];
#pragma unroll
            for (int j = 0; j < 8; ++j) { const float g = ga[i][j]; hv[j] = g * sigmoidf_(g) * ua[i][j]; }
            uint2 o0, o1;
            o0.x = pack2(hv[0], hv[1]); o0.y = pack2(hv[2], hv[3]); o1.x = pack2(hv[4], hv[5]); o1.y = pack2(hv[6], hv[7]);
            *(uint2*)(c.HIDC() + (size_t)lr * DFE + c0 + tx * 4) = o0;
            *(uint2*)(c.HIDC() + (size_t)lr * DFE + c0 + 64 + tx * 4) = o1;
        }
    }
}
__device__ __forceinline__ void phase_moe_down(const Ctx& c, int chunk) {
    MoeMap m; moe_map(c, m);
    const int total = m.ebase[8];
    const int ntr = MOE_CH / 128, ntc = D / 128;
    const int ty = c.tid >> 4, tx = c.tid & 15;
    for (int t = blockIdx.x; t < ntr * ntc; t += gridDim.x) {
        const int tr = t / ntc, tc = t % ntc;
        const int slot0 = chunk * MOE_CH + tr * 128, c0 = tc * 128;
        if (slot0 >= total) continue;
        int e = 0;
#pragma unroll
        for (int k = 1; k < 8; ++k) if (slot0 >= m.ebase[k]) e = k;
        float acc[4][8]; ZERO_ACC(acc);
        ngemm(acc, RowsStrided{c.HIDC(), DFE, MOE_CH}, tr * 128, c.moe_wd() + (size_t)e * DFE * D, D, c0, DFE, c.smem, c.tid);
#pragma unroll
        for (int i = 0; i < 4; ++i) {
            const int slot = slot0 + ty * 4 + i;
            uint2 o0, o1;
            o0.x = pack2(acc[i][0], acc[i][1]); o0.y = pack2(acc[i][2], acc[i][3]);
            o1.x = pack2(acc[i][4], acc[i][5]); o1.y = pack2(acc[i][6], acc[i][7]);
            *(uint2*)(c.Y() + (size_t)slot * D + c0 + tx * 4) = o0;
            *(uint2*)(c.Y() + (size_t)slot * D + c0 + 64 + tx * 4) = o1;
        }
    }
}
__device__ __forceinline__ void phase_final(const Ctx& c) {
    MoeMap m; moe_map(c, m);
    const int lane = c.lane;
    for (int rr = blockIdx.x * 8 + c.wave; rr < R; rr += gridDim.x * 8) {
        const int p0 = c.PAIR()[(size_t)rr * 2], p1 = c.PAIR()[(size_t)rr * 2 + 1];
        const float w0 = c.TOPW()[(size_t)rr * 2], w1 = c.TOPW()[(size_t)rr * 2 + 1];
        int b0 = 0, b1 = 0;
#pragma unroll
        for (int k = 0; k < 8; ++k) { if (k == (p0 >> 20)) b0 = m.ebase[k]; if (k == (p1 >> 20)) b1 = m.ebase[k]; }
        const bf16_t* y0 = c.Y() + (size_t)(b0 + (p0 & 0xFFFFF)) * D;
        const bf16_t* y1 = c.Y() + (size_t)(b1 + (p1 & 0xFFFFF)) * D;
        float* hrow = c.out() + (size_t)rr * D;
        float v[16];
        float ss = 0.f;
#pragma unroll
        for (int i = 0; i < 4; ++i) {
            const float4 t = *(const float4*)(hrow + i * 256 + lane * 4);
            const uint2 a = *(const uint2*)(y0 + i * 256 + lane * 4), bq = *(const uint2*)(y1 + i * 256 + lane * 4);
            v[4 * i] = t.x + w0 * bflo(a.x) + w1 * bflo(bq.x); v[4 * i + 1] = t.y + w0 * bfhi(a.x) + w1 * bfhi(bq.x);
            v[4 * i + 2] = t.z + w0 * bflo(a.y) + w1 * bflo(bq.y); v[4 * i + 3] = t.w + w0 * bfhi(a.y) + w1 * bfhi(bq.y);
        }
#pragma unroll
        for (int k = 0; k < 16; ++k) ss += v[k] * v[k];
        ss = wave_sum(ss);
        const float rstd = rsqrtf(ss * (1.f / D) + RMS_EPS);
#pragma unroll
        for (int i = 0; i < 4; ++i) {
            const float4 g = *(const float4*)(c.g_final() + i * 256 + lane * 4);
            float4 o; o.x = v[4 * i] * rstd * g.x; o.y = v[4 * i + 1] * rstd * g.y; o.z = v[4 * i + 2] * rstd * g.z; o.w = v[4 * i + 3] * rstd * g.w;
            *(float4*)(hrow + i * 256 + lane * 4) = o;
        }
    }
}

constexpr int N_PHASES = 27;
constexpr int LDS_BYTES = 147456;
__global__ void __launch_bounds__(NTHR, 2) fwd(Args args) {
    extern __shared__ __attribute__((aligned(16))) unsigned char lds[];
    Ctx c; c.a = &args;
    c.smem = (float*)(lds + 64);
    c.tid = threadIdx.x; c.lane = c.tid & 63; c.wave = __builtin_amdgcn_readfirstlane(c.tid >> 6);

    if (c.tid < 4) ((unsigned*)lds)[c.tid] = 0u;
    __syncthreads();
    const int lo = args.ph_lo, hi = args.ph_hi;
    XcdBarrier bar; bar.bar = (unsigned*)(args.ws + WS_BAR); bar.x = 0; bar.st = (volatile LAS unsigned*)lds;
    if (hi - lo > 1) bar = xcd_barrier_post((unsigned*)(args.ws + WS_BAR), (volatile LAS unsigned*)lds);
#define IN(k) (lo <= (k) && (k) < hi)
#define SEAM(k) do { if (IN(k) && IN((k) + 1)) xcd_barrier(bar); } while (0)

    if (IN(0)) phase_norm(c, 0, 0);
    SEAM(0);
    if (IN(1)) phase_proj(c, 0);
    SEAM(1);
    if (IN(2)) phase_attn(c, 0);
    SEAM(2);
    if (IN(3)) phase_lru(c, 0, 1);
    SEAM(3);
    if (IN(4)) phase_merge(c, 0);
    SEAM(4);
    if (IN(5)) phase_resid_gemm(c, 0, 1, c.PROJ() + C_MRG, PC, c.w_out() + (size_t)0 * D * D, D);
    SEAM(5);
    if (IN(6)) phase_norm(c, 0, 1);
    SEAM(6);
    if (IN(7)) phase_ffn_up(c);
    SEAM(7);
    if (IN(8)) phase_resid_gemm(c, 0, 0, c.PROJ(), DFF, c.ffn_wd(), DFF);
    SEAM(8);
    if (IN(9)) phase_norm(c, 1, 0);
    SEAM(9);
    if (IN(10)) phase_proj(c, 1);
    SEAM(10);
    if (IN(11)) phase_attn(c, 1);
    SEAM(11);
    if (IN(12)) phase_lru(c, 1, 1);
    SEAM(12);
    if (IN(13)) phase_merge(c, 1);
    SEAM(13);
    if (IN(14)) phase_resid_gemm(c, 1, 0, c.PROJ() + C_MRG, PC, c.w_out() + (size_t)1 * D * D, D);
    SEAM(14);
    if (IN(15)) phase_norm(c, 1, 1);
    SEAM(15);
#pragma unroll 1
    for (int ch = 0; ch < MOE_NCH; ++ch) {
        if (IN(16 + 2 * ch)) phase_moe_up(c, ch);
        SEAM(16 + 2 * ch);
        if (IN(17 + 2 * ch)) phase_moe_down(c, ch);
        SEAM(17 + 2 * ch);
    }
    if (IN(26)) phase_final(c);
}

extern "C" void kernel_launch(void* const* d_in, const int* in_sizes, int n_in, void* d_out, int out_size, void* d_ws, size_t ws_size, hipStream_t stream) {
    static int grid = 0;
    if (grid == 0) {
        if (n_in != 26 || out_size != R * D || ws_size < WS_END) { fprintf(stderr, "kernel_launch: unexpected problem (n_in %d out %d ws %zu)\n", n_in, out_size, ws_size); grid = -1; return; }
        int dev = 0, cus = 0, per_cu = 0;
        if (hipGetDevice(&dev) != hipSuccess || hipDeviceGetAttribute(&cus, hipDeviceAttributeMultiprocessorCount, dev) != hipSuccess) { grid = -1; return; }
        if (hipFuncSetAttribute((const void*)fwd, hipFuncAttributeMaxDynamicSharedMemorySize, LDS_BYTES) != hipSuccess) { grid = -1; return; }
        if (hipOccupancyMaxActiveBlocksPerMultiprocessor(&per_cu, (const void*)fwd, NTHR, LDS_BYTES) != hipSuccess || per_cu < 1) { fprintf(stderr, "occupancy query: %d\n", per_cu); }
        (void)hipGetLastError();
        grid = cus;
    }
    if (grid < 0) return;
    (void)hipMemsetAsync(d_ws, 0, WS_ZERO_BYTES, stream);
    Args a{};
    for (int i = 0; i < 26; ++i) a.in[i] = (const float*)d_in[i];
    a.out = (float*)d_out; a.ws = (unsigned char*)d_ws;
#if N_LAUNCH_MODE == 1
    a.ph_lo = 0; a.ph_hi = N_PHASES;
    hipLaunchKernelGGL(fwd, dim3(grid), dim3(NTHR), LDS_BYTES, stream, a);
#else
    for (int p = 0; p < N_PHASES; ++p) {
        a.ph_lo = p; a.ph_hi = p + 1;
        hipLaunchKernelGGL(fwd, dim3(grid), dim3(NTHR), LDS_BYTES, stream, a);
    }
#endif
}
```

```cpp
#include <hip/hip_runtime.h>
#include <cstdio>
#include <cstdint>

#ifndef N_LAUNCH_MODE
#define N_LAUNCH_MODE 1
#endif

typedef unsigned short bf16_t;
#define LAS __attribute__((address_space(3)))

constexpr int D = 1024, NB = 4, S = 8192, NM = 16, R = NB * S, RT = R + NM;
constexpr int INC = 7172;
constexpr int PC = 4096;
constexpr int C_FQ = 0, C_FK = 512, C_FV = 1024, C_SQ = 1536, C_SK = 2048, C_SV = 2560, C_LX = 3072, C_LG = 3584, C_MRG = 512;
constexpr int WI_GATES = 4100;
constexpr int DFF = 2816, DFE = 3584, NE = 8;
constexpr int LCH = 64, NLC = S / LCH;
constexpr int MOE_CH = 16384;
constexpr int MOE_NCH = 5;
constexpr int NTHR = 512;
constexpr float RMS_EPS = 1e-6f;

constexpr size_t MiB = 1ull << 20;
constexpr size_t WS_BAR = 0;
constexpr size_t WS_CNT = 16384;
constexpr size_t WS_ZERO_BYTES = 16384 + 4096;
constexpr size_t WS_HMETA = 32768;
constexpr size_t WS_LF = 1 * MiB;
constexpr size_t WS_C = 2 * MiB;
constexpr size_t WS_SUMP = 3 * MiB;
constexpr size_t WS_SUME = 4 * MiB + 65536;
constexpr size_t WS_LIST = 6 * MiB;
constexpr size_t WS_PAIR = 7 * MiB;
constexpr size_t WS_TOPW = 7 * MiB + 512 * 1024;
constexpr size_t WS_XN = 8 * MiB;
constexpr size_t WS_PROJ = 73 * MiB;
constexpr size_t WS_HIDC_OFF = 0;
constexpr size_t WS_Y_OFF = 112 * MiB;
constexpr size_t WS_END = 331 * MiB;

__device__ __forceinline__ float bf2f(bf16_t v) { return __uint_as_float(((unsigned)v) << 16); }
__device__ __forceinline__ float bflo(unsigned v) { return __uint_as_float(v << 16); }
__device__ __forceinline__ float bfhi(unsigned v) { return __uint_as_float(v & 0xFFFF0000u); }
__device__ __forceinline__ bf16_t f2bf(float f) { unsigned u = __float_as_uint(f); u += 0x7FFFu + ((u >> 16) & 1u); return (bf16_t)(u >> 16); }
__device__ __forceinline__ unsigned pack2(float a, float b) { return (unsigned)f2bf(a) | ((unsigned)f2bf(b) << 16); }
__device__ __forceinline__ float wave_sum(float v) {
#pragma unroll
    for (int o = 32; o; o >>= 1) v += __shfl_xor(v, o);
    return v;
}
__device__ __forceinline__ float wave_max(float v) {
#pragma unroll
    for (int o = 32; o; o >>= 1) v = fmaxf(v, __shfl_xor(v, o));
    return v;
}
__device__ __forceinline__ float sigmoidf_(float x) { return 1.f / (1.f + expf(-x)); }
__device__ __forceinline__ float softplusf_(float x) { return fmaxf(x, 0.f) + log1pf(expf(-fabsf(x))); }
__device__ __forceinline__ float logsigf_(float x) { return fminf(x, 0.f) - log1pf(expf(-fabsf(x))); }
__device__ __forceinline__ float gelu_tanh(float x) { return 0.5f * x * (1.f + tanhf(0.7978845608028654f * (x + 0.044715f * x * x * x))); }

#define XB_TMO      128
#define XB_XCNT(j)  (256  + 64 * (j))
#define XB_XSUB(j)  (1280 + 64 * (j))
#define XB_XGEN(j)  (2304 + 64 * (j))
#define XB_TOP      3328
#define XB_TOPGEN   3392
#define XCD_BAR_WORDS 3456
#define XB_SPIN_CAP (1u << 24)
__device__ __forceinline__ unsigned xb_ld(unsigned* p)              { return __hip_atomic_load(p, __ATOMIC_RELAXED, __HIP_MEMORY_SCOPE_AGENT); }
__device__ __forceinline__ unsigned xb_add(unsigned* p, unsigned v) { return __hip_atomic_fetch_add(p, v, __ATOMIC_RELAXED, __HIP_MEMORY_SCOPE_AGENT); }
__device__ __forceinline__ unsigned xb_xcc_id() { return (unsigned)__builtin_amdgcn_s_getreg((3 << 11) | 20) & 0xFu; }
#define XB_SPIN(cond, bar) do { unsigned _sp = 0; while (cond) { __builtin_amdgcn_s_sleep(1); \
    if ((++_sp & 255u) == 0u) { if (xb_ld(&(bar)[XB_TMO])) break; if (_sp > XB_SPIN_CAP) { atomicAdd(&(bar)[XB_TMO], 1u); break; } } } } while (0)
struct XcdBarrier { unsigned* bar; unsigned x; volatile LAS unsigned* st; };
__device__ __forceinline__ XcdBarrier xcd_barrier_post(unsigned* bar, volatile LAS unsigned* st) {
    XcdBarrier b; b.bar = bar; b.x = xb_xcc_id(); b.st = st;
    if (threadIdx.x == 0) (void)xb_add(&bar[XB_XCNT(b.x)], 1u);
    return b;
}
__device__ __forceinline__ void xcd_barrier_complete(unsigned* bar, unsigned x, unsigned& nloc, unsigned& nx) {
    const unsigned G = gridDim.x * gridDim.y * gridDim.z;
    unsigned sum, cnt, mine, sp = 0u;
    for (;;) {
        sum = 0u; cnt = 0u; mine = 0u;
#pragma unroll
        for (unsigned j = 0; j < 16; ++j) { const unsigned c = xb_ld(&bar[XB_XCNT(j)]); sum += c; cnt += (c > 0u) ? 1u : 0u; mine = (j == x) ? c : mine; }
        if (sum == G) break;
        __builtin_amdgcn_s_sleep(1);
        if ((++sp & 255u) == 0u) { if (xb_ld(&bar[XB_TMO])) break; if (sp > XB_SPIN_CAP) { atomicAdd(&bar[XB_TMO], 1u); break; } }
    }
    nloc = mine > 0u ? mine : 1u; nx = cnt > 0u ? cnt : 1u;
}
__device__ __forceinline__ void xcd_barrier(const XcdBarrier& b) {
    asm volatile("s_waitcnt vmcnt(0)" ::: "memory");
    __syncthreads();
    if (threadIdx.x == 0) {
        unsigned* bar = b.bar;
        __builtin_amdgcn_s_waitcnt(0);
        unsigned nloc = b.st[0], nx = b.st[1];
        if (nloc == 0u) { xcd_barrier_complete(bar, b.x, nloc, nx); b.st[0] = nloc; b.st[1] = nx; }
        const unsigned old = xb_add(&bar[XB_XSUB(b.x)], 1u);
        const unsigned gen = old / nloc;
        if (old + 1u == (gen + 1u) * nloc) {
            __builtin_amdgcn_fence(__ATOMIC_RELEASE, "agent");
            asm volatile("s_waitcnt vmcnt(0)" ::: "memory");
            const unsigned og = xb_add(&bar[XB_TOP], 1u);
            const unsigned tg = og / nx;
            if (og + 1u == (tg + 1u) * nx) xb_add(&bar[XB_TOPGEN], 1u);
            else XB_SPIN(xb_ld(&bar[XB_TOPGEN]) == tg, bar);
            __builtin_amdgcn_fence(__ATOMIC_ACQUIRE, "agent");
            xb_add(&bar[XB_XGEN(b.x)], 1u);
            asm volatile("s_waitcnt vmcnt(0)" ::: "memory");
        } else {
            XB_SPIN(xb_ld(&bar[XB_XGEN(b.x)]) == gen, bar);
            __builtin_amdgcn_fence(__ATOMIC_ACQUIRE, "agent");
            asm volatile("s_waitcnt vmcnt(0)" ::: "memory");
        }
    }
    __syncthreads();
}

struct Args { const float* in[26]; float* out; unsigned char* ws; int ph_lo, ph_hi; };

struct Ctx {
    const Args* a; float* smem; int tid, lane, wave;
    __device__ __forceinline__ const float* x() const { return a->in[0]; }
    __device__ __forceinline__ const float* meta() const { return a->in[1]; }
    __device__ __forceinline__ const float* g_mix() const { return a->in[2]; }
    __device__ __forceinline__ const float* w_in() const { return a->in[3]; }
    __device__ __forceinline__ const float* b_forget() const { return a->in[4]; }
    __device__ __forceinline__ const float* b_gate() const { return a->in[5]; }
    __device__ __forceinline__ const float* conv_w() const { return a->in[6]; }
    __device__ __forceinline__ const float* conv_b() const { return a->in[7]; }
    __device__ __forceinline__ const float* wa() const { return a->in[8]; }
    __device__ __forceinline__ const float* ba() const { return a->in[9]; }
    __device__ __forceinline__ const float* wx() const { return a->in[10]; }
    __device__ __forceinline__ const float* bx() const { return a->in[11]; }
    __device__ __forceinline__ const float* lam() const { return a->in[12]; }
    __device__ __forceinline__ const float* w_fox_o() const { return a->in[13]; }
    __device__ __forceinline__ const float* w_sb_o() const { return a->in[14]; }
    __device__ __forceinline__ const float* w_lru_o() const { return a->in[15]; }
    __device__ __forceinline__ const float* w_out() const { return a->in[16]; }
    __device__ __forceinline__ const float* g_ffn() const { return a->in[17]; }
    __device__ __forceinline__ const float* ffn_wg() const { return a->in[18]; }
    __device__ __forceinline__ const float* ffn_wu() const { return a->in[19]; }
    __device__ __forceinline__ const float* ffn_wd() const { return a->in[20]; }
    __device__ __forceinline__ const float* router_w() const { return a->in[21]; }
    __device__ __forceinline__ const float* moe_wg() const { return a->in[22]; }
    __device__ __forceinline__ const float* moe_wu() const { return a->in[23]; }
    __device__ __forceinline__ const float* moe_wd() const { return a->in[24]; }
    __device__ __forceinline__ const float* g_final() const { return a->in[25]; }
    __device__ __forceinline__ float* out() const { return a->out; }
    __device__ __forceinline__ float* hmeta() const { return (float*)(a->ws + WS_HMETA); }
    __device__ __forceinline__ float* LF() const { return (float*)(a->ws + WS_LF); }
    __device__ __forceinline__ float* C() const { return (float*)(a->ws + WS_C); }
    __device__ __forceinline__ float* SUMP() const { return (float*)(a->ws + WS_SUMP); }
    __device__ __forceinline__ float* SUME() const { return (float*)(a->ws + WS_SUME); }
    __device__ __forceinline__ int* LIST() const { return (int*)(a->ws + WS_LIST); }
    __device__ __forceinline__ int* PAIR() const { return (int*)(a->ws + WS_PAIR); }
    __device__ __forceinline__ float* TOPW() const { return (float*)(a->ws + WS_TOPW); }
    __device__ __forceinline__ int* CNT() const { return (int*)(a->ws + WS_CNT); }
    __device__ __forceinline__ bf16_t* XN() const { return (bf16_t*)(a->ws + WS_XN); }
    __device__ __forceinline__ bf16_t* PROJ() const { return (bf16_t*)(a->ws + WS_PROJ); }
    __device__ __forceinline__ bf16_t* HIDC() const { return (bf16_t*)(a->ws + WS_PROJ + WS_HIDC_OFF); }
    __device__ __forceinline__ bf16_t* Y() const { return (bf16_t*)(a->ws + WS_PROJ + WS_Y_OFF); }
};

__device__ __forceinline__ const float* hsrc_row(const Ctx& c, int layer, int rr) {
    if (layer == 0) return rr < R ? c.x() + (size_t)rr * D : c.meta() + (size_t)(rr - R) * D;
    return rr < R ? c.out() + (size_t)rr * D : c.hmeta() + (size_t)(rr - R) * D;
}
__device__ __forceinline__ float* hdst_row(const Ctx& c, int rr) {
    return rr < R ? c.out() + (size_t)rr * D : c.hmeta() + (size_t)(rr - R) * D;
}

template <class AR>
__device__ __forceinline__ void ngemm(float (&acc)[4][8], const AR& arow, int r0, const float* __restrict__ W, int ldw, int c0, int K, float* smem, int tid) {
    float* As = smem; float* Ws = smem + 16 * 132;
    const int ty = tid >> 4, tx = tid & 15;
    const int lr = tid >> 2, lk = (tid & 3) * 4;
    const int wk = tid >> 5, wc = (tid & 31) * 4;
    const bf16_t* ap = arow(r0 + lr);
    for (int k0 = 0; k0 < K; k0 += 16) {
        uint2 av = make_uint2(0u, 0u);
        if (ap) av = *(const uint2*)(ap + k0 + lk);
        const float4 wv = *(const float4*)(W + (size_t)(k0 + wk) * ldw + c0 + wc);
        __syncthreads();
        As[(lk + 0) * 132 + lr] = bflo(av.x); As[(lk + 1) * 132 + lr] = bfhi(av.x);
        As[(lk + 2) * 132 + lr] = bflo(av.y); As[(lk + 3) * 132 + lr] = bfhi(av.y);
        *(float4*)(Ws + wk * 128 + wc) = wv;
        __syncthreads();
#pragma unroll 2
        for (int kk = 0; kk < 16; ++kk) {
            const float4 a = *(const float4*)(As + kk * 132 + ty * 4);
            const float4 w0 = *(const float4*)(Ws + kk * 128 + tx * 4);
            const float4 w1 = *(const float4*)(Ws + kk * 128 + 64 + tx * 4);
            const float av4[4] = {a.x, a.y, a.z, a.w};
            const float wv8[8] = {w0.x, w0.y, w0.z, w0.w, w1.x, w1.y, w1.z, w1.w};
#pragma unroll
            for (int i = 0; i < 4; ++i)
#pragma unroll
                for (int j = 0; j < 8; ++j) acc[i][j] += av4[i] * wv8[j];
        }
    }
}
#define ZERO_ACC(a) _Pragma("unroll") for (int _i = 0; _i < 4; ++_i) _Pragma("unroll") for (int _j = 0; _j < 8; ++_j) a[_i][_j] = 0.f
#define TILE_ROW(r0, ty, i) ((r0) + (ty) * 4 + (i))
#define TILE_COL(c0, tx, j) ((c0) + ((j) < 4 ? (tx) * 4 + (j) : 64 + (tx) * 4 + (j) - 4))

struct RowsStrided {
    const bf16_t* base; int ld; int nrows;
    __device__ __forceinline__ const bf16_t* operator()(int r) const { return r < nrows ? base + (size_t)r * ld : nullptr; }
};

__device__ __forceinline__ void phase_norm(const Ctx& c, int layer, int mode) {
    const int lane = c.lane;
    const float* gain = (mode == 0 ? c.g_mix() : c.g_ffn()) + layer * D;
    const int nrows = (mode == 1 && layer == 1) ? R : RT;
    for (int rr = blockIdx.x * 8 + c.wave; rr < nrows; rr += gridDim.x * 8) {
        const float* src = (mode == 0) ? hsrc_row(c, layer, rr) : hdst_row(c, rr);
        float v[16];
#pragma unroll
        for (int i = 0; i < 4; ++i) { const float4 t = *(const float4*)(src + i * 256 + lane * 4); v[4 * i] = t.x; v[4 * i + 1] = t.y; v[4 * i + 2] = t.z; v[4 * i + 3] = t.w; }
        float ss = 0.f;
#pragma unroll
        for (int k = 0; k < 16; ++k) ss += v[k] * v[k];
        ss = wave_sum(ss);
        const float rstd = rsqrtf(ss * (1.f / D) + RMS_EPS);
#pragma unroll
        for (int i = 0; i < 4; ++i) {
            const float4 g = *(const float4*)(gain + i * 256 + lane * 4);
            v[4 * i] *= rstd * g.x; v[4 * i + 1] *= rstd * g.y; v[4 * i + 2] *= rstd * g.z; v[4 * i + 3] *= rstd * g.w;
            uint2 o; o.x = pack2(v[4 * i], v[4 * i + 1]); o.y = pack2(v[4 * i + 2], v[4 * i + 3]);
            *(uint2*)(c.XN() + (size_t)rr * D + i * 256 + lane * 4) = o;
        }
        if (mode == 0) {
            const float* wf = c.w_in() + (size_t)layer * D * INC + 1536;
            float d0 = 0.f, d1 = 0.f, d2 = 0.f, d3 = 0.f;
#pragma unroll
            for (int i = 0; i < 4; ++i)
#pragma unroll
                for (int j = 0; j < 4; ++j) {
                    const int col = i * 256 + lane * 4 + j;
                    const float4 w = *(const float4*)(wf + (size_t)col * INC);
                    const float y = v[4 * i + j];
                    d0 += y * w.x; d1 += y * w.y; d2 += y * w.z; d3 += y * w.w;
                }
            d0 = wave_sum(d0); d1 = wave_sum(d1); d2 = wave_sum(d2); d3 = wave_sum(d3);
            if (lane < 4) {
                const float dsel = lane == 0 ? d0 : lane == 1 ? d1 : lane == 2 ? d2 : d3;
                c.LF()[(size_t)rr * 4 + lane] = logsigf_(dsel + c.b_forget()[layer * 4 + lane]);
            }
        } else if (layer == 1) {
            float lg[8];
#pragma unroll
            for (int e = 0; e < 8; ++e) lg[e] = 0.f;
#pragma unroll
            for (int i = 0; i < 4; ++i)
#pragma unroll
                for (int j = 0; j < 4; ++j) {
                    const int col = i * 256 + lane * 4 + j;
                    const float4 w0 = *(const float4*)(c.router_w() + (size_t)col * 8);
                    const float4 w1 = *(const float4*)(c.router_w() + (size_t)col * 8 + 4);
                    const float y = v[4 * i + j];
                    lg[0] += y * w0.x; lg[1] += y * w0.y; lg[2] += y * w0.z; lg[3] += y * w0.w;
                    lg[4] += y * w1.x; lg[5] += y * w1.y; lg[6] += y * w1.z; lg[7] += y * w1.w;
                }
#pragma unroll
            for (int e = 0; e < 8; ++e) lg[e] = wave_sum(lg[e]);
            int i1 = 0; float v1 = lg[0];
#pragma unroll
            for (int e = 1; e < 8; ++e) if (lg[e] > v1) { v1 = lg[e]; i1 = e; }
            int i2 = -1; float v2 = -3.0e38f;
#pragma unroll
            for (int e = 0; e < 8; ++e) if (e != i1 && lg[e] > v2) { v2 = lg[e]; i2 = e; }
            const float w1 = 1.f / (1.f + expf(v2 - v1)), w2 = 1.f - w1;
            if (lane == 0) {
                const int p1 = atomicAdd(&c.CNT()[i1], 1); c.LIST()[(size_t)i1 * R + p1] = rr;
                const int p2 = atomicAdd(&c.CNT()[i2], 1); c.LIST()[(size_t)i2 * R + p2] = rr;
                c.PAIR()[(size_t)rr * 2] = (i1 << 20) | p1; c.PAIR()[(size_t)rr * 2 + 1] = (i2 << 20) | p2;
                c.TOPW()[(size_t)rr * 2] = w1; c.TOPW()[(size_t)rr * 2 + 1] = w2;
            }
        }
    }
}

__device__ __forceinline__ void side_cumsum(const Ctx& c) {
    if (blockIdx.x >= NB || c.wave >= 4) return;
    const int b = blockIdx.x, h = c.wave, lane = c.lane;
    float carry;
    {
        float v = lane < NM ? c.LF()[(size_t)(R + lane) * 4 + h] : 0.f;
        float sc = v;
#pragma unroll
        for (int o = 1; o < 64; o <<= 1) { const float t = __shfl_up(sc, o); if (lane >= o) sc += t; }
        if (b == 0 && lane < NM) c.C()[(size_t)(R + lane) * 4 + h] = sc;
        carry = __shfl(sc, 63);
    }
    for (int s0 = 0; s0 < S; s0 += 64) {
        const size_t rr = (size_t)b * S + s0 + lane;
        const float v = c.LF()[rr * 4 + h];
        float sc = v;
#pragma unroll
        for (int o = 1; o < 64; o <<= 1) { const float t = __shfl_up(sc, o); if (lane >= o) sc += t; }
        c.C()[rr * 4 + h] = carry + sc;
        carry += __shfl(sc, 63);
    }
}

__device__ __forceinline__ void phase_proj(const Ctx& c, int layer) {
    side_cumsum(c);
    const int ntr = (RT + 127) / 128, ntc = PC / 128;
    const float* W = c.w_in() + (size_t)layer * D * INC;
    const int ty = c.tid >> 4, tx = c.tid & 15;
    for (int t = blockIdx.x; t < ntr * ntc; t += gridDim.x) {
        const int tr = t / ntc, tc = t % ntc;
        const int r0 = tr * 128, c0 = tc * 128;
        const int wcol = c0 + (c0 >= 1536 ? 4 : 0);
        float acc[4][8]; ZERO_ACC(acc);
        ngemm(acc, RowsStrided{c.XN(), D, RT}, r0, W, INC, wcol, D, c.smem, c.tid);
#pragma unroll
        for (int i = 0; i < 4; ++i) {
            const int rr = TILE_ROW(r0, ty, i);
            if (rr < RT) {
                uint2 o0, o1;
                o0.x = pack2(acc[i][0], acc[i][1]); o0.y = pack2(acc[i][2], acc[i][3]);
                o1.x = pack2(acc[i][4], acc[i][5]); o1.y = pack2(acc[i][6], acc[i][7]);
                *(uint2*)(c.PROJ() + (size_t)rr * PC + c0 + tx * 4) = o0;
                *(uint2*)(c.PROJ() + (size_t)rr * PC + c0 + 64 + tx * 4) = o1;
            }
        }
    }
}

__device__ __forceinline__ int key_row(int b, int g) { return g < NM ? R + g : b * S + g - NM; }

__device__ __forceinline__ float qk_dot(const float* qs, const bf16_t* kp) {
    float dot = 0.f;
#pragma unroll 4
    for (int dd = 0; dd < 16; ++dd) {
        const uint4 kk = *(const uint4*)(kp + dd * 8);
        const float4 qa = *(const float4*)(qs + dd * 8), qb = *(const float4*)(qs + dd * 8 + 4);
        dot += qa.x * bflo(kk.x) + qa.y * bfhi(kk.x) + qa.z * bflo(kk.y) + qa.w * bfhi(kk.y)
             + qb.x * bflo(kk.z) + qb.y * bfhi(kk.z) + qb.z * bflo(kk.w) + qb.w * bfhi(kk.w);
    }
    return dot;
}

__device__ __forceinline__ void attn_query(const Ctx& c, int type, int rr, int h) {
    const int lane = c.lane;
    int b, pg;
    if (rr < R) { b = rr >> 13; pg = NM + (rr & (S - 1)); } else { b = 0; pg = rr - R; }
    const int cq = type == 0 ? C_FQ : C_SQ, ck = type == 0 ? C_FK : C_SK, cv = type == 0 ? C_FV : C_SV;
    bf16_t* qrow = c.PROJ() + (size_t)rr * PC + cq + h * 128;
    float* q = c.smem + c.wave * 128;
    const float scale = 0.08838834764831845f;
    q[lane] = bf2f(qrow[lane]) * scale; q[lane + 64] = bf2f(qrow[lane + 64]) * scale;
    float a0 = 0.f, a1 = 0.f;
    if (type == 0) {
        float m = -1e30f, l = 0.f;
        const float cqv = c.C()[(size_t)rr * 4 + h];
        const int nk = pg + 1;
        for (int g0 = 0; g0 < nk; g0 += 64) {
            const int g = g0 + lane; const bool valid = g < nk;
            const int krow = key_row(b, valid ? g : 0);
            const float dot = qk_dot(q, c.PROJ() + (size_t)krow * PC + ck + h * 128);
            const float sc = valid ? dot + cqv - c.C()[(size_t)krow * 4 + h] : -__builtin_inff();
            const float mn = fmaxf(m, wave_max(sc));
            const float p = valid ? expf(sc - mn) : 0.f;
            const float alpha = expf(m - mn);
            l = l * alpha + wave_sum(p); a0 *= alpha; a1 *= alpha; m = mn;
            const int cnt = min(64, nk - g0);
            for (int j = 0; j < cnt; ++j) {
                const float pj = __shfl(p, j);
                const int vrow = key_row(b, g0 + j);
                const unsigned vv = *(const unsigned*)(c.PROJ() + (size_t)vrow * PC + cv + h * 128 + lane * 2);
                a0 += pj * bflo(vv); a1 += pj * bfhi(vv);
            }
        }
        const float inv = 1.f / l; a0 *= inv; a1 *= inv;
    } else {
        float Rrun = 0.f;
        for (int gtop = pg - 1; gtop >= 0; gtop -= 64) {
            const int g = gtop - lane; const bool valid = g >= 0;
            const int krow = key_row(b, valid ? g : 0);
            const float z = qk_dot(q, c.PROJ() + (size_t)krow * PC + ck + h * 128);
            const float sp = softplusf_(z);
            const float mval = valid ? -sp : 0.f;
            float sc = mval;
#pragma unroll
            for (int o = 1; o < 64; o <<= 1) { const float t = __shfl_up(sc, o); if (lane >= o) sc += t; }
            const float excl = sc - mval;
            const float p = valid ? expf(z - sp + Rrun + excl) : 0.f;
            const int cnt = min(64, gtop + 1);
            for (int j = 0; j < cnt; ++j) {
                const float pj = __shfl(p, j);
                const int vrow = key_row(b, gtop - j);
                const unsigned vv = *(const unsigned*)(c.PROJ() + (size_t)vrow * PC + cv + h * 128 + lane * 2);
                a0 += pj * bflo(vv); a1 += pj * bfhi(vv);
            }
            Rrun += __shfl(sc, 63);
            if (Rrun < -110.f) break;
        }
    }
    *(unsigned*)(qrow + lane * 2) = pack2(a0, a1);
}

__device__ __forceinline__ void lru_item(const Ctx& c, int layer, int seq, int chunk, int n, int pass) {
    float* xs = c.smem;
    float* us = xs + 67 * 64;
    float* as_ = us + 64 * 64;
    float* is_ = as_ + 64 * 64;
    const int tid = c.tid;
    const int len = seq == 4 ? NM : LCH;
    const int gbase = seq == 4 ? 0 : NM + chunk * LCH;
    const int b = seq == 4 ? 0 : seq;
    __syncthreads();
    for (int e = tid; e < (len + 3) * 64; e += NTHR) {
        const int t = e >> 6, ch = e & 63; const int g = gbase - 3 + t;
        float v = 0.f;
        if (g >= 0) v = bf2f(c.PROJ()[(size_t)key_row(b, g) * PC + C_LX + n * 64 + ch]);
        xs[e] = v;
    }
    __syncthreads();
    const float* cw = c.conv_w() + (size_t)layer * 4 * 512 + n * 64;
    const float* cb = c.conv_b() + layer * 512 + n * 64;
    for (int e = tid; e < len * 64; e += NTHR) {
        const int t = e >> 6, ch = e & 63;
        float u = cb[ch];
#pragma unroll
        for (int j = 0; j < 4; ++j) u += cw[j * 512 + ch] * xs[(t + j) * 64 + ch];
        us[e] = u;
    }
    __syncthreads();
    {
        const int j = tid & 63, tg = tid >> 6;
        const float* wa = c.wa() + ((size_t)layer * 8 + n) * 4096;
        const float* wx = c.wx() + ((size_t)layer * 8 + n) * 4096;
        float ar[8], ax[8];
#pragma unroll
        for (int tt = 0; tt < 8; ++tt) { ar[tt] = 0.f; ax[tt] = 0.f; }
        for (int i = 0; i < 64; ++i) {
            const float wai = wa[i * 64 + j], wxi = wx[i * 64 + j];
#pragma unroll
            for (int tt = 0; tt < 8; ++tt) { const float u = us[(tg * 8 + tt) * 64 + i]; ar[tt] += u * wai; ax[tt] += u * wxi; }
        }
        const float bav = c.ba()[layer * 512 + n * 64 + j], bxv = c.bx()[layer * 512 + n * 64 + j];
        const float spl = softplusf_(-c.lam()[layer * 512 + n * 64 + j]);
#pragma unroll
        for (int tt = 0; tt < 8; ++tt) {
            const int t = tg * 8 + tt;
            if (t < len) {
                const float r = sigmoidf_(ar[tt] + bav), gi = sigmoidf_(ax[tt] + bxv);
                const float la = -8.f * r * spl;
                as_[t * 64 + j] = expf(la);
                is_[t * 64 + j] = sqrtf(-expm1f(2.f * la)) * gi * us[t * 64 + j];
            }
        }
    }
    __syncthreads();
    if (tid < 64) {
        const int ch = tid; const int cidx = n * 64 + ch;
        const size_t sidx = (size_t)(seq == 4 ? 4 * NLC : seq * NLC + chunk) * 512 + cidx;
        if (pass == 0) {
            float hst = 0.f, P = 1.f;
            for (int t = 0; t < len; ++t) { const float a = as_[t * 64 + ch]; hst = a * hst + is_[t * 64 + ch]; P *= a; }
            c.SUMP()[sidx] = P; c.SUME()[sidx] = hst;
        } else {
            float hst = 0.f;
            if (seq != 4) {
                hst = c.SUME()[(size_t)(4 * NLC) * 512 + cidx];
                for (int cc = 0; cc < chunk; ++cc) { const size_t si = (size_t)(seq * NLC + cc) * 512 + cidx; hst = c.SUMP()[si] * hst + c.SUME()[si]; }
            }
            for (int t = 0; t < len; ++t) {
                hst = as_[t * 64 + ch] * hst + is_[t * 64 + ch];
                bf16_t* gp = c.PROJ() + (size_t)key_row(b, gbase + t) * PC + C_LG + cidx;
                *gp = f2bf(hst * gelu_tanh(bf2f(*gp)));
            }
        }
    }
}

__device__ __forceinline__ void phase_lru(const Ctx& c, int layer, int pass) {
    const int nitems = NB * NLC * 8 + 8;
    for (int it = blockIdx.x; it < nitems; it += gridDim.x) {
        if (it < NB * NLC * 8) { const int n = it & 7, ch = (it >> 3) % NLC, b = (it >> 3) / NLC; lru_item(c, layer, b, ch, n, pass); }
        else lru_item(c, layer, 4, 0, it - NB * NLC * 8, pass);
    }
}

__device__ __forceinline__ void phase_attn(const Ctx& c, int layer) {
    phase_lru(c, layer, 0);
    const int nitems = RT * 8;
    for (int it = blockIdx.x * 8 + c.wave; it < nitems; it += gridDim.x * 8) {
        const int rr = it % RT, hh = it / RT;
        attn_query(c, hh >> 2, rr, hh & 3);
    }
}

__device__ __forceinline__ void phase_merge(const Ctx& c, int layer) {
    const int ntr = (RT + 127) / 128, ntc = D / 128;
    const int ty = c.tid >> 4, tx = c.tid & 15;
    const float* Wg = c.w_in() + (size_t)layer * D * INC + WI_GATES;
    for (int t = blockIdx.x; t < ntr * ntc; t += gridDim.x) {
        const int tr = t / ntc, tc = t % ntc;
        const int r0 = tr * 128, c0 = tc * 128;
        float macc[4][8]; ZERO_ACC(macc);
#pragma unroll 1
        for (int i3 = 0; i3 < 3; ++i3) {
            const float* Wo = (i3 == 0 ? c.w_fox_o() : i3 == 1 ? c.w_sb_o() : c.w_lru_o()) + (size_t)layer * 512 * D;
            const int acol = i3 == 0 ? C_FQ : i3 == 1 ? C_SQ : C_LG;
            float ya[4][8]; ZERO_ACC(ya);
            ngemm(ya, RowsStrided{c.PROJ() + acol, PC, RT}, r0, Wo, D, c0, 512, c.smem, c.tid);
            float ga[4][8]; ZERO_ACC(ga);
            ngemm(ga, RowsStrided{c.XN(), D, RT}, r0, Wg + i3 * D, INC, c0, D, c.smem, c.tid);
            const float* bg = c.b_gate() + layer * 3 * D + i3 * D;
#pragma unroll
            for (int i = 0; i < 4; ++i)
#pragma unroll
                for (int j = 0; j < 8; ++j) macc[i][j] += sigmoidf_(ga[i][j] + bg[TILE_COL(c0, tx, j)]) * ya[i][j];
        }
#pragma unroll
        for (int i = 0; i < 4; ++i) {
            const int rr = TILE_ROW(r0, ty, i);
            if (rr < RT) {
                uint2 o0, o1;
                o0.x = pack2(macc[i][0], macc[i][1]); o0.y = pack2(macc[i][2], macc[i][3]);
                o1.x = pack2(macc[i][4], macc[i][5]); o1.y = pack2(macc[i][6], macc[i][7]);
                *(uint2*)(c.PROJ() + (size_t)rr * PC + C_MRG + c0 + tx * 4) = o0;
                *(uint2*)(c.PROJ() + (size_t)rr * PC + C_MRG + c0 + 64 + tx * 4) = o1;
            }
        }
    }
}

__device__ __forceinline__ void phase_resid_gemm(const Ctx& c, int layer, int src_layer0, const bf16_t* A, int lda, const float* W, int K) {
    const int ntr = (RT + 127) / 128, ntc = D / 128;
    const int ty = c.tid >> 4, tx = c.tid & 15;
    for (int t = blockIdx.x; t < ntr * ntc; t += gridDim.x) {
        const int tr = t / ntc, tc = t % ntc;
        const int r0 = tr * 128, c0 = tc * 128;
        float acc[4][8]; ZERO_ACC(acc);
        ngemm(acc, RowsStrided{A, lda, RT}, r0, W, D, c0, K, c.smem, c.tid);
#pragma unroll
        for (int i = 0; i < 4; ++i) {
            const int rr = TILE_ROW(r0, ty, i);
            if (rr < RT) {
                const float* src = src_layer0 ? hsrc_row(c, 0, rr) : hdst_row(c, rr);
                float* dst = hdst_row(c, rr);
                const float4 s0 = *(const float4*)(src + c0 + tx * 4), s1 = *(const float4*)(src + c0 + 64 + tx * 4);
                float4 o0, o1;
                o0.x = s0.x + acc[i][0]; o0.y = s0.y + acc[i][1]; o0.z = s0.z + acc[i][2]; o0.w = s0.w + acc[i][3];
                o1.x = s1.x + acc[i][4]; o1.y = s1.y + acc[i][5]; o1.z = s1.z + acc[i][6]; o1.w = s1.w + acc[i][7];
                *(float4*)(dst + c0 + tx * 4) = o0; *(float4*)(dst + c0 + 64 + tx * 4) = o1;
            }
        }
    }
}

__device__ __forceinline__ void phase_ffn_up(const Ctx& c) {
    const int ntr = (RT + 127) / 128, ntc = DFF / 128;
    const int ty = c.tid >> 4, tx = c.tid & 15;
    bf16_t* HID = c.PROJ();
    for (int t = blockIdx.x; t < ntr * ntc; t += gridDim.x) {
        const int tr = t / ntc, tc = t % ntc;
        const int r0 = tr * 128, c0 = tc * 128;
        float ga[4][8]; ZERO_ACC(ga);
        ngemm(ga, RowsStrided{c.XN(), D, RT}, r0, c.ffn_wg(), DFF, c0, D, c.smem, c.tid);
        float ua[4][8]; ZERO_ACC(ua);
        ngemm(ua, RowsStrided{c.XN(), D, RT}, r0, c.ffn_wu(), DFF, c0, D, c.smem, c.tid);
#pragma unroll
        for (int i = 0; i < 4; ++i) {
            const int rr = TILE_ROW(r0, ty, i);
            if (rr < RT) {
                float hv[8];
#pragma unroll
                for (int j = 0; j < 8; ++j) { const float g = ga[i][j]; hv[j] = g * sigmoidf_(g) * ua[i][j]; }
                uint2 o0, o1;
                o0.x = pack2(hv[0], hv[1]); o0.y = pack2(hv[2], hv[3]); o1.x = pack2(hv[4], hv[5]); o1.y = pack2(hv[6], hv[7]);
                *(uint2*)(HID + (size_t)rr * DFF + c0 + tx * 4) = o0;
                *(uint2*)(HID + (size_t)rr * DFF + c0 + 64 + tx * 4) = o1;
            }
        }
    }
}

struct MoeMap { int ebase[9]; int cnt[8]; };
__device__ __forceinline__ void moe_map(const Ctx& c, MoeMap& m) {
    int acc = 0;
#pragma unroll
    for (int e = 0; e < 8; ++e) { m.cnt[e] = c.CNT()[e]; m.ebase[e] = acc; acc += (m.cnt[e] + 127) & ~127; }
    m.ebase[8] = acc;
}
struct RowsMoe {
    const bf16_t* XN; const int* list; int ebase, cnt;
    __device__ __forceinline__ const bf16_t* operator()(int slot) const { const int pos = slot - ebase; return pos < cnt ? XN + (size_t)list[pos] * D : nullptr; }
};
__device__ __forceinline__ void phase_moe_up(const Ctx& c, int chunk) {
    MoeMap m; moe_map(c, m);
    const int total = m.ebase[8];
    const int ntr = MOE_CH / 128, ntc = DFE / 128;
    const int ty = c.tid >> 4, tx = c.tid & 15;
    for (int t = blockIdx.x; t < ntr * ntc; t += gridDim.x) {
        const int tr = t / ntc, tc = t % ntc;
        const int slot0 = chunk * MOE_CH + tr * 128, c0 = tc * 128;
        if (slot0 >= total) continue;
        int e = 0;
#pragma unroll
        for (int k = 1; k < 8; ++k) if (slot0 >= m.ebase[k]) e = k;
        int eb = 0, ec = 0;
#pragma unroll
        for (int k = 0; k < 8; ++k) if (k == e) { eb = m.ebase[k]; ec = m.cnt[k]; }
        const RowsMoe rows{c.XN(), c.LIST() + (size_t)e * R, eb, ec};
        float ga[4][8]; ZERO_ACC(ga);
        ngemm(ga, rows, slot0, c.moe_wg() + (size_t)e * D * DFE, DFE, c0, D, c.smem, c.tid);
        float ua[4][8]; ZERO_ACC(ua);
        ngemm(ua, rows, slot0, c.moe_wu() + (size_t)e * D * DFE, DFE, c0, D, c.smem, c.tid);
#pragma unroll
        for (int i = 0; i < 4; ++i) {
            const int lr = tr * 128 + ty * 4 + i;
            float hv[8];
#pragma unroll
            for (int j = 0; j < 8; ++j) { const float g = ga[i][j]; hv[j] = g * sigmoidf_(g) * ua[i][j]; }
            uint2 o0, o1;
            o0.x = pack2(hv[0], hv[1]); o0.y = pack2(hv[2], hv[3]); o1.x = pack2(hv[4], hv[5]); o1.y = pack2(hv[6], hv[7]);
            *(uint2*)(c.HIDC() + (size_t)lr * DFE + c0 + tx * 4) = o0;
            *(uint2*)(c.HIDC() + (size_t)lr * DFE + c0 + 64 + tx * 4) = o1;
        }
    }
}
__device__ __forceinline__ void phase_moe_down(const Ctx& c, int chunk) {
    MoeMap m; moe_map(c, m);
    const int total = m.ebase[8];
    const int ntr = MOE_CH / 128, ntc = D / 128;
    const int ty = c.tid >> 4, tx = c.tid & 15;
    for (int t = blockIdx.x; t < ntr * ntc; t += gridDim.x) {
        const int tr = t / ntc, tc = t % ntc;
        const int slot0 = chunk * MOE_CH + tr * 128, c0 = tc * 128;
        if (slot0 >= total) continue;
        int e = 0;
#pragma unroll
        for (int k = 1; k < 8; ++k) if (slot0 >= m.ebase[k]) e = k;
        float acc[4][8]; ZERO_ACC(acc);
        ngemm(acc, RowsStrided{c.HIDC(), DFE, MOE_CH}, tr * 128, c.moe_wd() + (size_t)e * DFE * D, D, c0, DFE, c.smem, c.tid);
#pragma unroll
        for (int i = 0; i < 4; ++i) {
            const int slot = slot0 + ty * 4 + i;
            uint2 o0, o1;
            o0.x = pack2(acc[i][0], acc[i][1]); o0.y = pack2(acc[i][2], acc[i][3]);
            o1.x = pack2(acc[i][4], acc[i][5]); o1.y = pack2(acc[i][6], acc[i][7]);
            *(uint2*)(c.Y() + (size_t)slot * D + c0 + tx * 4) = o0;
            *(uint2*)(c.Y() + (size_t)slot * D + c0 + 64 + tx * 4) = o1;
        }
    }
}
__device__ __forceinline__ void phase_final(const Ctx& c) {
    MoeMap m; moe_map(c, m);
    const int lane = c.lane;
    for (int rr = blockIdx.x * 8 + c.wave; rr < R; rr += gridDim.x * 8) {
        const int p0 = c.PAIR()[(size_t)rr * 2], p1 = c.PAIR()[(size_t)rr * 2 + 1];
        const float w0 = c.TOPW()[(size_t)rr * 2], w1 = c.TOPW()[(size_t)rr * 2 + 1];
        int b0 = 0, b1 = 0;
#pragma unroll
        for (int k = 0; k < 8; ++k) { if (k == (p0 >> 20)) b0 = m.ebase[k]; if (k == (p1 >> 20)) b1 = m.ebase[k]; }
        const bf16_t* y0 = c.Y() + (size_t)(b0 + (p0 & 0xFFFFF)) * D;
        const bf16_t* y1 = c.Y() + (size_t)(b1 + (p1 & 0xFFFFF)) * D;
        float* hrow = c.out() + (size_t)rr * D;
        float v[16];
        float ss = 0.f;
#pragma unroll
        for (int i = 0; i < 4; ++i) {
            const float4 t = *(const float4*)(hrow + i * 256 + lane * 4);
            const uint2 a = *(const uint2*)(y0 + i * 256 + lane * 4), bq = *(const uint2*)(y1 + i * 256 + lane * 4);
            v[4 * i] = t.x + w0 * bflo(a.x) + w1 * bflo(bq.x); v[4 * i + 1] = t.y + w0 * bfhi(a.x) + w1 * bfhi(bq.x);
            v[4 * i + 2] = t.z + w0 * bflo(a.y) + w1 * bflo(bq.y); v[4 * i + 3] = t.w + w0 * bfhi(a.y) + w1 * bfhi(bq.y);
        }
#pragma unroll
        for (int k = 0; k < 16; ++k) ss += v[k] * v[k];
        ss = wave_sum(ss);
        const float rstd = rsqrtf(ss * (1.f / D) + RMS_EPS);
#pragma unroll
        for (int i = 0; i < 4; ++i) {
            const float4 g = *(const float4*)(c.g_final() + i * 256 + lane * 4);
            float4 o; o.x = v[4 * i] * rstd * g.x; o.y = v[4 * i + 1] * rstd * g.y; o.z = v[4 * i + 2] * rstd * g.z; o.w = v[4 * i + 3] * rstd * g.w;
            *(float4*)(hrow + i * 256 + lane * 4) = o;
        }
    }
}

constexpr int N_PHASES = 27;
constexpr int LDS_BYTES = 147456;
__global__ void __launch_bounds__(NTHR, 2) fwd(Args args) {
    extern __shared__ __attribute__((aligned(16))) unsigned char lds[];
    Ctx c; c.a = &args;
    c.smem = (float*)(lds + 64);
    c.tid = threadIdx.x; c.lane = c.tid & 63; c.wave = __builtin_amdgcn_readfirstlane(c.tid >> 6);

    if (c.tid < 4) ((unsigned*)lds)[c.tid] = 0u;
    __syncthreads();
    const int lo = args.ph_lo, hi = args.ph_hi;
    XcdBarrier bar; bar.bar = (unsigned*)(args.ws + WS_BAR); bar.x = 0; bar.st = (volatile LAS unsigned*)lds;
    if (hi - lo > 1) bar = xcd_barrier_post((unsigned*)(args.ws + WS_BAR), (volatile LAS unsigned*)lds);
#define IN(k) (lo <= (k) && (k) < hi)
#define SEAM(k) do { if (IN(k) && IN((k) + 1)) xcd_barrier(bar); } while (0)

    if (IN(0)) phase_norm(c, 0, 0);
    SEAM(0);
    if (IN(1)) phase_proj(c, 0);
    SEAM(1);
    if (IN(2)) phase_attn(c, 0);
    SEAM(2);
    if (IN(3)) phase_lru(c, 0, 1);
    SEAM(3);
    if (IN(4)) phase_merge(c, 0);
    SEAM(4);
    if (IN(5)) phase_resid_gemm(c, 0, 1, c.PROJ() + C_MRG, PC, c.w_out() + (size_t)0 * D * D, D);
    SEAM(5);
    if (IN(6)) phase_norm(c, 0, 1);
    SEAM(6);
    if (IN(7)) phase_ffn_up(c);
    SEAM(7);
    if (IN(8)) phase_resid_gemm(c, 0, 0, c.PROJ(), DFF, c.ffn_wd(), DFF);
    SEAM(8);
    if (IN(9)) phase_norm(c, 1, 0);
    SEAM(9);
    if (IN(10)) phase_proj(c, 1);
    SEAM(10);
    if (IN(11)) phase_attn(c, 1);
    SEAM(11);
    if (IN(12)) phase_lru(c, 1, 1);
    SEAM(12);
    if (IN(13)) phase_merge(c, 1);
    SEAM(13);
    if (IN(14)) phase_resid_gemm(c, 1, 0, c.PROJ() + C_MRG, PC, c.w_out() + (size_t)1 * D * D, D);
    SEAM(14);
    if (IN(15)) phase_norm(c, 1, 1);
    SEAM(15);
#pragma unroll 1
    for (int ch = 0; ch < MOE_NCH; ++ch) {
        if (IN(16 + 2 * ch)) phase_moe_up(c, ch);
        SEAM(16 + 2 * ch);
        if (IN(17 + 2 * ch)) phase_moe_down(c, ch);
        SEAM(17 + 2 * ch);
    }
    if (IN(26)) phase_final(c);
}

extern "C" void kernel_launch(void* const* d_in, const int* in_sizes, int n_in, void* d_out, int out_size, void* d_ws, size_t ws_size, hipStream_t stream) {
    static int grid = 0;
    if (grid == 0) {
        if (n_in != 26 || out_size != R * D || ws_size < WS_END) { fprintf(stderr, "kernel_launch: unexpected problem (n_in %d out %d ws %zu)\n", n_in, out_size, ws_size); grid = -1; return; }
        int dev = 0, cus = 0, per_cu = 0;
        if (hipGetDevice(&dev) != hipSuccess || hipDeviceGetAttribute(&cus, hipDeviceAttributeMultiprocessorCount, dev) != hipSuccess) { grid = -1; return; }
        if (hipFuncSetAttribute((const void*)fwd, hipFuncAttributeMaxDynamicSharedMemorySize, LDS_BYTES) != hipSuccess) { grid = -1; return; }
        if (hipOccupancyMaxActiveBlocksPerMultiprocessor(&per_cu, (const void*)fwd, NTHR, LDS_BYTES) != hipSuccess || per_cu < 1) { fprintf(stderr, "occupancy query: %d\n", per_cu); }
        (void)hipGetLastError();
        grid = cus;
    }
    if (grid < 0) return;
    (void)hipMemsetAsync(d_ws, 0, WS_ZERO_BYTES, stream);
    Args a{};
    for (int i = 0; i < 26; ++i) a.in[i] = (const float*)d_in[i];
    a.out = (float*)d_out; a.ws = (unsigned char*)d_ws;
#if N_LAUNCH_MODE == 1
    a.ph_lo = 0; a.ph_hi = N_PHASES;
    hipLaunchKernelGGL(fwd, dim3(grid), dim3(NTHR), LDS_BYTES, stream, a);
#else
    for (int p = 0; p < N_PHASES; ++p) {
        a.ph_lo = p; a.ph_hi = p + 1;
        hipLaunchKernelGGL(fwd, dim3(grid), dim3(NTHR), LDS_BYTES, stream, a);
    }
#endif
}
```

```cpp
#include <hip/hip_runtime.h>
#include <cstdio>
#include <cstdint>

#ifndef N_LAUNCH_MODE
#define N_LAUNCH_MODE 1
#endif

typedef unsigned short bf16_t;
#define LAS __attribute__((address_space(3)))

constexpr int D = 1024, NB = 4, S = 8192, NM = 16, R = NB * S, RT = R + NM;
constexpr int INC = 7172;
constexpr int PC = 4096;
constexpr int C_FQ = 0, C_FK = 512, C_FV = 1024, C_SQ = 1536, C_SK = 2048, C_SV = 2560, C_LX = 3072, C_LG = 3584, C_MRG = 512;
constexpr int WI_GATES = 4100;
constexpr int DFF = 2816, DFE = 3584, NE = 8;
constexpr int LCH = 64, NLC = S / LCH;
constexpr int MOE_CH = 16384;
constexpr int MOE_NCH = 5;
constexpr int NTHR = 512;
constexpr float RMS_EPS = 1e-6f;

constexpr size_t MiB = 1ull << 20;
constexpr size_t WS_BAR = 0;
constexpr size_t WS_CNT = 16384;
constexpr size_t WS_ZERO_BYTES = 16384 + 4096;
constexpr size_t WS_HMETA = 32768;
constexpr size_t WS_LF = 1 * MiB;
constexpr size_t WS_C = 2 * MiB;
constexpr size_t WS_SUMP = 3 * MiB;
constexpr size_t WS_SUME = 4 * MiB + 65536;
constexpr size_t WS_LIST = 6 * MiB;
constexpr size_t WS_PAIR = 7 * MiB;
constexpr size_t WS_TOPW = 7 * MiB + 512 * 1024;
constexpr size_t WS_XN = 8 * MiB;
constexpr size_t WS_PROJ = 73 * MiB;
constexpr size_t WS_HIDC_OFF = 0;
constexpr size_t WS_Y_OFF = 112 * MiB;
constexpr size_t WS_WB = 331 * MiB;
constexpr size_t WB_LAYER = 19 * MiB, WB_IN = 0, WB_G = 8 * MiB, WB_FO = 14 * MiB, WB_SO = 15 * MiB, WB_LO = 16 * MiB, WB_OUT = 17 * MiB;
constexpr size_t WS_WGU = 369 * MiB;
constexpr size_t WS_WD = 380 * MiB;
constexpr size_t WS_GSCR = 400 * MiB;
constexpr size_t WS_VT = 432 * MiB;
constexpr size_t WS_MOE_GU = 331 * MiB;
constexpr size_t WS_MOE_D = 443 * MiB;
constexpr size_t WS_END = 499 * MiB;

__device__ __forceinline__ float bf2f(bf16_t v) { return __uint_as_float(((unsigned)v) << 16); }
__device__ __forceinline__ float bflo(unsigned v) { return __uint_as_float(v << 16); }
__device__ __forceinline__ float bfhi(unsigned v) { return __uint_as_float(v & 0xFFFF0000u); }
__device__ __forceinline__ bf16_t f2bf(float f) { unsigned u = __float_as_uint(f); u += 0x7FFFu + ((u >> 16) & 1u); return (bf16_t)(u >> 16); }
__device__ __forceinline__ unsigned pack2(float a, float b) { return (unsigned)f2bf(a) | ((unsigned)f2bf(b) << 16); }
__device__ __forceinline__ float wave_sum(float v) {
#pragma unroll
    for (int o = 32; o; o >>= 1) v += __shfl_xor(v, o);
    return v;
}
__device__ __forceinline__ float wave_max(float v) {
#pragma unroll
    for (int o = 32; o; o >>= 1) v = fmaxf(v, __shfl_xor(v, o));
    return v;
}
__device__ __forceinline__ float sigmoidf_(float x) { return 1.f / (1.f + expf(-x)); }
__device__ __forceinline__ float softplusf_(float x) { return fmaxf(x, 0.f) + log1pf(expf(-fabsf(x))); }
__device__ __forceinline__ float logsigf_(float x) { return fminf(x, 0.f) - log1pf(expf(-fabsf(x))); }
__device__ __forceinline__ float gelu_tanh(float x) { return 0.5f * x * (1.f + tanhf(0.7978845608028654f * (x + 0.044715f * x * x * x))); }

#define XB_TMO      128
#define XB_XCNT(j)  (256  + 64 * (j))
#define XB_XSUB(j)  (1280 + 64 * (j))
#define XB_XGEN(j)  (2304 + 64 * (j))
#define XB_TOP      3328
#define XB_TOPGEN   3392
#define XCD_BAR_WORDS 3456
#define XB_SPIN_CAP (1u << 24)
__device__ __forceinline__ unsigned xb_ld(unsigned* p)              { return __hip_atomic_load(p, __ATOMIC_RELAXED, __HIP_MEMORY_SCOPE_AGENT); }
__device__ __forceinline__ unsigned xb_add(unsigned* p, unsigned v) { return __hip_atomic_fetch_add(p, v, __ATOMIC_RELAXED, __HIP_MEMORY_SCOPE_AGENT); }
__device__ __forceinline__ unsigned xb_xcc_id() { return (unsigned)__builtin_amdgcn_s_getreg((3 << 11) | 20) & 0xFu; }
#define XB_SPIN(cond, bar) do { unsigned _sp = 0; while (cond) { __builtin_amdgcn_s_sleep(1); \
    if ((++_sp & 255u) == 0u) { if (xb_ld(&(bar)[XB_TMO])) break; if (_sp > XB_SPIN_CAP) { atomicAdd(&(bar)[XB_TMO], 1u); break; } } } } while (0)
struct XcdBarrier { unsigned* bar; unsigned x; volatile LAS unsigned* st; };
__device__ __forceinline__ XcdBarrier xcd_barrier_post(unsigned* bar, volatile LAS unsigned* st) {
    XcdBarrier b; b.bar = bar; b.x = xb_xcc_id(); b.st = st;
    if (threadIdx.x == 0) (void)xb_add(&bar[XB_XCNT(b.x)], 1u);
    return b;
}
__device__ __forceinline__ void xcd_barrier_complete(unsigned* bar, unsigned x, unsigned& nloc, unsigned& nx) {
    const unsigned G = gridDim.x * gridDim.y * gridDim.z;
    unsigned sum, cnt, mine, sp = 0u;
    for (;;) {
        sum = 0u; cnt = 0u; mine = 0u;
#pragma unroll
        for (unsigned j = 0; j < 16; ++j) { const unsigned c = xb_ld(&bar[XB_XCNT(j)]); sum += c; cnt += (c > 0u) ? 1u : 0u; mine = (j == x) ? c : mine; }
        if (sum == G) break;
        __builtin_amdgcn_s_sleep(1);
        if ((++sp & 255u) == 0u) { if (xb_ld(&bar[XB_TMO])) break; if (sp > XB_SPIN_CAP) { atomicAdd(&bar[XB_TMO], 1u); break; } }
    }
    nloc = mine > 0u ? mine : 1u; nx = cnt > 0u ? cnt : 1u;
}
__device__ __forceinline__ void xcd_barrier(const XcdBarrier& b) {
    asm volatile("s_waitcnt vmcnt(0)" ::: "memory");
    __syncthreads();
    if (threadIdx.x == 0) {
        unsigned* bar = b.bar;
        __builtin_amdgcn_s_waitcnt(0);
        unsigned nloc = b.st[0], nx = b.st[1];
        if (nloc == 0u) { xcd_barrier_complete(bar, b.x, nloc, nx); b.st[0] = nloc; b.st[1] = nx; }
        const unsigned old = xb_add(&bar[XB_XSUB(b.x)], 1u);
        const unsigned gen = old / nloc;
        if (old + 1u == (gen + 1u) * nloc) {
            __builtin_amdgcn_fence(__ATOMIC_RELEASE, "agent");
            asm volatile("s_waitcnt vmcnt(0)" ::: "memory");
            const unsigned og = xb_add(&bar[XB_TOP], 1u);
            const unsigned tg = og / nx;
            if (og + 1u == (tg + 1u) * nx) xb_add(&bar[XB_TOPGEN], 1u);
            else XB_SPIN(xb_ld(&bar[XB_TOPGEN]) == tg, bar);
            __builtin_amdgcn_fence(__ATOMIC_ACQUIRE, "agent");
            xb_add(&bar[XB_XGEN(b.x)], 1u);
            asm volatile("s_waitcnt vmcnt(0)" ::: "memory");
        } else {
            XB_SPIN(xb_ld(&bar[XB_XGEN(b.x)]) == gen, bar);
            __builtin_amdgcn_fence(__ATOMIC_ACQUIRE, "agent");
            asm volatile("s_waitcnt vmcnt(0)" ::: "memory");
        }
    }
    __syncthreads();
}

struct Args { const float* in[26]; float* out; unsigned char* ws; int ph_lo, ph_hi; };

struct Ctx {
    const Args* a; float* smem; int tid, lane, wave;
    __device__ __forceinline__ const float* x() const { return a->in[0]; }
    __device__ __forceinline__ const float* meta() const { return a->in[1]; }
    __device__ __forceinline__ const float* g_mix() const { return a->in[2]; }
    __device__ __forceinline__ const float* w_in() const { return a->in[3]; }
    __device__ __forceinline__ const float* b_forget() const { return a->in[4]; }
    __device__ __forceinline__ const float* b_gate() const { return a->in[5]; }
    __device__ __forceinline__ const float* conv_w() const { return a->in[6]; }
    __device__ __forceinline__ const float* conv_b() const { return a->in[7]; }
    __device__ __forceinline__ const float* wa() const { return a->in[8]; }
    __device__ __forceinline__ const float* ba() const { return a->in[9]; }
    __device__ __forceinline__ const float* wx() const { return a->in[10]; }
    __device__ __forceinline__ const float* bx() const { return a->in[11]; }
    __device__ __forceinline__ const float* lam() const { return a->in[12]; }
    __device__ __forceinline__ const float* w_fox_o() const { return a->in[13]; }
    __device__ __forceinline__ const float* w_sb_o() const { return a->in[14]; }
    __device__ __forceinline__ const float* w_lru_o() const { return a->in[15]; }
    __device__ __forceinline__ const float* w_out() const { return a->in[16]; }
    __device__ __forceinline__ const float* g_ffn() const { return a->in[17]; }
    __device__ __forceinline__ const float* ffn_wg() const { return a->in[18]; }
    __device__ __forceinline__ const float* ffn_wu() const { return a->in[19]; }
    __device__ __forceinline__ const float* ffn_wd() const { return a->in[20]; }
    __device__ __forceinline__ const float* router_w() const { return a->in[21]; }
    __device__ __forceinline__ const float* moe_wg() const { return a->in[22]; }
    __device__ __forceinline__ const float* moe_wu() const { return a->in[23]; }
    __device__ __forceinline__ const float* moe_wd() const { return a->in[24]; }
    __device__ __forceinline__ const float* g_final() const { return a->in[25]; }
    __device__ __forceinline__ float* out() const { return a->out; }
    __device__ __forceinline__ float* hmeta() const { return (float*)(a->ws + WS_HMETA); }
    __device__ __forceinline__ float* LF() const { return (float*)(a->ws + WS_LF); }
    __device__ __forceinline__ float* C() const { return (float*)(a->ws + WS_C); }
    __device__ __forceinline__ float* SUMP() const { return (float*)(a->ws + WS_SUMP); }
    __device__ __forceinline__ float* SUME() const { return (float*)(a->ws + WS_SUME); }
    __device__ __forceinline__ int* LIST() const { return (int*)(a->ws + WS_LIST); }
    __device__ __forceinline__ int* PAIR() const { return (int*)(a->ws + WS_PAIR); }
    __device__ __forceinline__ float* TOPW() const { return (float*)(a->ws + WS_TOPW); }
    __device__ __forceinline__ int* CNT() const { return (int*)(a->ws + WS_CNT); }
    __device__ __forceinline__ bf16_t* XN() const { return (bf16_t*)(a->ws + WS_XN); }
    __device__ __forceinline__ bf16_t* PROJ() const { return (bf16_t*)(a->ws + WS_PROJ); }
    __device__ __forceinline__ bf16_t* HIDC() const { return (bf16_t*)(a->ws + WS_PROJ + WS_HIDC_OFF); }
    __device__ __forceinline__ bf16_t* Y() const { return (bf16_t*)(a->ws + WS_PROJ + WS_Y_OFF); }
};

__device__ __forceinline__ const float* hsrc_row(const Ctx& c, int layer, int rr) {
    if (layer == 0) return rr < R ? c.x() + (size_t)rr * D : c.meta() + (size_t)(rr - R) * D;
    return rr < R ? c.out() + (size_t)rr * D : c.hmeta() + (size_t)(rr - R) * D;
}
__device__ __forceinline__ float* hdst_row(const Ctx& c, int rr) {
    return rr < R ? c.out() + (size_t)rr * D : c.hmeta() + (size_t)(rr - R) * D;
}

template <class AR>
__device__ __forceinline__ void ngemm(float (&acc)[4][8], const AR& arow, int r0, const float* __restrict__ W, int ldw, int c0, int K, float* smem, int tid) {
    float* As = smem; float* Ws = smem + 16 * 132;
    const int ty = tid >> 4, tx = tid & 15;
    const int lr = tid >> 2, lk = (tid & 3) * 4;
    const int wk = tid >> 5, wc = (tid & 31) * 4;
    const bf16_t* ap = arow(r0 + lr);
    for (int k0 = 0; k0 < K; k0 += 16) {
        uint2 av = make_uint2(0u, 0u);
        if (ap) av = *(const uint2*)(ap + k0 + lk);
        const float4 wv = *(const float4*)(W + (size_t)(k0 + wk) * ldw + c0 + wc);
        __syncthreads();
        As[(lk + 0) * 132 + lr] = bflo(av.x); As[(lk + 1) * 132 + lr] = bfhi(av.x);
        As[(lk + 2) * 132 + lr] = bflo(av.y); As[(lk + 3) * 132 + lr] = bfhi(av.y);
        *(float4*)(Ws + wk * 128 + wc) = wv;
        __syncthreads();
#pragma unroll 2
        for (int kk = 0; kk < 16; ++kk) {
            const float4 a = *(const float4*)(As + kk * 132 + ty * 4);
            const float4 w0 = *(const float4*)(Ws + kk * 128 + tx * 4);
            const float4 w1 = *(const float4*)(Ws + kk * 128 + 64 + tx * 4);
            const float av4[4] = {a.x, a.y, a.z, a.w};
            const float wv8[8] = {w0.x, w0.y, w0.z, w0.w, w1.x, w1.y, w1.z, w1.w};
#pragma unroll
            for (int i = 0; i < 4; ++i)
#pragma unroll
                for (int j = 0; j < 8; ++j) acc[i][j] += av4[i] * wv8[j];
        }
    }
}
#define ZERO_ACC(a) _Pragma("unroll") for (int _i = 0; _i < 4; ++_i) _Pragma("unroll") for (int _j = 0; _j < 8; ++_j) a[_i][_j] = 0.f
#define TILE_ROW(r0, ty, i) ((r0) + (ty) * 4 + (i))
#define TILE_COL(c0, tx, j) ((c0) + ((j) < 4 ? (tx) * 4 + (j) : 64 + (tx) * 4 + (j) - 4))

struct RowsStrided {
    const bf16_t* base; int ld; int nrows;
    __device__ __forceinline__ const bf16_t* operator()(int r) const { return r < nrows ? base + (size_t)r * ld : nullptr; }
};

__device__ __forceinline__ void phase_norm(const Ctx& c, int layer, int mode) {
    const int lane = c.lane;
    const float* gain = (mode == 0 ? c.g_mix() : c.g_ffn()) + layer * D;
    const int nrows = (mode == 1 && layer == 1) ? R : RT;
    for (int rr = blockIdx.x * 8 + c.wave; rr < nrows; rr += gridDim.x * 8) {
        const float* src = (mode == 0) ? hsrc_row(c, layer, rr) : hdst_row(c, rr);
        float v[16];
#pragma unroll
        for (int i = 0; i < 4; ++i) { const float4 t = *(const float4*)(src + i * 256 + lane * 4); v[4 * i] = t.x; v[4 * i + 1] = t.y; v[4 * i + 2] = t.z; v[4 * i + 3] = t.w; }
        float ss = 0.f;
#pragma unroll
        for (int k = 0; k < 16; ++k) ss += v[k] * v[k];
        ss = wave_sum(ss);
        const float rstd = rsqrtf(ss * (1.f / D) + RMS_EPS);
#pragma unroll
        for (int i = 0; i < 4; ++i) {
            const float4 g = *(const float4*)(gain + i * 256 + lane * 4);
            v[4 * i] *= rstd * g.x; v[4 * i + 1] *= rstd * g.y; v[4 * i + 2] *= rstd * g.z; v[4 * i + 3] *= rstd * g.w;
            uint2 o; o.x = pack2(v[4 * i], v[4 * i + 1]); o.y = pack2(v[4 * i + 2], v[4 * i + 3]);
            *(uint2*)(c.XN() + (size_t)rr * D + i * 256 + lane * 4) = o;
        }
        if (mode == 0) {
            const float* wf = c.w_in() + (size_t)layer * D * INC + 1536;
            float d0 = 0.f, d1 = 0.f, d2 = 0.f, d3 = 0.f;
#pragma unroll
            for (int i = 0; i < 4; ++i)
#pragma unroll
                for (int j = 0; j < 4; ++j) {
                    const int col = i * 256 + lane * 4 + j;
                    const float4 w = *(const float4*)(wf + (size_t)col * INC);
                    const float y = v[4 * i + j];
                    d0 += y * w.x; d1 += y * w.y; d2 += y * w.z; d3 += y * w.w;
                }
            d0 = wave_sum(d0); d1 = wave_sum(d1); d2 = wave_sum(d2); d3 = wave_sum(d3);
            if (lane < 4) {
                const float dsel = lane == 0 ? d0 : lane == 1 ? d1 : lane == 2 ? d2 : d3;
                c.LF()[(size_t)rr * 4 + lane] = logsigf_(dsel + c.b_forget()[layer * 4 + lane]);
            }
        } else if (layer == 1) {
            float lg[8];
#pragma unroll
            for (int e = 0; e < 8; ++e) lg[e] = 0.f;
#pragma unroll
            for (int i = 0; i < 4; ++i)
#pragma unroll
                for (int j = 0; j < 4; ++j) {
                    const int col = i * 256 + lane * 4 + j;
                    const float4 w0 = *(const float4*)(c.router_w() + (size_t)col * 8);
                    const float4 w1 = *(const float4*)(c.router_w() + (size_t)col * 8 + 4);
                    const float y = v[4 * i + j];
                    lg[0] += y * w0.x; lg[1] += y * w0.y; lg[2] += y * w0.z; lg[3] += y * w0.w;
                    lg[4] += y * w1.x; lg[5] += y * w1.y; lg[6] += y * w1.z; lg[7] += y * w1.w;
                }
#pragma unroll
            for (int e = 0; e < 8; ++e) lg[e] = wave_sum(lg[e]);
            int i1 = 0; float v1 = lg[0];
#pragma unroll
            for (int e = 1; e < 8; ++e) if (lg[e] > v1) { v1 = lg[e]; i1 = e; }
            int i2 = -1; float v2 = -3.0e38f;
#pragma unroll
            for (int e = 0; e < 8; ++e) if (e != i1 && lg[e] > v2) { v2 = lg[e]; i2 = e; }
            const float w1 = 1.f / (1.f + expf(v2 - v1)), w2 = 1.f - w1;
            if (lane == 0) {
                const int p1 = atomicAdd(&c.CNT()[i1], 1); c.LIST()[(size_t)i1 * R + p1] = rr;
                const int p2 = atomicAdd(&c.CNT()[i2], 1); c.LIST()[(size_t)i2 * R + p2] = rr;
                c.PAIR()[(size_t)rr * 2] = (i1 << 20) | p1; c.PAIR()[(size_t)rr * 2 + 1] = (i2 << 20) | p2;
                c.TOPW()[(size_t)rr * 2] = w1; c.TOPW()[(size_t)rr * 2 + 1] = w2;
            }
        }
    }
}

__device__ __forceinline__ void side_cumsum(const Ctx& c) {
    if (blockIdx.x >= 16 || c.wave != 0) return;
    const int b = blockIdx.x >> 2, h = blockIdx.x & 3, lane = c.lane;
    float carry;
    {
        float v = lane < NM ? c.LF()[(size_t)(R + lane) * 4 + h] : 0.f;
        float sc = v;
#pragma unroll
        for (int o = 1; o < 64; o <<= 1) { const float t = __shfl_up(sc, o); if (lane >= o) sc += t; }
        if (b == 0 && lane < NM) c.C()[(size_t)(R + lane) * 4 + h] = sc;
        carry = __shfl(sc, 63);
    }
    const float* lf = c.LF() + ((size_t)b * S + (size_t)lane * 128) * 4 + h;
    float* cc = c.C() + ((size_t)b * S + (size_t)lane * 128) * 4 + h;
    float tot = 0.f;
#pragma unroll 16
    for (int t = 0; t < 128; ++t) tot += lf[t * 4];
    float sc = tot;
#pragma unroll
    for (int o = 1; o < 64; o <<= 1) { const float t = __shfl_up(sc, o); if (lane >= o) sc += t; }
    float run = carry + sc - tot;
#pragma unroll 16
    for (int t = 0; t < 128; ++t) { run += lf[t * 4]; cc[t * 4] = run; }
}

__device__ __forceinline__ void phase_proj(const Ctx& c, int layer) {
    const int ntr = 1, ntc = PC / 128;
    const float* W = c.w_in() + (size_t)layer * D * INC;
    const int ty = c.tid >> 4, tx = c.tid & 15;
    for (int t = blockIdx.x; t < ntr * ntc; t += gridDim.x) {
        const int tr = R / 128 + t / ntc, tc = t % ntc;
        const int r0 = tr * 128, c0 = tc * 128;
        const int wcol = c0 + (c0 >= 1536 ? 4 : 0);
        float acc[4][8]; ZERO_ACC(acc);
        ngemm(acc, RowsStrided{c.XN(), D, RT}, r0, W, INC, wcol, D, c.smem, c.tid);
#pragma unroll
        for (int i = 0; i < 4; ++i) {
            const int rr = TILE_ROW(r0, ty, i);
            if (rr < RT) {
                uint2 o0, o1;
                o0.x = pack2(acc[i][0], acc[i][1]); o0.y = pack2(acc[i][2], acc[i][3]);
                o1.x = pack2(acc[i][4], acc[i][5]); o1.y = pack2(acc[i][6], acc[i][7]);
                *(uint2*)(c.PROJ() + (size_t)rr * PC + c0 + tx * 4) = o0;
                *(uint2*)(c.PROJ() + (size_t)rr * PC + c0 + 64 + tx * 4) = o1;
            }
        }
    }
}

__device__ __forceinline__ int key_row(int b, int g) { return g < NM ? R + g : b * S + g - NM; }

__device__ __forceinline__ float qk_dot(const float* qs, const bf16_t* kp) {
    float dot = 0.f;
#pragma unroll 4
    for (int dd = 0; dd < 16; ++dd) {
        const uint4 kk = *(const uint4*)(kp + dd * 8);
        const float4 qa = *(const float4*)(qs + dd * 8), qb = *(const float4*)(qs + dd * 8 + 4);
        dot += qa.x * bflo(kk.x) + qa.y * bfhi(kk.x) + qa.z * bflo(kk.y) + qa.w * bfhi(kk.y)
             + qb.x * bflo(kk.z) + qb.y * bfhi(kk.z) + qb.z * bflo(kk.w) + qb.w * bfhi(kk.w);
    }
    return dot;
}

__device__ __forceinline__ void attn_query(const Ctx& c, int type, int rr, int h) {
    const int lane = c.lane;
    int b, pg;
    if (rr < R) { b = rr >> 13; pg = NM + (rr & (S - 1)); } else { b = 0; pg = rr - R; }
    const int cq = type == 0 ? C_FQ : C_SQ, ck = type == 0 ? C_FK : C_SK, cv = type == 0 ? C_FV : C_SV;
    bf16_t* qrow = c.PROJ() + (size_t)rr * PC + cq + h * 128;
    float* q = c.smem + c.wave * 128;
    const float scale = 0.08838834764831845f;
    q[lane] = bf2f(qrow[lane]) * scale; q[lane + 64] = bf2f(qrow[lane + 64]) * scale;
    float a0 = 0.f, a1 = 0.f;
    if (type == 0) {
        float m = -1e30f, l = 0.f;
        const float cqv = c.C()[(size_t)rr * 4 + h];
        const int nk = pg + 1;
        for (int g0 = 0; g0 < nk; g0 += 64) {
            const int g = g0 + lane; const bool valid = g < nk;
            const int krow = key_row(b, valid ? g : 0);
            const float dot = qk_dot(q, c.PROJ() + (size_t)krow * PC + ck + h * 128);
            const float sc = valid ? dot + cqv - c.C()[(size_t)krow * 4 + h] : -__builtin_inff();
            const float mn = fmaxf(m, wave_max(sc));
            const float p = valid ? expf(sc - mn) : 0.f;
            const float alpha = expf(m - mn);
            l = l * alpha + wave_sum(p); a0 *= alpha; a1 *= alpha; m = mn;
            const int cnt = min(64, nk - g0);
            for (int j = 0; j < cnt; ++j) {
                const float pj = __shfl(p, j);
                const int vrow = key_row(b, g0 + j);
                const unsigned vv = *(const unsigned*)(c.PROJ() + (size_t)vrow * PC + cv + h * 128 + lane * 2);
                a0 += pj * bflo(vv); a1 += pj * bfhi(vv);
            }
        }
        const float inv = 1.f / l; a0 *= inv; a1 *= inv;
    } else {
        float Rrun = 0.f;
        for (int gtop = pg - 1; gtop >= 0; gtop -= 64) {
            const int g = gtop - lane; const bool valid = g >= 0;
            const int krow = key_row(b, valid ? g : 0);
            const float z = qk_dot(q, c.PROJ() + (size_t)krow * PC + ck + h * 128);
            const float sp = softplusf_(z);
            const float mval = valid ? -sp : 0.f;
            float sc = mval;
#pragma unroll
            for (int o = 1; o < 64; o <<= 1) { const float t = __shfl_up(sc, o); if (lane >= o) sc += t; }
            const float excl = sc - mval;
            const float p = valid ? expf(z - sp + Rrun + excl) : 0.f;
            const int cnt = min(64, gtop + 1);
            for (int j = 0; j < cnt; ++j) {
                const float pj = __shfl(p, j);
                const int vrow = key_row(b, gtop - j);
                const unsigned vv = *(const unsigned*)(c.PROJ() + (size_t)vrow * PC + cv + h * 128 + lane * 2);
                a0 += pj * bflo(vv); a1 += pj * bfhi(vv);
            }
            Rrun += __shfl(sc, 63);
            if (Rrun < -110.f) break;
        }
    }
    *(unsigned*)(qrow + lane * 2) = pack2(a0, a1);
}

__device__ __forceinline__ void lru_item(const Ctx& c, int layer, int seq, int chunk, int n, int pass) {
    float* xs = c.smem;
    float* us = xs + 67 * 64;
    float* as_ = us + 64 * 64;
    float* is_ = as_ + 64 * 64;
    const int tid = c.tid;
    const int len = seq == 4 ? NM : LCH;
    const int gbase = seq == 4 ? 0 : NM + chunk * LCH;
    const int b = seq == 4 ? 0 : seq;
    __syncthreads();
    for (int e = tid; e < (len + 3) * 64; e += NTHR) {
        const int t = e >> 6, ch = e & 63; const int g = gbase - 3 + t;
        float v = 0.f;
        if (g >= 0) v = bf2f(c.PROJ()[(size_t)key_row(b, g) * PC + C_LX + n * 64 + ch]);
        xs[e] = v;
    }
    __syncthreads();
    const float* cw = c.conv_w() + (size_t)layer * 4 * 512 + n * 64;
    const float* cb = c.conv_b() + layer * 512 + n * 64;
    for (int e = tid; e < len * 64; e += NTHR) {
        const int t = e >> 6, ch = e & 63;
        float u = cb[ch];
#pragma unroll
        for (int j = 0; j < 4; ++j) u += cw[j * 512 + ch] * xs[(t + j) * 64 + ch];
        us[e] = u;
    }
    __syncthreads();
    {
        const int j = tid & 63, tg = tid >> 6;
        const float* wa = c.wa() + ((size_t)layer * 8 + n) * 4096;
        const float* wx = c.wx() + ((size_t)layer * 8 + n) * 4096;
        float ar[8], ax[8];
#pragma unroll
        for (int tt = 0; tt < 8; ++tt) { ar[tt] = 0.f; ax[tt] = 0.f; }
        for (int i = 0; i < 64; ++i) {
            const float wai = wa[i * 64 + j], wxi = wx[i * 64 + j];
#pragma unroll
            for (int tt = 0; tt < 8; ++tt) { const float u = us[(tg * 8 + tt) * 64 + i]; ar[tt] += u * wai; ax[tt] += u * wxi; }
        }
        const float bav = c.ba()[layer * 512 + n * 64 + j], bxv = c.bx()[layer * 512 + n * 64 + j];
        const float spl = softplusf_(-c.lam()[layer * 512 + n * 64 + j]);
#pragma unroll
        for (int tt = 0; tt < 8; ++tt) {
            const int t = tg * 8 + tt;
            if (t < len) {
                const float r = sigmoidf_(ar[tt] + bav), gi = sigmoidf_(ax[tt] + bxv);
                const float la = -8.f * r * spl;
                as_[t * 64 + j] = expf(la);
                is_[t * 64 + j] = sqrtf(-expm1f(2.f * la)) * gi * us[t * 64 + j];
            }
        }
    }
    __syncthreads();
    if (tid < 64) {
        const int ch = tid; const int cidx = n * 64 + ch;
        const size_t sidx = (size_t)(seq == 4 ? 4 * NLC : seq * NLC + chunk) * 512 + cidx;
        if (pass == 0) {
            float hst = 0.f, P = 1.f;
            for (int t = 0; t < len; ++t) { const float a = as_[t * 64 + ch]; hst = a * hst + is_[t * 64 + ch]; P *= a; }
            c.SUMP()[sidx] = P; c.SUME()[sidx] = hst;
        } else {
            float hst = 0.f;
            if (seq != 4) {
                hst = c.SUME()[(size_t)(4 * NLC) * 512 + cidx];
                for (int cc = 0; cc < chunk; ++cc) { const size_t si = (size_t)(seq * NLC + cc) * 512 + cidx; hst = c.SUMP()[si] * hst + c.SUME()[si]; }
            }
            for (int t = 0; t < len; ++t) {
                hst = as_[t * 64 + ch] * hst + is_[t * 64 + ch];
                bf16_t* gp = c.PROJ() + (size_t)key_row(b, gbase + t) * PC + C_LG + cidx;
                *gp = f2bf(hst * gelu_tanh(bf2f(*gp)));
            }
        }
    }
}

__device__ __forceinline__ void phase_lru(const Ctx& c, int layer, int pass) {
    const int nitems = NB * NLC * 8 + 8;
    for (int it = blockIdx.x; it < nitems; it += gridDim.x) {
        if (it < NB * NLC * 8) { const int n = it & 7, ch = (it >> 3) % NLC, b = (it >> 3) / NLC; lru_item(c, layer, b, ch, n, pass); }
        else lru_item(c, layer, 4, 0, it - NB * NLC * 8, pass);
    }
}

__device__ __forceinline__ void phase_attn(const Ctx& c, int layer) {
    phase_lru(c, layer, 0);
    const int nitems = NM * 8;
    for (int it = blockIdx.x * 8 + c.wave; it < nitems; it += gridDim.x * 8) {
        const int rr = R + it % NM, hh = it / NM;
        attn_query(c, hh >> 2, rr, hh & 3);
    }
}

__device__ __forceinline__ void phase_merge(const Ctx& c, int layer) {
    const int ntr = 1, ntc = D / 128;
    const int ty = c.tid >> 4, tx = c.tid & 15;
    const float* Wg = c.w_in() + (size_t)layer * D * INC + WI_GATES;
    for (int t = blockIdx.x; t < ntr * ntc; t += gridDim.x) {
        const int tr = R / 128 + t / ntc, tc = t % ntc;
        const int r0 = tr * 128, c0 = tc * 128;
        float macc[4][8]; ZERO_ACC(macc);
#pragma unroll 1
        for (int i3 = 0; i3 < 3; ++i3) {
            const float* Wo = (i3 == 0 ? c.w_fox_o() : i3 == 1 ? c.w_sb_o() : c.w_lru_o()) + (size_t)layer * 512 * D;
            const int acol = i3 == 0 ? C_FQ : i3 == 1 ? C_SQ : C_LG;
            float ya[4][8]; ZERO_ACC(ya);
            ngemm(ya, RowsStrided{c.PROJ() + acol, PC, RT}, r0, Wo, D, c0, 512, c.smem, c.tid);
            float ga[4][8]; ZERO_ACC(ga);
            ngemm(ga, RowsStrided{c.XN(), D, RT}, r0, Wg + i3 * D, INC, c0, D, c.smem, c.tid);
            const float* bg = c.b_gate() + layer * 3 * D + i3 * D;
#pragma unroll
            for (int i = 0; i < 4; ++i)
#pragma unroll
                for (int j = 0; j < 8; ++j) macc[i][j] += sigmoidf_(ga[i][j] + bg[TILE_COL(c0, tx, j)]) * ya[i][j];
        }
#pragma unroll
        for (int i = 0; i < 4; ++i) {
            const int rr = TILE_ROW(r0, ty, i);
            if (rr < RT) {
                uint2 o0, o1;
                o0.x = pack2(macc[i][0], macc[i][1]); o0.y = pack2(macc[i][2], macc[i][3]);
                o1.x = pack2(macc[i][4], macc[i][5]); o1.y = pack2(macc[i][6], macc[i][7]);
                *(uint2*)(c.PROJ() + (size_t)rr * PC + C_MRG + c0 + tx * 4) = o0;
                *(uint2*)(c.PROJ() + (size_t)rr * PC + C_MRG + c0 + 64 + tx * 4) = o1;
            }
        }
    }
}

__device__ __forceinline__ void phase_resid_gemm(const Ctx& c, int layer, int src_layer0, const bf16_t* A, int lda, const float* W, int K) {
    const int ntr = 1, ntc = D / 128;
    const int ty = c.tid >> 4, tx = c.tid & 15;
    for (int t = blockIdx.x; t < ntr * ntc; t += gridDim.x) {
        const int tr = R / 128 + t / ntc, tc = t % ntc;
        const int r0 = tr * 128, c0 = tc * 128;
        float acc[4][8]; ZERO_ACC(acc);
        ngemm(acc, RowsStrided{A, lda, RT}, r0, W, D, c0, K, c.smem, c.tid);
#pragma unroll
        for (int i = 0; i < 4; ++i) {
            const int rr = TILE_ROW(r0, ty, i);
            if (rr < RT) {
                const float* src = src_layer0 ? hsrc_row(c, 0, rr) : hdst_row(c, rr);
                float* dst = hdst_row(c, rr);
                const float4 s0 = *(const float4*)(src + c0 + tx * 4), s1 = *(const float4*)(src + c0 + 64 + tx * 4);
                float4 o0, o1;
                o0.x = s0.x + acc[i][0]; o0.y = s0.y + acc[i][1]; o0.z = s0.z + acc[i][2]; o0.w = s0.w + acc[i][3];
                o1.x = s1.x + acc[i][4]; o1.y = s1.y + acc[i][5]; o1.z = s1.z + acc[i][6]; o1.w = s1.w + acc[i][7];
                *(float4*)(dst + c0 + tx * 4) = o0; *(float4*)(dst + c0 + 64 + tx * 4) = o1;
            }
        }
    }
}

__device__ __forceinline__ void phase_ffn_up(const Ctx& c) {
    const int ntr = 1, ntc = DFF / 128;
    const int ty = c.tid >> 4, tx = c.tid & 15;
    bf16_t* HID = c.PROJ();
    for (int t = blockIdx.x; t < ntr * ntc; t += gridDim.x) {
        const int tr = R / 128 + t / ntc, tc = t % ntc;
        const int r0 = tr * 128, c0 = tc * 128;
        float ga[4][8]; ZERO_ACC(ga);
        ngemm(ga, RowsStrided{c.XN(), D, RT}, r0, c.ffn_wg(), DFF, c0, D, c.smem, c.tid);
        float ua[4][8]; ZERO_ACC(ua);
        ngemm(ua, RowsStrided{c.XN(), D, RT}, r0, c.ffn_wu(), DFF, c0, D, c.smem, c.tid);
#pragma unroll
        for (int i = 0; i < 4; ++i) {
            const int rr = TILE_ROW(r0, ty, i);
            if (rr < RT) {
                float hv[8];
#pragma unroll
                for (int j = 0; j < 8; ++j) { const float g = ga[i][j]; hv[j] = g * sigmoidf_(g) * ua[i][j]; }
                uint2 o0, o1;
                o0.x = pack2(hv[0], hv[1]); o0.y = pack2(hv[2], hv[3]); o1.x = pack2(hv[4], hv[5]); o1.y = pack2(hv[6], hv[7]);
                *(uint2*)(HID + (size_t)rr * DFF + c0 + tx * 4) = o0;
                *(uint2*)(HID + (size_t)rr * DFF + c0 + 64 + tx * 4) = o1;
            }
        }
    }
}

namespace g8 {
constexpr int BM = 256, BK = 64, HALF = 128, HTB = HALF * BK * 2, STAGE_BYTES = 8 * HTB, NXCD = 8, WGM = 8;
typedef short bf16x8 __attribute__((ext_vector_type(8)));
typedef float f32x4 __attribute__((ext_vector_type(4)));
typedef unsigned u32x4 __attribute__((ext_vector_type(4)));
__device__ __forceinline__ int lds_byte(int r, int c) { const int st = (r >> 4) * 2 + (c >> 5), rr = r & 15, cc = c & 31, ob = rr * 64 + cc * 2; return st * 1024 + (ob ^ (((ob >> 9) & 1) << 5)); }
__device__ __forceinline__ void stage_rc(int b, int& R_, int& C_) { const int st = b / 1024, sb = b % 1024, swz = sb ^ (((sb >> 9) & 1) << 5); R_ = (st >> 1) * 16 + swz / 64; C_ = (st & 1) * 32 + (swz % 64) / 2; }
__device__ __forceinline__ int perm32(int rho) { const int n = rho >> 4, i = rho & 15; return 8 * (i >> 2) + 4 * n + (i & 3); }
__device__ __forceinline__ unsigned cvt_pk_bf16(float lo, float hi) { unsigned r; asm volatile("v_cvt_pk_bf16_f32 %0, %1, %2" : "=v"(r) : "v"(lo), "v"(hi)); return r; }

struct Unit {
    unsigned A;
    unsigned B;
    const int* gidx;
    int gcnt;
    int lda;
    int K;
    int tag;
    int pm, pn;
};

__device__ __forceinline__ void tile_of(int L, int nM, int nN, int& pm, int& pn) {
    const int nwg = nM * nN; int wgid = L;
    { const int q = nwg / NXCD, r = nwg % NXCD, xcd = wgid % NXCD, off = wgid / NXCD; wgid = (xcd < r ? xcd * (q + 1) : r * (q + 1) + (xcd - r) * q) + off; }
    const int nig = WGM * nN, gid = wgid / nig, fm = gid * WGM, gsz = (nM - fm) < WGM ? (nM - fm) : WGM;
    pm = fm + ((wgid % nig) % gsz); pn = (wgid % nig) / gsz;
}

template <bool PERM, bool GATHER>
__device__ __forceinline__ void mk_off(const Unit& u, const int (&sR)[2], const int (&sC)[2], unsigned (&vA)[2][2], unsigned (&vB)[2]) {
#pragma unroll
    for (int i = 0; i < 2; ++i) {
        if (GATHER) {
#pragma unroll
            for (int h = 0; h < 2; ++h) { const int r = h * HALF + sR[i]; const int idx = u.gidx[r < u.gcnt ? r : 0]; vA[h][i] = (unsigned)idx * (unsigned)u.lda + (unsigned)sC[i] * 2u; }
        } else {
            vA[0][i] = (unsigned)sR[i] * (unsigned)u.lda + (unsigned)sC[i] * 2u; vA[1][i] = 0u;
        }
        const int Rb = PERM ? ((sR[i] & ~31) + perm32(sR[i] & 31)) : sR[i];
        vB[i] = ((unsigned)Rb * (unsigned)u.K + (unsigned)sC[i]) * 2u;
    }
}

#define G8_SA(b, h) (((b) * 2 + (h)) * HTB)
#define G8_SB(b, h) ((4 + (b) * 2 + (h)) * HTB)
#define G8_GLL(gp, lp) __builtin_amdgcn_global_load_lds((const unsigned*)(gp), (LAS unsigned*)(lp), 16, 0, 0)
#define G8_STAGE(bufoff, gbase, v0, v1) do { G8_GLL(wsb + (unsigned)((gbase) + (v0)), lds + (bufoff) + ldsw); G8_GLL(wsb + (unsigned)((gbase) + (v1)), lds + (bufoff) + ldsw + 8192); } while (0)
#define G8_LDA(dst, b, h) do { _Pragma("unroll") for (int m = 0; m < 4; ++m) _Pragma("unroll") for (int k = 0; k < 2; ++k) dst[m][k] = *(const LAS bf16x8*)(lds + G8_SA(b, h) + aoff + m * 2048 + k * 1024); } while (0)
#define G8_LDB(dst, b, h) do { _Pragma("unroll") for (int n = 0; n < 2; ++n) _Pragma("unroll") for (int k = 0; k < 2; ++k) dst[n][k] = *(const LAS bf16x8*)(lds + G8_SB(b, h) + boff + n * 2048 + k * 1024); } while (0)
#define G8_MMA(ai, bj, At, Bt) do { __builtin_amdgcn_s_setprio(1); _Pragma("unroll") for (int m = 0; m < 4; ++m) _Pragma("unroll") for (int n = 0; n < 2; ++n) _Pragma("unroll") for (int k = 0; k < 2; ++k) \
        acc[ai][bj][m][n] = __builtin_amdgcn_mfma_f32_16x16x32_bf16(Bt[n][k], At[m][k], acc[ai][bj][m][n], 0, 0, 0); __builtin_amdgcn_s_setprio(0); } while (0)
#define G8_WAIT_V(n) asm volatile("s_waitcnt vmcnt(" #n ")" ::: "memory")
#define G8_WAIT_L(n) asm volatile("s_waitcnt lgkmcnt(" #n ")" ::: "memory")
#define G8_BAR __builtin_amdgcn_s_barrier()
#define G8_SCHED __builtin_amdgcn_sched_barrier(0)

template <bool PERM, bool GATHER, class Sched, class Epi>
__device__ __forceinline__ void gemm_stream(LAS unsigned char* lds, const char* wsb, const Sched& S, const Epi& E) {
    const int tid = threadIdx.x, wid = __builtin_amdgcn_readfirstlane(tid >> 6), lane = tid & 63, wr = wid >> 2, wc = wid & 3, fr = lane & 15, fq = lane >> 4;
    int sR[2], sC[2];
#pragma unroll
    for (int i = 0; i < 2; ++i) stage_rc(tid * 16 + i * 8192, sR[i], sC[i]);
    const unsigned ldsw = (unsigned)wid * 1024u;
    const int aoff = lds_byte(wr * 64 + fr, fq * 8), boff = lds_byte(wc * 32 + fr, fq * 8);
    Unit cur, nxt; int ui = 0;
    if (!S.next(0, cur)) return;
    f32x4 acc[2][2][4][2];
#pragma unroll
    for (int a = 0; a < 2; ++a)
#pragma unroll
        for (int b = 0; b < 2; ++b)
#pragma unroll
            for (int m = 0; m < 4; ++m)
#pragma unroll
                for (int n = 0; n < 2; ++n) acc[a][b][m][n] = (f32x4){0.f, 0.f, 0.f, 0.f};
    bf16x8 At[4][2], B0[2][2], B1[2][2];
    unsigned cvA[2][2], cvB[2], nvA[2][2], nvB[2];
    mk_off<PERM, GATHER>(cur, sR, sC, cvA, cvB);
    constexpr int H1 = GATHER ? 1 : 0;
    unsigned cA = cur.A, cB = cur.B; unsigned chB = (unsigned)HALF * cur.K * 2; unsigned chA = GATHER ? 0u : (unsigned)HALF * cur.lda;
    const unsigned kstep = (unsigned)(BK * 2);
    G8_STAGE(G8_SB(0, 0), cB, cvB[0], cvB[1]); G8_STAGE(G8_SA(0, 0), cA, cvA[0][0], cvA[0][1]); G8_STAGE(G8_SB(0, 1), cB + chB, cvB[0], cvB[1]); G8_STAGE(G8_SA(0, 1), cA + chA, cvA[H1][0], cvA[H1][1]);
    if (wr == 1) G8_BAR;
    G8_WAIT_V(4); G8_BAR;
    G8_STAGE(G8_SB(1, 0), cB + kstep, cvB[0], cvB[1]); G8_STAGE(G8_SA(1, 0), cA + kstep, cvA[0][0], cvA[0][1]); G8_STAGE(G8_SB(1, 1), cB + chB + kstep, cvB[0], cvB[1]);
    G8_WAIT_V(6); G8_BAR;
    for (;;) {
        const bool has_next = S.next(ui + 1, nxt);
        if (!has_next) nxt = cur;
        mk_off<PERM, GATHER>(nxt, sR, sC, nvA, nvB);
        const unsigned nA = nxt.A, nB = nxt.B; const unsigned nhB = (unsigned)HALF * nxt.K * 2; const unsigned nhA = GATHER ? 0u : (unsigned)HALF * nxt.lda;
        const int nt = cur.K / BK;
        for (int t = 0; t < nt; t += 2) {
            const bool last = (t == nt - 2);
            const unsigned a1 = cA + (unsigned)(t + 1) * kstep;
            const unsigned a2 = last ? nA : cA + (unsigned)(t + 2) * kstep, b2 = last ? nB : cB + (unsigned)(t + 2) * kstep;
            const unsigned a3 = a2 + kstep, b3 = b2 + kstep;
            const unsigned hB2 = last ? nhB : chB, hA2 = last ? nhA : chA;
            G8_LDB(B0, 0, 0); G8_SCHED; G8_LDA(At, 0, 0); G8_STAGE(G8_SA(1, 1), a1 + chA, cvA[H1][0], cvA[H1][1]);
            if (last) {
#pragma unroll
                for (int i = 0; i < 2; ++i) { cvA[0][i] = nvA[0][i]; cvA[1][i] = nvA[1][i]; cvB[i] = nvB[i]; }
            }
            G8_WAIT_L(8); G8_BAR; G8_WAIT_L(0); G8_MMA(0, 0, At, B0); G8_BAR; G8_SCHED;
            G8_LDB(B1, 0, 1); G8_STAGE(G8_SB(0, 0), b2, cvB[0], cvB[1]);
            G8_BAR; G8_WAIT_L(0); G8_MMA(0, 1, At, B1); G8_BAR;
            G8_LDA(At, 0, 1); G8_STAGE(G8_SA(0, 0), a2, cvA[0][0], cvA[0][1]);
            G8_BAR; G8_WAIT_L(0); G8_MMA(1, 0, At, B0); G8_BAR; G8_SCHED;
            G8_STAGE(G8_SB(0, 1), b2 + hB2, cvB[0], cvB[1]);
            G8_WAIT_V(6); G8_BAR; G8_MMA(1, 1, At, B1); G8_BAR;
            G8_LDB(B0, 1, 0); G8_SCHED; G8_LDA(At, 1, 0); G8_STAGE(G8_SA(0, 1), a2 + hA2, cvA[H1][0], cvA[H1][1]);
            G8_WAIT_L(8); G8_BAR; G8_WAIT_L(0); G8_MMA(0, 0, At, B0); G8_BAR; G8_SCHED;
            G8_LDB(B1, 1, 1); G8_STAGE(G8_SB(1, 0), b3, cvB[0], cvB[1]);
            G8_BAR; G8_WAIT_L(0); G8_MMA(0, 1, At, B1); G8_BAR;
            G8_LDA(At, 1, 1); G8_STAGE(G8_SA(1, 0), a3, cvA[0][0], cvA[0][1]);
            G8_BAR; G8_WAIT_L(0); G8_MMA(1, 0, At, B0); G8_BAR; G8_SCHED;
            G8_STAGE(G8_SB(1, 1), b3 + hB2, cvB[0], cvB[1]);
            G8_WAIT_V(6); G8_BAR; G8_MMA(1, 1, At, B1); G8_BAR;
        }
        E(acc, cur, wr, wc, fr, fq);
        if (!has_next) break;
#pragma unroll
        for (int a = 0; a < 2; ++a)
#pragma unroll
            for (int b = 0; b < 2; ++b)
#pragma unroll
                for (int m = 0; m < 4; ++m)
#pragma unroll
                    for (int n = 0; n < 2; ++n) acc[a][b][m][n] = (f32x4){0.f, 0.f, 0.f, 0.f};
        cur = nxt; cA = nA; cB = nB; chB = nhB; chA = nhA; ++ui;
    }
    G8_WAIT_V(0);
    if (wr == 0) G8_BAR;
    G8_BAR;
}
}

using g8::f32x4; using g8::u32x4; using g8::Unit;
namespace at { constexpr float QSCALE_ = 0.08838834764831845f * 1.4426950408889634f; }
#define ACC_T const f32x4 (&acc)[2][2][4][2]

struct SchedStd {
    unsigned A, B; int lda, K, nM, nN, G, c;
    __device__ __forceinline__ bool next(int i, Unit& u) const {
        const int L = i * G + c; if (L >= nM * nN) return false;
        int pm, pn; g8::tile_of(L, nM, nN, pm, pn);
        u.A = A + (unsigned)pm * 256u * (unsigned)lda; u.B = B + (unsigned)pn * 256u * (unsigned)K * 2u; u.gidx = nullptr; u.gcnt = 0; u.lda = lda; u.K = K; u.tag = 0; u.pm = pm; u.pn = pn;
        return true;
    }
};
struct EpiBf16 {
    bf16_t* O; int ldc;
    __device__ __forceinline__ void operator()(ACC_T, const Unit& u, int wr, int wc, int fr, int fq) const {
        const int row0 = u.pm * 256 + wr * 64 + fr, col0 = u.pn * 256 + wc * 32 + 8 * fq;
#pragma unroll
        for (int ai = 0; ai < 2; ++ai)
#pragma unroll
            for (int m = 0; m < 4; ++m) {
                bf16_t* rowp = O + (size_t)(row0 + ai * 128 + m * 16) * ldc + col0;
#pragma unroll
                for (int bj = 0; bj < 2; ++bj) {
                    const f32x4 v0 = acc[ai][bj][m][0], v1 = acc[ai][bj][m][1];
                    u32x4 w; w.x = g8::cvt_pk_bf16(v0[0], v0[1]); w.y = g8::cvt_pk_bf16(v0[2], v0[3]); w.z = g8::cvt_pk_bf16(v1[0], v1[1]); w.w = g8::cvt_pk_bf16(v1[2], v1[3]);
                    *(u32x4*)(rowp + bj * 128) = w;
                }
            }
    }
};
struct EpiResid {
    const float* src; float* dst;
    __device__ __forceinline__ void operator()(ACC_T, const Unit& u, int wr, int wc, int fr, int fq) const {
        const int row0 = u.pm * 256 + wr * 64 + fr, col0 = u.pn * 256 + wc * 32 + 4 * fq;
#pragma unroll
        for (int ai = 0; ai < 2; ++ai)
#pragma unroll
            for (int m = 0; m < 4; ++m) {
                const size_t ro = (size_t)(row0 + ai * 128 + m * 16) * D + col0;
#pragma unroll
                for (int bj = 0; bj < 2; ++bj)
#pragma unroll
                    for (int n = 0; n < 2; ++n) {
                        const f32x4 sv = *(const f32x4*)(src + ro + bj * 128 + n * 16);
                        *(f32x4*)(dst + ro + bj * 128 + n * 16) = sv + acc[ai][bj][m][n];
                    }
            }
    }
};
struct EpiSwiglu {
    bf16_t* Hd; int ldh;
    __device__ __forceinline__ void operator()(ACC_T, const Unit& u, int wr, int wc, int fr, int fq) const {
        const int row0 = u.pm * 256 + wr * 64 + fr, col0 = u.pn * 128 + wc * 16 + 4 * fq;
#pragma unroll
        for (int ai = 0; ai < 2; ++ai)
#pragma unroll
            for (int m = 0; m < 4; ++m) {
                bf16_t* rowp = Hd + (size_t)(row0 + ai * 128 + m * 16) * ldh + col0;
#pragma unroll
                for (int bj = 0; bj < 2; ++bj) {
                    const f32x4 g = acc[ai][bj][m][0], uu = acc[ai][bj][m][1];
                    float hv[4];
#pragma unroll
                    for (int j = 0; j < 4; ++j) hv[j] = g[j] / (1.f + __expf(-g[j])) * uu[j];
                    uint2 w; w.x = g8::cvt_pk_bf16(hv[0], hv[1]); w.y = g8::cvt_pk_bf16(hv[2], hv[3]);
                    *(uint2*)(rowp + bj * 64) = w;
                }
            }
    }
};

struct EpiProj {
    bf16_t* O; bf16_t* VT;
    __device__ __forceinline__ void operator()(ACC_T, const Unit& u, int wr, int wc, int fr, int fq) const {
        const int pn = u.pn;
        const bool isV = (pn == 4 || pn == 5 || pn == 10 || pn == 11);
        const int row0 = u.pm * 256 + wr * 64 + fr;
        if (!isV) {
            const float sc = (pn < 2 || pn == 6 || pn == 7) ? at::QSCALE_ : 1.f;
            const int col0 = pn * 256 + wc * 32 + 8 * fq;
#pragma unroll
            for (int ai = 0; ai < 2; ++ai)
#pragma unroll
                for (int m = 0; m < 4; ++m) {
                    bf16_t* rowp = O + (size_t)(row0 + ai * 128 + m * 16) * PC + col0;
#pragma unroll
                    for (int bj = 0; bj < 2; ++bj) {
                        const f32x4 v0 = acc[ai][bj][m][0] * sc, v1 = acc[ai][bj][m][1] * sc;
                        u32x4 w; w.x = g8::cvt_pk_bf16(v0[0], v0[1]); w.y = g8::cvt_pk_bf16(v0[2], v0[3]); w.z = g8::cvt_pk_bf16(v1[0], v1[1]); w.w = g8::cvt_pk_bf16(v1[2], v1[3]);
                        *(u32x4*)(rowp + bj * 128) = w;
                    }
                }
        } else {
            const int type = pn >= 10 ? 1 : 0, hp = (pn & 1) * 2, d0 = wc * 32 + 8 * fq;
#pragma unroll
            for (int ai = 0; ai < 2; ++ai)
#pragma unroll
                for (int m = 0; m < 4; ++m) {
                    const int row = row0 + ai * 128 + m * 16; const int b = row >> 13, sq = row & (S - 1);
#pragma unroll
                    for (int bj = 0; bj < 2; ++bj) {
                        bf16_t* base = VT + ((size_t)((type * 16 + b * 4 + hp + bj) * 128 + d0)) * S + sq;
#pragma unroll
                        for (int n = 0; n < 2; ++n)
#pragma unroll
                            for (int j = 0; j < 4; ++j) base[(size_t)(4 * n + j) * S] = f2bf(acc[ai][bj][m][n][j]);
                    }
                }
        }
    }
};

__device__ __forceinline__ void phase_proj_main(const Ctx& c, int layer, LAS unsigned char* lds) {
    SchedStd S{(unsigned)WS_XN, (unsigned)(WS_WB + layer * WB_LAYER + WB_IN), D * 2, D, R / 256, PC / 256, (int)gridDim.x, (int)blockIdx.x};
    EpiProj E{c.PROJ(), (bf16_t*)(c.a->ws + WS_VT)};
    g8::gemm_stream<true, false>(lds, (const char*)c.a->ws, S, E);
}
__device__ __forceinline__ void phase_resid_main(const Ctx& c, const float* src, unsigned A, int lda_bytes, unsigned Bt, int K, LAS unsigned char* lds) {
    SchedStd S{A, Bt, lda_bytes, K, R / 256, D / 256, (int)gridDim.x, (int)blockIdx.x};
    EpiResid E{src, c.out()};
    g8::gemm_stream<false, false>(lds, (const char*)c.a->ws, S, E);
}
__device__ __forceinline__ void phase_ffn_up_main(const Ctx& c, LAS unsigned char* lds) {
    SchedStd S{(unsigned)WS_XN, (unsigned)WS_WGU, D * 2, D, R / 256, 2 * DFF / 256, (int)gridDim.x, (int)blockIdx.x};
    EpiSwiglu E{c.PROJ(), DFF};
    g8::gemm_stream<true, false>(lds, (const char*)c.a->ws, S, E);
}

struct SchedMerge {
    unsigned WB; int G, c;
    __device__ __forceinline__ bool next(int i, Unit& u) const {
        const int ti = i / 6, sub = i - ti * 6, j = sub >> 1;
        const int L = ti * G + c; if (L >= (R / 256) * (D / 256)) return false;
        int pm, pn; g8::tile_of(L, R / 256, D / 256, pm, pn);
        if ((sub & 1) == 0) { u.A = (unsigned)WS_XN + (unsigned)pm * 256u * (D * 2); u.lda = D * 2; u.K = D; u.B = WB + (unsigned)WB_G + ((unsigned)j * D + (unsigned)pn * 256u) * D * 2; }
        else {
            const int acol = j == 0 ? C_FQ : j == 1 ? C_SQ : C_LG;
            u.A = (unsigned)WS_PROJ + (unsigned)pm * 256u * (PC * 2) + acol * 2; u.lda = PC * 2; u.K = 512;
            u.B = WB + (unsigned)(j == 0 ? WB_FO : j == 1 ? WB_SO : WB_LO) + (unsigned)pn * 256u * 512 * 2;
        }
        u.gidx = nullptr; u.gcnt = 0; u.tag = sub; u.pm = pm; u.pn = pn;
        return true;
    }
};
struct EpiMerge {
    bf16_t* G; bf16_t* MRG; const float* bgate;
    __device__ __forceinline__ void operator()(ACC_T, const Unit& u, int wr, int wc, int fr, int fq) const {
        const int lr0 = wr * 64 + fr, lc0 = wc * 32 + 8 * fq;
        const int j = u.tag >> 1;
#pragma unroll
        for (int ai = 0; ai < 2; ++ai)
#pragma unroll
            for (int m = 0; m < 4; ++m)
#pragma unroll
                for (int bj = 0; bj < 2; ++bj) {
                    const int lr = lr0 + ai * 128 + m * 16, lc = lc0 + bj * 128;
                    const f32x4 v0 = acc[ai][bj][m][0], v1 = acc[ai][bj][m][1];
                    bf16_t* gp = G + lr * 256 + lc;
                    if ((u.tag & 1) == 0) {
                        const float* bp = bgate + j * D + u.pn * 256 + lc;
                        const f32x4 b0 = *(const f32x4*)bp, b1 = *(const f32x4*)(bp + 4);
                        float s[8];
#pragma unroll
                        for (int q = 0; q < 4; ++q) { s[q] = 1.f / (1.f + __expf(-(v0[q] + b0[q]))); s[4 + q] = 1.f / (1.f + __expf(-(v1[q] + b1[q]))); }
                        u32x4 w; w.x = g8::cvt_pk_bf16(s[0], s[1]); w.y = g8::cvt_pk_bf16(s[2], s[3]); w.z = g8::cvt_pk_bf16(s[4], s[5]); w.w = g8::cvt_pk_bf16(s[6], s[7]);
                        *(u32x4*)gp = w;
                    } else {
                        const u32x4 gw = *(const u32x4*)gp;
                        bf16_t* mp = MRG + (size_t)(u.pm * 256 + lr) * PC + u.pn * 256 + lc;
                        float o[8];
                        o[0] = bflo(gw.x) * v0[0]; o[1] = bfhi(gw.x) * v0[1]; o[2] = bflo(gw.y) * v0[2]; o[3] = bfhi(gw.y) * v0[3];
                        o[4] = bflo(gw.z) * v1[0]; o[5] = bfhi(gw.z) * v1[1]; o[6] = bflo(gw.w) * v1[2]; o[7] = bfhi(gw.w) * v1[3];
                        if (u.tag > 1) {
                            const u32x4 pw = *(const u32x4*)mp;
                            o[0] += bflo(pw.x); o[1] += bfhi(pw.x); o[2] += bflo(pw.y); o[3] += bfhi(pw.y);
                            o[4] += bflo(pw.z); o[5] += bfhi(pw.z); o[6] += bflo(pw.w); o[7] += bfhi(pw.w);
                        }
                        u32x4 w; w.x = g8::cvt_pk_bf16(o[0], o[1]); w.y = g8::cvt_pk_bf16(o[2], o[3]); w.z = g8::cvt_pk_bf16(o[4], o[5]); w.w = g8::cvt_pk_bf16(o[6], o[7]);
                        *(u32x4*)mp = w;
                    }
                    __builtin_amdgcn_sched_barrier(0);
                }
    }
};
__device__ __forceinline__ void phase_merge_main(const Ctx& c, int layer, LAS unsigned char* lds) {
    SchedMerge S{(unsigned)(WS_WB + layer * WB_LAYER), (int)gridDim.x, (int)blockIdx.x};
    EpiMerge E{(bf16_t*)(c.a->ws + WS_GSCR + (size_t)blockIdx.x * 131072), c.PROJ() + C_MRG, c.b_gate() + layer * 3 * D};
    g8::gemm_stream<true, false>(lds, (const char*)c.a->ws, S, E);
}

struct MoeMap { int ebase[9]; int cnt[8]; };
__device__ __forceinline__ void moe_map(const Ctx& c, MoeMap& m) {
    int acc = 0;
#pragma unroll
    for (int e = 0; e < 8; ++e) { m.cnt[e] = c.CNT()[e]; m.ebase[e] = acc; acc += (m.cnt[e] + 255) & ~255; }
    m.ebase[8] = acc;
}
constexpr int LDS_MOETAB = 131072 + 64;
struct SchedMoe {
    const LAS int* tab; unsigned Asrc, W; const int* LIST; int chunk, nrt, nct, G, c, up;
    __device__ __forceinline__ bool next(int i, Unit& u) const {
        const int L = i * G + c; if (L >= nrt * nct) return false;
        const int rt = L % nrt, ct = L / nrt;
        const int e = tab[rt * 4 + 0], pos0 = tab[rt * 4 + 1], gc = tab[rt * 4 + 2];
        if (up) {
            u.A = Asrc; u.lda = D * 2; u.K = D; u.gidx = LIST + (size_t)e * R + pos0; u.gcnt = gc;
            u.B = W + (unsigned)e * (2 * DFE) * D * 2 + (unsigned)ct * 256u * D * 2; u.pm = rt; u.pn = ct;
        } else {
            u.A = Asrc + (unsigned)rt * 256u * (DFE * 2); u.lda = DFE * 2; u.K = DFE; u.gidx = nullptr; u.gcnt = 0;
            u.B = W + (unsigned)e * D * DFE * 2 + (unsigned)ct * 256u * DFE * 2; u.pm = chunk * (MOE_CH / 256) + rt; u.pn = ct;
        }
        u.tag = 0;
        return true;
    }
};
__device__ __forceinline__ int moe_table(const Ctx& c, int chunk, LAS unsigned char* lds) {
    LAS int* tab = (LAS int*)(lds + LDS_MOETAB);
    MoeMap m; moe_map(c, m);
    int n = (m.ebase[8] - chunk * MOE_CH) / 256; n = n < 0 ? 0 : (n > MOE_CH / 256 ? MOE_CH / 256 : n);
    __syncthreads();
    if (c.tid < MOE_CH / 256) {
        const int slot0 = chunk * MOE_CH + c.tid * 256;
        int e = 0;
#pragma unroll
        for (int k = 1; k < 8; ++k) if (slot0 >= m.ebase[k]) e = k;
        int eb = 0, ec = 0;
#pragma unroll
        for (int k = 0; k < 8; ++k) if (k == e) { eb = m.ebase[k]; ec = m.cnt[k]; }
        tab[c.tid * 4 + 0] = e; tab[c.tid * 4 + 1] = slot0 - eb; tab[c.tid * 4 + 2] = ec - (slot0 - eb);
    }
    __syncthreads();
    return __builtin_amdgcn_readfirstlane(n);
}
__device__ __forceinline__ void phase_moe_up(const Ctx& c, int chunk, LAS unsigned char* lds) {
    const int nrt = moe_table(c, chunk, lds);
    SchedMoe S{(const LAS int*)(lds + LDS_MOETAB), (unsigned)WS_XN, (unsigned)WS_MOE_GU, c.LIST(), chunk, nrt, 2 * DFE / 256, (int)gridDim.x, (int)blockIdx.x, 1};
    EpiSwiglu E{c.HIDC(), DFE};
    g8::gemm_stream<true, true>(lds, (const char*)c.a->ws, S, E);
}
__device__ __forceinline__ void phase_moe_down(const Ctx& c, int chunk, LAS unsigned char* lds) {
    const int nrt = moe_table(c, chunk, lds);
    SchedMoe S{(const LAS int*)(lds + LDS_MOETAB), (unsigned)(WS_PROJ + WS_HIDC_OFF), (unsigned)WS_MOE_D, c.LIST(), chunk, nrt, D / 256, (int)gridDim.x, (int)blockIdx.x, 0};
    EpiBf16 E{c.Y(), D};
    g8::gemm_stream<true, false>(lds, (const char*)c.a->ws, S, E);
}

namespace at {
typedef short bf16x8 __attribute__((ext_vector_type(8)));
typedef float f32x16 __attribute__((ext_vector_type(16)));
typedef float f32x4 __attribute__((ext_vector_type(4)));
typedef unsigned u32x2 __attribute__((ext_vector_type(2)));
constexpr int KROW = 272, VROW = 136;
constexpr int L_K = 0, L_V = 2 * 64 * KROW, L_CB = L_V + 2 * 128 * VROW, L_END = L_CB + 2 * 256;
constexpr float LOG2E = 1.4426950408889634f;
constexpr float QSCALE = 0.08838834764831845f * 1.4426950408889634f;
constexpr float SB_EXIT = -152.f;

struct TileRegs { uint4 k[2]; uint4 v[2]; float cb; };

__device__ __forceinline__ void load_tile(TileRegs& t, const char* wsb, int type, int b, int h, int jt, int tid) {
    const unsigned kcol = (unsigned)((type == 0 ? C_FK : C_SK) + h * 128), vcol = (unsigned)((type == 0 ? C_FV : C_SV) + h * 128);
    if (jt >= 0) {
        const unsigned kbase = (unsigned)WS_PROJ + ((unsigned)(b * S + 64 * jt) * PC + kcol) * 2u;
        const unsigned vbase = (unsigned)WS_VT + ((unsigned)((type * 16 + b * 4 + h) * 128) * S + 64u * jt) * 2u;
#pragma unroll
        for (int i = 0; i < 2; ++i) {
            const unsigned id = (unsigned)tid + 512u * i;
            t.k[i] = *(const uint4*)(wsb + (kbase + ((id >> 4) * PC + (id & 15) * 8) * 2u));
            t.v[i] = *(const uint4*)(wsb + (vbase + ((id >> 3) * S + (id & 7) * 8) * 2u));
        }
        t.cb = 0.f;
        if (tid < 64) t.cb = -*(const float*)(wsb + ((unsigned)WS_C + ((unsigned)(b * S + 64 * jt + tid) * 4 + h) * 4u)) * LOG2E;
    } else {
        const unsigned kbase = (unsigned)WS_PROJ + ((unsigned)R * PC + kcol) * 2u, vbase = (unsigned)WS_PROJ + ((unsigned)R * PC + vcol) * 2u;
#pragma unroll
        for (int i = 0; i < 2; ++i) {
            const unsigned id = (unsigned)tid + 512u * i; const unsigned row = id >> 4;
            t.k[i] = make_uint4(0u, 0u, 0u, 0u);
            if (row < NM) t.k[i] = *(const uint4*)(wsb + (kbase + (row * PC + (id & 15) * 8) * 2u));
            const unsigned d = id >> 3, ch = id & 7;
            t.v[i] = make_uint4(0u, 0u, 0u, 0u);
            if (ch < 2) {
                const unsigned vo = vbase + (ch * 8 * PC + d) * 2u;
                unsigned e[8];
#pragma unroll
                for (int q = 0; q < 8; ++q) e[q] = *(const bf16_t*)(wsb + (vo + (unsigned)q * PC * 2u));
                t.v[i] = make_uint4(e[0] | (e[1] << 16), e[2] | (e[3] << 16), e[4] | (e[5] << 16), e[6] | (e[7] << 16));
            }
        }
        t.cb = 0.f;
        if (tid < NM) t.cb = -*(const float*)(wsb + ((unsigned)WS_C + ((unsigned)(R + tid) * 4 + h) * 4u)) * LOG2E;
    }
}
__device__ __forceinline__ void store_tile(const TileRegs& t, LAS unsigned char* lds, int buf, int tid) {
#pragma unroll
    for (int i = 0; i < 2; ++i) {
        const int id = tid + 512 * i;
        *(LAS g8::u32x4*)(lds + L_K + buf * 64 * KROW + (id >> 4) * KROW + (id & 15) * 16) = (g8::u32x4){t.k[i].x, t.k[i].y, t.k[i].z, t.k[i].w};
        LAS unsigned char* vp = lds + L_V + buf * 128 * VROW + (id >> 3) * VROW + (id & 7) * 16;
        *(LAS u32x2*)vp = (u32x2){t.v[i].x, t.v[i].y}; *(LAS u32x2*)(vp + 8) = (u32x2){t.v[i].z, t.v[i].w};
    }
    if (tid < 64) *(LAS float*)(lds + L_CB + buf * 256 + tid * 4) = t.cb;
}

struct WaveState { f32x16 O[4]; float m, l, Rrun; };

template <int TYPE>
__device__ __forceinline__ void tile_compute(WaveState& w, const bf16x8 (&qf)[8], LAS unsigned char* lds, int buf, int lim, int lane, const TileRegs& tr, bool do_store, int tid) {
    const int ql = lane & 31, hi = lane >> 5;
    const LAS unsigned char* Kb = lds + L_K + buf * 64 * KROW + ql * KROW + hi * 16;
    f32x16 s0, s1;
#pragma unroll
    for (int r = 0; r < 16; ++r) { s0[r] = 0.f; s1[r] = 0.f; }
#pragma unroll
    for (int ks = 0; ks < 8; ++ks) {
        const bf16x8 a0 = *(const LAS bf16x8*)(Kb + ks * 32), a1 = *(const LAS bf16x8*)(Kb + 32 * KROW + ks * 32);
        s0 = __builtin_amdgcn_mfma_f32_32x32x16_bf16(a0, qf[ks], s0, 0, 0, 0);
        s1 = __builtin_amdgcn_mfma_f32_32x32x16_bf16(a1, qf[ks], s1, 0, 0, 0);
        if (ks & 1) __builtin_amdgcn_sched_barrier(0);
    }
    if (do_store) store_tile(tr, lds, buf ^ 1, tid);
    __builtin_amdgcn_sched_barrier(0);
    unsigned pk0[8], pk1[8];
    if (TYPE == 0) {
        const LAS float* cb = (const LAS float*)(lds + L_CB + buf * 256) + 4 * hi;
#pragma unroll
        for (int g = 0; g < 4; ++g) {
            const f32x4 c0 = *(const LAS f32x4*)(cb + 8 * g), c1 = *(const LAS f32x4*)(cb + 32 + 8 * g);
#pragma unroll
            for (int j = 0; j < 4; ++j) { s0[4 * g + j] += c0[j]; s1[4 * g + j] += c1[j]; }
        }
        if (lim < 64) {
            const float NEG = -__builtin_inff();
#pragma unroll
            for (int r = 0; r < 16; ++r) {
                const int kap = (r & 3) + 8 * (r >> 2) + 4 * hi;
                if (kap > lim) s0[r] = NEG;
                if (kap + 32 > lim) s1[r] = NEG;
            }
        }
        float pmax = s0[0];
#pragma unroll
        for (int r = 1; r < 16; ++r) pmax = fmaxf(pmax, s0[r]);
#pragma unroll
        for (int r = 0; r < 16; ++r) pmax = fmaxf(pmax, s1[r]);
        pmax = fmaxf(pmax, __shfl_xor(pmax, 32));
        const float mn = fmaxf(w.m, pmax);
        const float alpha = __builtin_amdgcn_exp2f(w.m - mn);
        w.m = mn;
        float ls = 0.f;
#pragma unroll
        for (int r = 0; r < 16; ++r) { s0[r] = __builtin_amdgcn_exp2f(s0[r] - mn); s1[r] = __builtin_amdgcn_exp2f(s1[r] - mn); ls += s0[r] + s1[r]; }
        ls += __shfl_xor(ls, 32);
        w.l = w.l * alpha + ls;
#pragma unroll
        for (int db = 0; db < 4; ++db)
#pragma unroll
            for (int r = 0; r < 16; ++r) w.O[db][r] *= alpha;
    } else {
        float T[8];
#pragma unroll
        for (int kb = 0; kb < 2; ++kb)
#pragma unroll
            for (int g = 0; g < 4; ++g) {
                float mv[4], dv[4];
#pragma unroll
                for (int j = 0; j < 4; ++j) {
                    const int r = 4 * g + j;
                    const float z = kb == 0 ? s0[r] : s1[r];
                    const float e = __builtin_amdgcn_exp2f(-fabsf(z));
                    const float sp = fmaxf(z, 0.f) + __builtin_amdgcn_logf(1.f + e);
                    const int kap = 32 * kb + 8 * g + 4 * hi + j;
                    const bool valid = kap < lim;
                    mv[j] = valid ? -sp : 0.f;
                    dv[j] = valid ? z - sp : -__builtin_inff();
                }
                const float e2 = mv[3], e1 = e2 + mv[2], e0 = e1 + mv[1];
                T[4 * kb + g] = e0 + mv[0];
                dv[2] += e2; dv[1] += e1; dv[0] += e0;
#pragma unroll
                for (int j = 0; j < 4; ++j) { if (kb == 0) s0[4 * g + j] = dv[j]; else s1[4 * g + j] = dv[j]; }
            }
        float PT[8], Tp[8];
#pragma unroll
        for (int u = 0; u < 8; ++u) { Tp[u] = __shfl_xor(T[u], 32); PT[u] = T[u] + Tp[u]; }
        float run = w.Rrun;
#pragma unroll
        for (int u = 7; u >= 0; --u) {
            const float base = run + (hi == 0 ? Tp[u] : 0.f);
#pragma unroll
            for (int j = 0; j < 4; ++j) {
                const int r = 4 * (u & 3) + j;
                if (u < 4) s0[r] = __builtin_amdgcn_exp2f(s0[r] + base); else s1[r] = __builtin_amdgcn_exp2f(s1[r] + base);
            }
            run += PT[u];
        }
        w.Rrun = run;
    }
    __builtin_amdgcn_sched_barrier(0);
#pragma unroll
    for (int i = 0; i < 8; ++i) { pk0[i] = g8::cvt_pk_bf16(s0[2 * i], s0[2 * i + 1]); pk1[i] = g8::cvt_pk_bf16(s1[2 * i], s1[2 * i + 1]); }
    __builtin_amdgcn_sched_barrier(0);
    const LAS unsigned char* Vb = lds + L_V + buf * 128 * VROW + ql * VROW + hi * 8;
#pragma unroll
    for (int db = 0; db < 4; ++db) {
#pragma unroll
        for (int kb = 0; kb < 2; ++kb)
#pragma unroll
            for (int sl = 0; sl < 2; ++sl) {
                const LAS unsigned char* vp = Vb + db * 32 * VROW + (32 * kb + 16 * sl) * 2;
                const u32x2 v0 = *(const LAS u32x2*)vp, v1 = *(const LAS u32x2*)(vp + 16);
                const g8::u32x4 av = {v0[0], v0[1], v1[0], v1[1]};
                g8::u32x4 bv;
                if (kb == 0) bv = (g8::u32x4){pk0[4 * sl], pk0[4 * sl + 1], pk0[4 * sl + 2], pk0[4 * sl + 3]};
                else         bv = (g8::u32x4){pk1[4 * sl], pk1[4 * sl + 1], pk1[4 * sl + 2], pk1[4 * sl + 3]};
                w.O[db] = __builtin_amdgcn_mfma_f32_32x32x16_bf16(__builtin_bit_cast(bf16x8, av), __builtin_bit_cast(bf16x8, bv), w.O[db], 0, 0, 0);
            }
        __builtin_amdgcn_sched_barrier(0);
    }
}

template <int TYPE>
__device__ __forceinline__ void qblock(char* wsb, LAS unsigned char* lds, int b, int h, int qb, int tid) {
    const int lane = tid & 63, wv = __builtin_amdgcn_readfirstlane(tid >> 6), ql = lane & 31, hi = lane >> 5;
    const int qcol = (TYPE == 0 ? C_FQ : C_SQ) + h * 128;
    const unsigned qoff = (unsigned)WS_PROJ + ((unsigned)(b * S + 256 * qb + 32 * wv + ql) * PC + qcol + hi * 8) * 2u;
    bf16x8 qf[8];
#pragma unroll
    for (int ks = 0; ks < 8; ++ks) qf[ks] = *(const bf16x8*)(wsb + (qoff + ks * 32));
    WaveState w;
#pragma unroll
    for (int db = 0; db < 4; ++db)
#pragma unroll
        for (int r = 0; r < 16; ++r) w.O[db][r] = 0.f;
    w.m = -1e30f; w.l = 0.f; w.Rrun = 0.f;
    const int ntile = 4 * qb + 4 + 1;
    const int jd = 4 * qb + (wv >> 1);
    const int dlim = 32 * (wv & 1) + ql;
    TileRegs tr;
    __syncthreads();
    load_tile(tr, wsb, TYPE, b, h, TYPE == 0 ? -1 : 4 * qb + 3, tid);
    store_tile(tr, lds, 0, tid);
    __syncthreads();
    for (int i = 0; i < ntile; ++i) {
        const int jt = TYPE == 0 ? i - 1 : (i == ntile - 1 ? -1 : 4 * qb + 3 - i);
        int tz = tid; asm volatile("" : "+v"(tz));
        const int lz = tz & 63;
        const bool more = i + 1 < ntile;
        if (more) { const int jn = TYPE == 0 ? i : (i + 1 == ntile - 1 ? -1 : 4 * qb + 2 - i); load_tile(tr, wsb, TYPE, b, h, jn, tz); }
        if (jt < 0) tile_compute<TYPE>(w, qf, lds, i & 1, TYPE == 0 ? NM - 1 : NM, lz, tr, more, tz);
        else if (jt <= jd) tile_compute<TYPE>(w, qf, lds, i & 1, jt < jd ? 64 : dlim, lz, tr, more, tz);
        else if (more) store_tile(tr, lds, (i + 1) & 1, tz);
        if (TYPE == 1) { if (__syncthreads_and(w.Rrun < SB_EXIT)) break; }
        else __syncthreads();
    }
    const float inv = TYPE == 0 ? 1.f / w.l : 1.f;
    int tz = tid; asm volatile("" : "+v"(tz));
    const unsigned ooff = (unsigned)WS_PROJ + ((unsigned)(b * S + 256 * qb + 32 * wv + (tz & 31)) * PC + qcol + ((tz >> 5) & 1) * 4) * 2u;
#pragma unroll
    for (int db = 0; db < 4; ++db)
#pragma unroll
        for (int g = 0; g < 4; ++g) {
            uint2 o; o.x = g8::cvt_pk_bf16(w.O[db][4 * g] * inv, w.O[db][4 * g + 1] * inv); o.y = g8::cvt_pk_bf16(w.O[db][4 * g + 2] * inv, w.O[db][4 * g + 3] * inv);
            *(uint2*)(wsb + (ooff + (32 * db + 8 * g) * 2)) = o;
        }
}
}

__device__ __forceinline__ void phase_attn_main(const Ctx& c, LAS unsigned char* lds) {
    char* wsb = (char*)c.a->ws;
    for (int it = blockIdx.x; it < 256; it += gridDim.x) {
        const int bh = it >> 4, qb = it & 15;
        at::qblock<0>(wsb, lds, bh >> 2, bh & 3, 31 - qb, c.tid);
        at::qblock<0>(wsb, lds, bh >> 2, bh & 3, qb, c.tid);
    }
    for (int it = blockIdx.x; it < 512; it += gridDim.x) {
        const int bh = it >> 5, qb = it & 31;
        at::qblock<1>(wsb, lds, bh >> 2, bh & 3, qb, c.tid);
    }
    __syncthreads();
}

struct CvtJob { const float* src; bf16_t* dst; int ldw, K, N, mode; };
__device__ __forceinline__ void cvt_tiles(const CvtJob& j, int& base, float* tile  , int tid) {
    const int nk = j.K / 64, nn = j.N / 64, nt = nk * nn;
    const int G = gridDim.x;
    int first = ((int)blockIdx.x - base % G + G) % G;
    for (int t = first; t < nt; t += G) {
        const int kt = t % nk, ntile = t / nk;
        const int k0 = kt * 64, n0 = ntile * 64;
        __syncthreads();
        {
            const int n = tid & 63, kb = tid >> 6;
#pragma unroll
            for (int i = 0; i < 8; ++i) { const int k = kb + 8 * i; tile[k * 65 + n] = j.src[(size_t)(k0 + k) * j.ldw + n0 + n]; }
        }
        __syncthreads();
        {
            const int k2 = (tid & 31) * 2, nb = tid >> 5;
#pragma unroll
            for (int i = 0; i < 4; ++i) {
                const int n = nb + 16 * i; const int ng = n0 + n;
                const int row = j.mode == 0 ? ng : (8 * (ng >> 2) + (ng & 3) + (j.mode == 2 ? 4 : 0));
                *(unsigned*)(j.dst + (size_t)row * j.K + k0 + k2) = pack2(tile[k2 * 65 + n], tile[(k2 + 1) * 65 + n]);
            }
        }
    }
    base += nt;
}
__device__ __forceinline__ void phase_cvt_dense(const Ctx& c) {
    int base = 0; float* tile = c.smem; unsigned char* ws = c.a->ws;
#pragma unroll 1
    for (int l = 0; l < 2; ++l) {
        const float* win = c.w_in() + (size_t)l * D * INC; unsigned char* wb = ws + WS_WB + l * WB_LAYER;
        cvt_tiles(CvtJob{win, (bf16_t*)(wb + WB_IN), INC, D, 1536, 0}, base, tile, c.tid);
        cvt_tiles(CvtJob{win + 1540, (bf16_t*)(wb + WB_IN) + (size_t)1536 * D, INC, D, 2560, 0}, base, tile, c.tid);
        cvt_tiles(CvtJob{win + WI_GATES, (bf16_t*)(wb + WB_G), INC, D, 3 * D, 0}, base, tile, c.tid);
        cvt_tiles(CvtJob{c.w_fox_o() + (size_t)l * 512 * D, (bf16_t*)(wb + WB_FO), D, 512, D, 0}, base, tile, c.tid);
        cvt_tiles(CvtJob{c.w_sb_o() + (size_t)l * 512 * D, (bf16_t*)(wb + WB_SO), D, 512, D, 0}, base, tile, c.tid);
        cvt_tiles(CvtJob{c.w_lru_o() + (size_t)l * 512 * D, (bf16_t*)(wb + WB_LO), D, 512, D, 0}, base, tile, c.tid);
        cvt_tiles(CvtJob{c.w_out() + (size_t)l * D * D, (bf16_t*)(wb + WB_OUT), D, D, D, 0}, base, tile, c.tid);
    }
    cvt_tiles(CvtJob{c.ffn_wg(), (bf16_t*)(ws + WS_WGU), DFF, D, DFF, 1}, base, tile, c.tid);
    cvt_tiles(CvtJob{c.ffn_wu(), (bf16_t*)(ws + WS_WGU), DFF, D, DFF, 2}, base, tile, c.tid);
    cvt_tiles(CvtJob{c.ffn_wd(), (bf16_t*)(ws + WS_WD), D, DFF, D, 0}, base, tile, c.tid);
}
__device__ __forceinline__ void phase_cvt_moe(const Ctx& c) {
    int base = 0; float* tile = c.smem; unsigned char* ws = c.a->ws;
#pragma unroll 1
    for (int e = 0; e < NE; ++e) {
        cvt_tiles(CvtJob{c.moe_wg() + (size_t)e * D * DFE, (bf16_t*)(ws + WS_MOE_GU) + (size_t)e * 2 * DFE * D, DFE, D, DFE, 1}, base, tile, c.tid);
        cvt_tiles(CvtJob{c.moe_wu() + (size_t)e * D * DFE, (bf16_t*)(ws + WS_MOE_GU) + (size_t)e * 2 * DFE * D, DFE, D, DFE, 2}, base, tile, c.tid);
        cvt_tiles(CvtJob{c.moe_wd() + (size_t)e * DFE * D, (bf16_t*)(ws + WS_MOE_D) + (size_t)e * D * DFE, D, DFE, D, 0}, base, tile, c.tid);
    }
}

__device__ __forceinline__ void phase_final(const Ctx& c) {
    MoeMap m; moe_map(c, m);
    const int lane = c.lane;
    for (int rr = blockIdx.x * 8 + c.wave; rr < R; rr += gridDim.x * 8) {
        const int p0 = c.PAIR()[(size_t)rr * 2], p1 = c.PAIR()[(size_t)rr * 2 + 1];
        const float w0 = c.TOPW()[(size_t)rr * 2], w1 = c.TOPW()[(size_t)rr * 2 + 1];
        int b0 = 0, b1 = 0;
#pragma unroll
        for (int k = 0; k < 8; ++k) { if (k == (p0 >> 20)) b0 = m.ebase[k]; if (k == (p1 >> 20)) b1 = m.ebase[k]; }
        const bf16_t* y0 = c.Y() + (size_t)(b0 + (p0 & 0xFFFFF)) * D;
        const bf16_t* y1 = c.Y() + (size_t)(b1 + (p1 & 0xFFFFF)) * D;
        float* hrow = c.out() + (size_t)rr * D;
        float v[16];
        float ss = 0.f;
#pragma unroll
        for (int i = 0; i < 4; ++i) {
            const float4 t = *(const float4*)(hrow + i * 256 + lane * 4);
            const uint2 a = *(const uint2*)(y0 + i * 256 + lane * 4), bq = *(const uint2*)(y1 + i * 256 + lane * 4);
            v[4 * i] = t.x + w0 * bflo(a.x) + w1 * bflo(bq.x); v[4 * i + 1] = t.y + w0 * bfhi(a.x) + w1 * bfhi(bq.x);
            v[4 * i + 2] = t.z + w0 * bflo(a.y) + w1 * bflo(bq.y); v[4 * i + 3] = t.w + w0 * bfhi(a.y) + w1 * bfhi(bq.y);
        }
#pragma unroll
        for (int k = 0; k < 16; ++k) ss += v[k] * v[k];
        ss = wave_sum(ss);
        const float rstd = rsqrtf(ss * (1.f / D) + RMS_EPS);
#pragma unroll
        for (int i = 0; i < 4; ++i) {
            const float4 g = *(const float4*)(c.g_final() + i * 256 + lane * 4);
            float4 o; o.x = v[4 * i] * rstd * g.x; o.y = v[4 * i + 1] * rstd * g.y; o.z = v[4 * i + 2] * rstd * g.z; o.w = v[4 * i + 3] * rstd * g.w;
            *(float4*)(hrow + i * 256 + lane * 4) = o;
        }
    }
}

constexpr int N_PHASES = 27;
constexpr int LDS_BYTES = 147456;
__global__ void __launch_bounds__(NTHR, 2) fwd(Args args) {
    extern __shared__ __attribute__((aligned(16))) unsigned char lds[];
    Ctx c; c.a = &args;
    c.smem = (float*)lds;
    c.tid = threadIdx.x; c.lane = c.tid & 63; c.wave = __builtin_amdgcn_readfirstlane(c.tid >> 6);

    if (c.tid < 4) ((unsigned*)(lds + 131072))[c.tid] = 0u;
    __syncthreads();
    const int lo = args.ph_lo, hi = args.ph_hi;
    XcdBarrier bar; bar.bar = (unsigned*)(args.ws + WS_BAR); bar.x = 0; bar.st = (volatile LAS unsigned*)(lds + 131072);
    if (hi - lo > 1) bar = xcd_barrier_post((unsigned*)(args.ws + WS_BAR), (volatile LAS unsigned*)(lds + 131072));
#define IN(k) (lo <= (k) && (k) < hi)
#define SEAM(k) do { if (IN(k) && IN((k) + 1)) xcd_barrier(bar); } while (0)

    LAS unsigned char* L = (LAS unsigned char*)lds;
    if (IN(0)) { phase_cvt_dense(c); phase_norm(c, 0, 0); }
    SEAM(0);
    if (IN(1)) { side_cumsum(c); phase_proj_main(c, 0, L); phase_proj(c, 0); }
    SEAM(1);
    if (IN(2)) { phase_attn_main(c, L); phase_attn(c, 0); }
    SEAM(2);
    if (IN(3)) phase_lru(c, 0, 1);
    SEAM(3);
    if (IN(4)) { phase_merge_main(c, 0, L); phase_merge(c, 0); }
    SEAM(4);
    if (IN(5)) { phase_resid_main(c, c.x(), (unsigned)(WS_PROJ + C_MRG * 2), PC * 2, (unsigned)(WS_WB + WB_OUT), D, L); phase_resid_gemm(c, 0, 1, c.PROJ() + C_MRG, PC, c.w_out(), D); }
    SEAM(5);
    if (IN(6)) phase_norm(c, 0, 1);
    SEAM(6);
    if (IN(7)) { phase_ffn_up_main(c, L); phase_ffn_up(c); }
    SEAM(7);
    if (IN(8)) { phase_resid_main(c, c.out(), (unsigned)WS_PROJ, DFF * 2, (unsigned)WS_WD, DFF, L); phase_resid_gemm(c, 0, 0, c.PROJ(), DFF, c.ffn_wd(), DFF); }
    SEAM(8);
    if (IN(9)) phase_norm(c, 1, 0);
    SEAM(9);
    if (IN(10)) { side_cumsum(c); phase_proj_main(c, 1, L); phase_proj(c, 1); }
    SEAM(10);
    if (IN(11)) { phase_attn_main(c, L); phase_attn(c, 1); }
    SEAM(11);
    if (IN(12)) phase_lru(c, 1, 1);
    SEAM(12);
    if (IN(13)) { phase_merge_main(c, 1, L); phase_merge(c, 1); }
    SEAM(13);
    if (IN(14)) { phase_resid_main(c, c.out(), (unsigned)(WS_PROJ + C_MRG * 2), PC * 2, (unsigned)(WS_WB + WB_LAYER + WB_OUT), D, L); phase_resid_gemm(c, 1, 0, c.PROJ() + C_MRG, PC, c.w_out() + (size_t)D * D, D); }
    SEAM(14);
    if (IN(15)) { phase_cvt_moe(c); phase_norm(c, 1, 1); }
    SEAM(15);
#pragma unroll 1
    for (int ch = 0; ch < MOE_NCH; ++ch) {
        if (IN(16 + 2 * ch)) phase_moe_up(c, ch, L);
        SEAM(16 + 2 * ch);
        if (IN(17 + 2 * ch)) phase_moe_down(c, ch, L);
        SEAM(17 + 2 * ch);
    }
    if (IN(26)) phase_final(c);
}

extern "C" void kernel_launch(void* const* d_in, const int* in_sizes, int n_in, void* d_out, int out_size, void* d_ws, size_t ws_size, hipStream_t stream) {
    static int grid = 0;
    if (grid == 0) {
        if (n_in != 26 || out_size != R * D || ws_size < WS_END) { fprintf(stderr, "kernel_launch: unexpected problem (n_in %d out %d ws %zu)\n", n_in, out_size, ws_size); grid = -1; return; }
        int dev = 0, cus = 0, per_cu = 0;
        if (hipGetDevice(&dev) != hipSuccess || hipDeviceGetAttribute(&cus, hipDeviceAttributeMultiprocessorCount, dev) != hipSuccess) { grid = -1; return; }
        if (hipFuncSetAttribute((const void*)fwd, hipFuncAttributeMaxDynamicSharedMemorySize, LDS_BYTES) != hipSuccess) { grid = -1; return; }
        if (hipOccupancyMaxActiveBlocksPerMultiprocessor(&per_cu, (const void*)fwd, NTHR, LDS_BYTES) != hipSuccess || per_cu < 1) { fprintf(stderr, "occupancy query: %d\n", per_cu); }
        (void)hipGetLastError();
        grid = cus;
    }
    if (grid < 0) return;
    (void)hipMemsetAsync(d_ws, 0, WS_ZERO_BYTES, stream);
    Args a{};
    for (int i = 0; i < 26; ++i) a.in[i] = (const float*)d_in[i];
    a.out = (float*)d_out; a.ws = (unsigned char*)d_ws;
#if N_LAUNCH_MODE == 1
    a.ph_lo = 0; a.ph_hi = N_PHASES;
    hipLaunchKernelGGL(fwd, dim3(grid), dim3(NTHR), LDS_BYTES, stream, a);
#else
    for (int p = 0; p < N_PHASES; ++p) {
        a.ph_lo = p; a.ph_hi = p + 1;
        hipLaunchKernelGGL(fwd, dim3(grid), dim3(NTHR), LDS_BYTES, stream, a);
    }
#endif
}
```

```cpp
#include <hip/hip_runtime.h>
#include <cstdio>
#include <cstdint>


typedef unsigned short bf16_t;
#define LAS __attribute__((address_space(3)))

constexpr int D = 1024, NB = 4, S = 8192, NM = 16, R = NB * S, RT = R + NM;
constexpr int INC = 7172;
constexpr int PC = 4096;
constexpr int C_FQ = 0, C_FK = 512, C_FV = 1024, C_SQ = 1536, C_SK = 2048, C_SV = 2560, C_LX = 3072, C_LG = 3584, C_MRG = 512;
constexpr int WI_GATES = 4100;
constexpr int DFF = 2816, DFE = 3584, NE = 8;
constexpr int LCH = 128, NLC = S / LCH;
constexpr int MOE_CH = 16384;
constexpr int MOE_NCH = 5;
constexpr int NTHR = 512;
constexpr float RMS_EPS = 1e-6f;

constexpr size_t MiB = 1ull << 20;
constexpr size_t WS_BAR = 0;
constexpr size_t WS_CNT = 16384;
constexpr size_t WS_KPART = 16384 + 1024;
constexpr size_t WS_FOXQ = 16384 + 2048;
constexpr size_t WS_ZERO_BYTES = 16384 + 4096;
constexpr size_t WS_HMETA = 32768;
constexpr size_t WS_SSQ = 262144;
constexpr size_t WS_SSQM = 262144 + 524288;
constexpr size_t WS_LF = 1 * MiB;
constexpr size_t WS_C = 2 * MiB;
constexpr size_t WS_SUMP = 3 * MiB;
constexpr size_t WS_SUME = 4 * MiB + 65536;
constexpr size_t WS_CARRY = 5 * MiB + 131072;
constexpr size_t WS_LIST = 6 * MiB + 262144;
constexpr size_t WS_PAIR = 7 * MiB + 524288;
constexpr size_t WS_TOPW = 7 * MiB + 786432;
constexpr size_t WS_XN = 8 * MiB;
constexpr size_t WS_PROJ = 73 * MiB;
constexpr size_t WS_HIDC_OFF = 0;
constexpr size_t WS_Y_OFF = 112 * MiB;
constexpr size_t WS_WB = 331 * MiB;
constexpr size_t WB_LAYER = 19 * MiB, WB_IN = 0, WB_G = 8 * MiB, WB_FO = 14 * MiB, WB_SO = 15 * MiB, WB_LO = 16 * MiB, WB_OUT = 17 * MiB;
constexpr size_t WS_WGU = 369 * MiB;
constexpr size_t WS_WD = 380 * MiB;
constexpr size_t WS_GSCR = 400 * MiB;
constexpr size_t WS_VT = 432 * MiB;
constexpr size_t WS_MOE_GU = 331 * MiB;
constexpr size_t WS_MOE_D = 443 * MiB;
constexpr size_t WS_END = 499 * MiB;

__device__ __forceinline__ float bf2f(bf16_t v) { return __uint_as_float(((unsigned)v) << 16); }
__device__ __forceinline__ float bflo(unsigned v) { return __uint_as_float(v << 16); }
__device__ __forceinline__ float bfhi(unsigned v) { return __uint_as_float(v & 0xFFFF0000u); }
__device__ __forceinline__ bf16_t f2bf(float f) { unsigned u = __float_as_uint(f); u += 0x7FFFu + ((u >> 16) & 1u); return (bf16_t)(u >> 16); }
__device__ __forceinline__ unsigned pack2(float a, float b) { return (unsigned)f2bf(a) | ((unsigned)f2bf(b) << 16); }
__device__ __forceinline__ void lds_barrier() { asm volatile("s_waitcnt lgkmcnt(0)" ::: "memory"); __builtin_amdgcn_s_barrier(); asm volatile("" ::: "memory"); }
__device__ __forceinline__ float wave_sum(float v) {
#pragma unroll
    for (int o = 32; o; o >>= 1) v += __shfl_xor(v, o);
    return v;
}
__device__ __forceinline__ float wave_max(float v) {
#pragma unroll
    for (int o = 32; o; o >>= 1) v = fmaxf(v, __shfl_xor(v, o));
    return v;
}
__device__ __forceinline__ float sigmoidf_(float x) { return 1.f / (1.f + expf(-x)); }
__device__ __forceinline__ float softplusf_(float x) { return fmaxf(x, 0.f) + log1pf(expf(-fabsf(x))); }
__device__ __forceinline__ float logsigf_(float x) { return fminf(x, 0.f) - log1pf(expf(-fabsf(x))); }
__device__ __forceinline__ float gelu_tanh(float x) { return 0.5f * x * (1.f + tanhf(0.7978845608028654f * (x + 0.044715f * x * x * x))); }

#define XB_TMO      128
#define XB_XCNT(j)  (256  + 64 * (j))
#define XB_XSUB(j)  (1280 + 64 * (j))
#define XB_XGEN(j)  (2304 + 64 * (j))
#define XB_TOP      3328
#define XB_TOPGEN   3392
#define XCD_BAR_WORDS 3456
#define XB_SPIN_CAP (1u << 24)
__device__ __forceinline__ unsigned xb_ld(unsigned* p)              { return __hip_atomic_load(p, __ATOMIC_RELAXED, __HIP_MEMORY_SCOPE_AGENT); }
__device__ __forceinline__ unsigned xb_add(unsigned* p, unsigned v) { return __hip_atomic_fetch_add(p, v, __ATOMIC_RELAXED, __HIP_MEMORY_SCOPE_AGENT); }
__device__ __forceinline__ unsigned xb_xcc_id() { return (unsigned)__builtin_amdgcn_s_getreg((3 << 11) | 20) & 0xFu; }
#define XB_SPIN(cond, bar) do { unsigned _sp = 0; while (cond) { __builtin_amdgcn_s_sleep(1); \
    if ((++_sp & 255u) == 0u) { if (xb_ld(&(bar)[XB_TMO])) break; if (_sp > XB_SPIN_CAP) { atomicAdd(&(bar)[XB_TMO], 1u); break; } } } } while (0)
struct XcdBarrier { unsigned* bar; unsigned x; volatile LAS unsigned* st; };
__device__ __forceinline__ XcdBarrier xcd_barrier_post(unsigned* bar, volatile LAS unsigned* st) {
    XcdBarrier b; b.bar = bar; b.x = xb_xcc_id(); b.st = st;
    if (threadIdx.x == 0) (void)xb_add(&bar[XB_XCNT(b.x)], 1u);
    return b;
}
__device__ __forceinline__ void xcd_barrier_complete(unsigned* bar, unsigned x, unsigned& nloc, unsigned& nx) {
    const unsigned G = gridDim.x * gridDim.y * gridDim.z;
    unsigned sum, cnt, mine, sp = 0u;
    for (;;) {
        sum = 0u; cnt = 0u; mine = 0u;
#pragma unroll
        for (unsigned j = 0; j < 16; ++j) { const unsigned c = xb_ld(&bar[XB_XCNT(j)]); sum += c; cnt += (c > 0u) ? 1u : 0u; mine = (j == x) ? c : mine; }
        if (sum == G) break;
        __builtin_amdgcn_s_sleep(1);
        if ((++sp & 255u) == 0u) { if (xb_ld(&bar[XB_TMO])) break; if (sp > XB_SPIN_CAP) { atomicAdd(&bar[XB_TMO], 1u); break; } }
    }
    nloc = mine > 0u ? mine : 1u; nx = cnt > 0u ? cnt : 1u;
}
__device__ __forceinline__ void xcd_barrier(const XcdBarrier& b) {
    asm volatile("s_waitcnt vmcnt(0)" ::: "memory");
    __syncthreads();
    if (threadIdx.x == 0) {
        unsigned* bar = b.bar;
        __builtin_amdgcn_s_waitcnt(0);
        unsigned nloc = b.st[0], nx = b.st[1];
        if (nloc == 0u) { xcd_barrier_complete(bar, b.x, nloc, nx); b.st[0] = nloc; b.st[1] = nx; }
        const unsigned old = xb_add(&bar[XB_XSUB(b.x)], 1u);
        const unsigned gen = old / nloc;
        if (old + 1u == (gen + 1u) * nloc) {
            __builtin_amdgcn_fence(__ATOMIC_RELEASE, "agent");
            asm volatile("s_waitcnt vmcnt(0)" ::: "memory");
            const unsigned og = xb_add(&bar[XB_TOP], 1u);
            const unsigned tg = og / nx;
            if (og + 1u == (tg + 1u) * nx) xb_add(&bar[XB_TOPGEN], 1u);
            else XB_SPIN(xb_ld(&bar[XB_TOPGEN]) == tg, bar);
            __builtin_amdgcn_fence(__ATOMIC_ACQUIRE, "agent");
            xb_add(&bar[XB_XGEN(b.x)], 1u);
            asm volatile("s_waitcnt vmcnt(0)" ::: "memory");
        } else {
            XB_SPIN(xb_ld(&bar[XB_XGEN(b.x)]) == gen, bar);
            __builtin_amdgcn_fence(__ATOMIC_ACQUIRE, "agent");
            asm volatile("s_waitcnt vmcnt(0)" ::: "memory");
        }
    }
    __syncthreads();
}

struct Args { const float* in[26]; float* out; unsigned char* ws; unsigned phmask; unsigned pad; };

struct Ctx {
    const Args* a; float* smem; int tid, lane, wave;
    __device__ __forceinline__ const float* x() const { return a->in[0]; }
    __device__ __forceinline__ const float* meta() const { return a->in[1]; }
    __device__ __forceinline__ const float* g_mix() const { return a->in[2]; }
    __device__ __forceinline__ const float* w_in() const { return a->in[3]; }
    __device__ __forceinline__ const float* b_forget() const { return a->in[4]; }
    __device__ __forceinline__ const float* b_gate() const { return a->in[5]; }
    __device__ __forceinline__ const float* conv_w() const { return a->in[6]; }
    __device__ __forceinline__ const float* conv_b() const { return a->in[7]; }
    __device__ __forceinline__ const float* wa() const { return a->in[8]; }
    __device__ __forceinline__ const float* ba() const { return a->in[9]; }
    __device__ __forceinline__ const float* wx() const { return a->in[10]; }
    __device__ __forceinline__ const float* bx() const { return a->in[11]; }
    __device__ __forceinline__ const float* lam() const { return a->in[12]; }
    __device__ __forceinline__ const float* w_fox_o() const { return a->in[13]; }
    __device__ __forceinline__ const float* w_sb_o() const { return a->in[14]; }
    __device__ __forceinline__ const float* w_lru_o() const { return a->in[15]; }
    __device__ __forceinline__ const float* w_out() const { return a->in[16]; }
    __device__ __forceinline__ const float* g_ffn() const { return a->in[17]; }
    __device__ __forceinline__ const float* ffn_wg() const { return a->in[18]; }
    __device__ __forceinline__ const float* ffn_wu() const { return a->in[19]; }
    __device__ __forceinline__ const float* ffn_wd() const { return a->in[20]; }
    __device__ __forceinline__ const float* router_w() const { return a->in[21]; }
    __device__ __forceinline__ const float* moe_wg() const { return a->in[22]; }
    __device__ __forceinline__ const float* moe_wu() const { return a->in[23]; }
    __device__ __forceinline__ const float* moe_wd() const { return a->in[24]; }
    __device__ __forceinline__ const float* g_final() const { return a->in[25]; }
    __device__ __forceinline__ float* out() const { return a->out; }
    __device__ __forceinline__ float* hmeta() const { return (float*)(a->ws + WS_HMETA); }
    __device__ __forceinline__ float* LF() const { return (float*)(a->ws + WS_LF); }
    __device__ __forceinline__ float* C() const { return (float*)(a->ws + WS_C); }
    __device__ __forceinline__ float* SUMP() const { return (float*)(a->ws + WS_SUMP); }
    __device__ __forceinline__ float* SUME() const { return (float*)(a->ws + WS_SUME); }
    __device__ __forceinline__ float* CARRY() const { return (float*)(a->ws + WS_CARRY); }
    __device__ __forceinline__ int* LIST() const { return (int*)(a->ws + WS_LIST); }
    __device__ __forceinline__ int* PAIR() const { return (int*)(a->ws + WS_PAIR); }
    __device__ __forceinline__ float* TOPW() const { return (float*)(a->ws + WS_TOPW); }
    __device__ __forceinline__ int* CNT() const { return (int*)(a->ws + WS_CNT); }
    __device__ __forceinline__ bf16_t* XN() const { return (bf16_t*)(a->ws + WS_XN); }
    __device__ __forceinline__ bf16_t* PROJ() const { return (bf16_t*)(a->ws + WS_PROJ); }
    __device__ __forceinline__ bf16_t* HIDC() const { return (bf16_t*)(a->ws + WS_PROJ + WS_HIDC_OFF); }
    __device__ __forceinline__ bf16_t* Y() const { return (bf16_t*)(a->ws + WS_PROJ + WS_Y_OFF); }
};

__device__ __forceinline__ const float* hsrc_row(const Ctx& c, int layer, int rr) {
    if (layer == 0) return rr < R ? c.x() + (size_t)rr * D : c.meta() + (size_t)(rr - R) * D;
    return rr < R ? c.out() + (size_t)rr * D : c.hmeta() + (size_t)(rr - R) * D;
}
__device__ __forceinline__ float* hdst_row(const Ctx& c, int rr) {
    return rr < R ? c.out() + (size_t)rr * D : c.hmeta() + (size_t)(rr - R) * D;
}

__device__ __forceinline__ void norm_load(const float* src, float4 (&nx)[4], int lane) {
#pragma unroll
    for (int i = 0; i < 4; ++i) nx[i] = *(const float4*)(src + i * 256 + lane * 4);
}
__device__ __forceinline__ void norm_take(const float4 (&nx)[4], float (&v)[16]) {
#pragma unroll
    for (int i = 0; i < 4; ++i) { v[4 * i] = nx[i].x; v[4 * i + 1] = nx[i].y; v[4 * i + 2] = nx[i].z; v[4 * i + 3] = nx[i].w; }
}
__device__ __forceinline__ void gain_load(const float* gain, float4 (&gv)[4], int lane) {
#pragma unroll
    for (int i = 0; i < 4; ++i) gv[i] = *(const float4*)(gain + i * 256 + lane * 4);
}
__device__ __forceinline__ void norm_row(const float4 (&gv)[4], bf16_t* dst, float (&v)[16], int lane) {
    float ss = 0.f;
#pragma unroll
    for (int k = 0; k < 16; ++k) ss += v[k] * v[k];
    ss = wave_sum(ss);
    const float rstd = rsqrtf(ss * (1.f / D) + RMS_EPS);
#pragma unroll
    for (int i = 0; i < 4; ++i) {
        const float4 g = gv[i];
        v[4 * i] *= rstd * g.x; v[4 * i + 1] *= rstd * g.y; v[4 * i + 2] *= rstd * g.z; v[4 * i + 3] *= rstd * g.w;
        uint2 o; o.x = pack2(v[4 * i], v[4 * i + 1]); o.y = pack2(v[4 * i + 2], v[4 * i + 3]);
        *(uint2*)(dst + i * 256 + lane * 4) = o;
    }
}
__device__ __forceinline__ void phase_norm(const Ctx& c, int layer, int mode) {
    const int lane = c.lane;
    const float* gain = (mode == 0 ? c.g_mix() : c.g_ffn()) + layer * D;
    float4 gv[4]; gain_load(gain, gv, lane);
    if (mode == 1 && layer == 1) {
        int* lcnt = (int*)c.smem;
        int* ent = lcnt + 16;
        float* entw = (float*)(ent + 512);
        float4* rw = (float4*)(c.smem + 1024);
        __syncthreads();
        for (int idx = c.tid; idx < 2 * D; idx += NTHR) {
            const int col = idx >> 1, h = idx & 1;
            rw[(((col >> 8) * 4 + (col & 3)) * 2 + h) * 64 + ((col >> 2) & 63)] = *(const float4*)(c.router_w() + (size_t)col * 8 + h * 4);
        }
        for (int chunk = blockIdx.x; chunk < R / 128; chunk += gridDim.x) {
            __syncthreads();
            if (c.tid < 16) lcnt[c.tid] = 0;
            __syncthreads();
            float4 nx[4];
            norm_load(c.out() + (size_t)(chunk * 128 + c.wave * 16) * D, nx, lane);
            for (int i = 0; i < 16; ++i) {
                const int lr = c.wave * 16 + i, rr = chunk * 128 + lr;
                float v[16];
                norm_take(nx, v);
                if (i < 15) norm_load(c.out() + (size_t)(rr + 1) * D, nx, lane);
                norm_row(gv, c.XN() + (size_t)rr * D, v, lane);
                float lg[8];
#pragma unroll
                for (int e = 0; e < 8; ++e) lg[e] = 0.f;
#pragma unroll
                for (int q = 0; q < 4; ++q)
#pragma unroll
                    for (int j = 0; j < 4; ++j) {
                        const float4 w0 = rw[((q * 4 + j) * 2) * 64 + lane];
                        const float4 w1 = rw[((q * 4 + j) * 2 + 1) * 64 + lane];
                        const float y = v[4 * q + j];
                        lg[0] += y * w0.x; lg[1] += y * w0.y; lg[2] += y * w0.z; lg[3] += y * w0.w;
                        lg[4] += y * w1.x; lg[5] += y * w1.y; lg[6] += y * w1.z; lg[7] += y * w1.w;
                    }
#pragma unroll
                for (int e = 0; e < 8; ++e) lg[e] = wave_sum(lg[e]);
                int i1 = 0; float v1 = lg[0];
#pragma unroll
                for (int e = 1; e < 8; ++e) if (lg[e] > v1) { v1 = lg[e]; i1 = e; }
                int i2 = -1; float v2 = -3.0e38f;
#pragma unroll
                for (int e = 0; e < 8; ++e) if (e != i1 && lg[e] > v2) { v2 = lg[e]; i2 = e; }
                const float w1 = 1.f / (1.f + expf(v2 - v1)), w2 = 1.f - w1;
                if (lane == 0) {
                    const int r1 = atomicAdd(&lcnt[i1], 1), r2 = atomicAdd(&lcnt[i2], 1);
                    ent[(lr * 2) * 2] = (rr << 3) | i1; ent[(lr * 2) * 2 + 1] = r1; entw[lr * 2] = w1;
                    ent[(lr * 2 + 1) * 2] = (rr << 3) | i2; ent[(lr * 2 + 1) * 2 + 1] = r2; entw[lr * 2 + 1] = w2;
                }
            }
            __syncthreads();
            if (c.tid < 8) lcnt[8 + c.tid] = atomicAdd(&c.CNT()[c.tid], lcnt[c.tid]);
            __syncthreads();
            if (c.tid < 256) {
                const int k = c.tid;
                const int re = ent[k * 2], e = re & 7, rr = re >> 3;
                const int pos = lcnt[8 + e] + ent[k * 2 + 1];
                c.LIST()[(size_t)e * R + pos] = rr;
                c.PAIR()[(size_t)rr * 2 + (k & 1)] = (e << 20) | pos;
                c.TOPW()[(size_t)rr * 2 + (k & 1)] = entw[k];
            }
        }
        return;
    }
    const int nrows = RT;
    float4* wfs = (float4*)c.smem;
    if (mode == 0) {
        const float* wf = c.w_in() + (size_t)layer * D * INC + 1536;
        __syncthreads();
        for (int k = c.tid; k < D; k += NTHR) wfs[((k >> 8) * 4 + (k & 3)) * 64 + ((k >> 2) & 63)] = *(const float4*)(wf + (size_t)k * INC);
        __syncthreads();
    }
    float4 nx[4];
    const float bfg = mode == 0 ? c.b_forget()[layer * 4 + (lane & 3)] : 0.f;
    const int rstep = gridDim.x * 8;
    { const int r0 = blockIdx.x * 8 + c.wave; if (r0 < nrows) norm_load((mode == 0) ? hsrc_row(c, layer, r0) : hdst_row(c, r0), nx, lane); }
    for (int rr = blockIdx.x * 8 + c.wave; rr < nrows; rr += rstep) {
        float v[16];
        norm_take(nx, v);
        if (rr + rstep < nrows) norm_load((mode == 0) ? hsrc_row(c, layer, rr + rstep) : hdst_row(c, rr + rstep), nx, lane);
        norm_row(gv, c.XN() + (size_t)rr * D, v, lane);
        if (mode == 0) {
            float d0 = 0.f, d1 = 0.f, d2 = 0.f, d3 = 0.f;
#pragma unroll
            for (int i = 0; i < 4; ++i)
#pragma unroll
                for (int j = 0; j < 4; ++j) {
                    const float4 w = wfs[(i * 4 + j) * 64 + lane];
                    const float y = v[4 * i + j];
                    d0 += y * w.x; d1 += y * w.y; d2 += y * w.z; d3 += y * w.w;
                }
            d0 = wave_sum(d0); d1 = wave_sum(d1); d2 = wave_sum(d2); d3 = wave_sum(d3);
            if (lane < 4) {
                const float dsel = lane == 0 ? d0 : lane == 1 ? d1 : lane == 2 ? d2 : d3;
                c.LF()[(size_t)rr * 4 + lane] = logsigf_(dsel + bfg);
            }
        }
    }
}

constexpr size_t WS_CT = 131072;
__device__ __forceinline__ void side_cumsum(const Ctx& c) {
    const int lane = c.lane;
    float* CT = (float*)(c.a->ws + WS_CT);
    for (int idx = blockIdx.x * 8 + c.wave; idx < 16 * (S / 64); idx += gridDim.x * 8) {
        const int seq = idx >> 7, chunk = idx & 127, b = seq >> 2, h = seq & 3;
        const size_t rr = (size_t)b * S + 64 * chunk + lane;
        float sc = c.LF()[rr * 4 + h];
#pragma unroll
        for (int o = 1; o < 64; o <<= 1) { const float t = __shfl_up(sc, o); if (lane >= o) sc += t; }
        c.C()[rr * 4 + h] = sc;
        if (lane == 63) CT[seq * 128 + chunk] = sc;
        if (b == 0 && chunk == 0) {
            float v = lane < NM ? c.LF()[(size_t)(R + lane) * 4 + h] : 0.f;
#pragma unroll
            for (int o = 1; o < 16; o <<= 1) { const float t = __shfl_up(v, o); if (lane >= o) v += t; }
            if (lane < NM) c.C()[(size_t)(R + lane) * 4 + h] = v;
        }
    }
}

__device__ __forceinline__ int key_row(int b, int g) { return g < NM ? R + g : b * S + g - NM; }

__device__ __forceinline__ float qk_dot(const float* qs, const bf16_t* kp) {
    float dot = 0.f;
#pragma unroll 4
    for (int dd = 0; dd < 16; ++dd) {
        const uint4 kk = *(const uint4*)(kp + dd * 8);
        const float4 qa = *(const float4*)(qs + dd * 8), qb = *(const float4*)(qs + dd * 8 + 4);
        dot += qa.x * bflo(kk.x) + qa.y * bfhi(kk.x) + qa.z * bflo(kk.y) + qa.w * bfhi(kk.y)
             + qb.x * bflo(kk.z) + qb.y * bfhi(kk.z) + qb.z * bflo(kk.w) + qb.w * bfhi(kk.w);
    }
    return dot;
}

__device__ __forceinline__ void attn_query(const Ctx& c, int type, int rr, int h) {
    const int lane = c.lane;
    int b, pg;
    if (rr < R) { b = rr >> 13; pg = NM + (rr & (S - 1)); } else { b = 0; pg = rr - R; }
    const int cq = type == 0 ? C_FQ : C_SQ, ck = type == 0 ? C_FK : C_SK, cv = type == 0 ? C_FV : C_SV;
    bf16_t* qrow = c.PROJ() + (size_t)rr * PC + cq + h * 128;
    float* q = c.smem + c.wave * 128;
    const float scale = 0.08838834764831845f;
    q[lane] = bf2f(qrow[lane]) * scale; q[lane + 64] = bf2f(qrow[lane + 64]) * scale;
    float a0 = 0.f, a1 = 0.f;
    if (type == 0) {
        float m = -1e30f, l = 0.f;
        const float cqv = c.C()[(size_t)rr * 4 + h];
        const int nk = pg + 1;
        for (int g0 = 0; g0 < nk; g0 += 64) {
            const int g = g0 + lane; const bool valid = g < nk;
            const int krow = key_row(b, valid ? g : 0);
            const float dot = qk_dot(q, c.PROJ() + (size_t)krow * PC + ck + h * 128);
            const float sc = valid ? dot + cqv - c.C()[(size_t)krow * 4 + h] : -__builtin_inff();
            const float mn = fmaxf(m, wave_max(sc));
            const float p = valid ? expf(sc - mn) : 0.f;
            const float alpha = expf(m - mn);
            l = l * alpha + wave_sum(p); a0 *= alpha; a1 *= alpha; m = mn;
            const int cnt = min(64, nk - g0);
            for (int j = 0; j < cnt; ++j) {
                const float pj = __shfl(p, j);
                const int vrow = key_row(b, g0 + j);
                const unsigned vv = *(const unsigned*)(c.PROJ() + (size_t)vrow * PC + cv + h * 128 + lane * 2);
                a0 += pj * bflo(vv); a1 += pj * bfhi(vv);
            }
        }
        const float inv = 1.f / l; a0 *= inv; a1 *= inv;
    } else {
        float Rrun = 0.f;
        for (int gtop = pg - 1; gtop >= 0; gtop -= 64) {
            const int g = gtop - lane; const bool valid = g >= 0;
            const int krow = key_row(b, valid ? g : 0);
            const float z = qk_dot(q, c.PROJ() + (size_t)krow * PC + ck + h * 128);
            const float sp = softplusf_(z);
            const float mval = valid ? -sp : 0.f;
            float sc = mval;
#pragma unroll
            for (int o = 1; o < 64; o <<= 1) { const float t = __shfl_up(sc, o); if (lane >= o) sc += t; }
            const float excl = sc - mval;
            const float p = valid ? expf(z - sp + Rrun + excl) : 0.f;
            const int cnt = min(64, gtop + 1);
            for (int j = 0; j < cnt; ++j) {
                const float pj = __shfl(p, j);
                const int vrow = key_row(b, gtop - j);
                const unsigned vv = *(const unsigned*)(c.PROJ() + (size_t)vrow * PC + cv + h * 128 + lane * 2);
                a0 += pj * bflo(vv); a1 += pj * bfhi(vv);
            }
            Rrun += __shfl(sc, 63);
            if (Rrun < -110.f) break;
        }
    }
    *(unsigned*)(qrow + lane * 2) = pack2(a0, a1);
}

typedef short lru_bf16x8 __attribute__((ext_vector_type(8)));
typedef float lru_f32x16 __attribute__((ext_vector_type(16)));
typedef unsigned lru_u32x4 __attribute__((ext_vector_type(4)));
constexpr int USS = 68;
typedef float cvt_f32x2 __attribute__((ext_vector_type(2)));
typedef __bf16 cvt_bf16x2 __attribute__((ext_vector_type(2)));
__device__ __forceinline__ unsigned lru_cvt_pk(float lo, float hi) { const cvt_f32x2 f = {lo, hi}; return __builtin_bit_cast(unsigned, __builtin_convertvector(f, cvt_bf16x2)); }
__device__ __forceinline__ void split8(const float (&x)[8], lru_bf16x8& hi, lru_bf16x8& lo) {
    unsigned h[4], l[4];
#pragma unroll
    for (int e = 0; e < 4; ++e) {
        h[e] = lru_cvt_pk(x[2 * e], x[2 * e + 1]);
        l[e] = lru_cvt_pk(x[2 * e] - __uint_as_float(h[e] << 16), x[2 * e + 1] - __uint_as_float(h[e] & 0xFFFF0000u));
    }
    const lru_u32x4 hv = {h[0], h[1], h[2], h[3]};
    const lru_u32x4 lv = {l[0], l[1], l[2], l[3]};
    hi = __builtin_bit_cast(lru_bf16x8, hv); lo = __builtin_bit_cast(lru_bf16x8, lv);
}
constexpr int TPT = LCH / 8;
struct LruIn { float x[TPT + 3]; float g[TPT]; float carry; };
struct LruIn2 { float ci[TPT]; };
struct LruCh { float w0, w1, w2, w3, cb, bav, bxv, spl; };
template <bool META>
__device__ __forceinline__ void lru_load(const Ctx& c, int seq, int chunk, int n, int pass, int tid, LruIn& in) {
    const int len = META ? NM : LCH;
    const int gbase = seq == 4 ? 0 : NM + chunk * LCH;
    const int b = seq == 4 ? 0 : seq;
    const int ch = tid & 63, sg = tid >> 6;
    const bf16_t* PROJ = c.PROJ();
#pragma unroll
    for (int k = 0; k < TPT + 3; ++k) {
        const int t = sg * TPT + k - 3; const int g = gbase + t;
        const bool ok = META ? (t < len && g >= 0) : true;
        const float v = bf2f(PROJ[(size_t)key_row(b, ok ? g : 0) * PC + C_LX + n * 64 + ch]);
        in.x[k] = ok ? v : 0.f;
    }
    in.carry = 0.f;
    if (pass == 1) {
#pragma unroll
        for (int tt = 0; tt < TPT; ++tt) { const int t = sg * TPT + tt; const float gv = bf2f(PROJ[(size_t)key_row(b, gbase + (t < len ? t : 0)) * PC + C_LG + n * 64 + ch]); in.g[tt] = t < len ? gv : 0.f; }
        if (seq != 4) in.carry = c.CARRY()[(size_t)(seq * NLC + chunk) * 512 + n * 64 + ch];
    }
}
template <bool META>
__device__ __forceinline__ void lru_item(const Ctx& c, int seq, int chunk, int n, int pass, const LruIn& in, const LruCh& kc, const lru_bf16x8 (&wbh)[4], const lru_bf16x8 (&wbl)[4]) {
    float* us = c.smem;
    float* as_ = us + LCH * USS;
    float* is_ = as_ + LCH * 64;
    float* sgP = is_ + LCH * 64;
    float* sgE = sgP + 8 * 64;
    int tid = threadIdx.x; asm volatile("" : "+v"(tid));
    const int len = META ? NM : LCH;
    const int gbase = seq == 4 ? 0 : NM + chunk * LCH;
    const int b = seq == 4 ? 0 : seq;
    const int ch = tid & 63, sg = tid >> 6;
    const int cidx = n * 64 + ch;
    bf16_t* PROJ = c.PROJ();
    lds_barrier();
    __builtin_amdgcn_sched_barrier(0);
#pragma unroll
    for (int tt = 0; tt < TPT; ++tt) {
        const int t = sg * TPT + tt;
        us[t * USS + ch] = (!META || t < len) ? kc.cb + kc.w0 * in.x[tt] + kc.w1 * in.x[tt + 1] + kc.w2 * in.x[tt + 2] + kc.w3 * in.x[tt + 3] : 0.f;
    }
    lds_barrier();
    __builtin_amdgcn_sched_barrier(0);
    {
        const int wv = tid >> 6, lane = tid & 63, tj = wv & 1, ql = lane & 31, kg = lane >> 5;
        float* dst = (wv >> 2) ? is_ : as_;
#pragma unroll
        for (int tb = 0; tb < LCH / 64; ++tb) {
            const int tq = ((wv >> 1) & 1) + 2 * tb;
            lru_f32x16 acc;
#pragma unroll
            for (int r = 0; r < 16; ++r) acc[r] = 0.f;
            const float* urow = us + (32 * tq + ql) * USS + 8 * kg;
#pragma unroll
            for (int ks = 0; ks < 4; ++ks) {
                const float4 u0 = *(const float4*)(urow + 16 * ks), u1 = *(const float4*)(urow + 16 * ks + 4);
                const float x[8] = {u0.x, u0.y, u0.z, u0.w, u1.x, u1.y, u1.z, u1.w};
                lru_bf16x8 ah, al; split8(x, ah, al);
                acc = __builtin_amdgcn_mfma_f32_32x32x16_bf16(ah, wbh[ks], acc, 0, 0, 0);
                acc = __builtin_amdgcn_mfma_f32_32x32x16_bf16(al, wbh[ks], acc, 0, 0, 0);
                acc = __builtin_amdgcn_mfma_f32_32x32x16_bf16(ah, wbl[ks], acc, 0, 0, 0);
            }
#pragma unroll
            for (int r = 0; r < 16; ++r) dst[(32 * tq + (r & 3) + 8 * (r >> 2) + 4 * kg) * 64 + 32 * tj + ql] = acc[r];
        }
    }
    lds_barrier();
    __builtin_amdgcn_sched_barrier(0);
    float P = 1.f, E = 0.f;
    bf16_t* cp0 = PROJ + (size_t)(b * S + chunk * LCH + sg * TPT) * PC + cidx;
#pragma unroll
    for (int tt = 0; tt < TPT; ++tt) {
        const int t = sg * TPT + tt;
        const float r = __builtin_amdgcn_rcpf(1.f + __builtin_amdgcn_exp2f(-1.4426950408889634f * (as_[t * 64 + ch] + kc.bav)));
        const float gi = __builtin_amdgcn_rcpf(1.f + __builtin_amdgcn_exp2f(-1.4426950408889634f * (is_[t * 64 + ch] + kc.bxv)));
        const float la = -8.f * r * kc.spl;
        const float av = __builtin_amdgcn_exp2f(1.4426950408889634f * la);
        const float a = (!META || t < len) ? av : 1.f;
        const float inp = (!META || t < len) ? __builtin_amdgcn_sqrtf(fmaxf(1.f - av * av, 0.f)) * gi * us[t * USS + ch] : 0.f;
        if (META || pass != 0) { as_[t * 64 + ch] = a; is_[t * 64 + ch] = inp; }
        E = a * E + inp; P *= a;
        if (!META && pass == 0) {
            cp0[(size_t)tt * PC + C_FV] = f2bf(1.f - av); cp0[(size_t)tt * PC + C_SV] = f2bf(inp);
        }
    }
    sgP[sg * 64 + ch] = P; sgE[sg * 64 + ch] = E;
    lds_barrier();
    __builtin_amdgcn_sched_barrier(0);
    const size_t sidx = (size_t)(seq == 4 ? 4 * NLC : seq * NLC + chunk) * 512 + cidx;
    if (pass == 0) {
        if (sg == 0) {
            float Pt = 1.f, Et = 0.f;
#pragma unroll
            for (int q = 0; q < 8; ++q) { const float pq = sgP[q * 64 + ch]; Et = pq * Et + sgE[q * 64 + ch]; Pt *= pq; }
            c.SUMP()[sidx] = Pt; c.SUME()[sidx] = Et;
        }
    } else {
        float hst = in.carry;
#pragma unroll
        for (int q = 0; q < 7; ++q) if (q < sg) hst = sgP[q * 64 + ch] * hst + sgE[q * 64 + ch];
#pragma unroll
        for (int tt = 0; tt < TPT; ++tt) {
            const int t = sg * TPT + tt;
            hst = as_[t * 64 + ch] * hst + is_[t * 64 + ch];
            if (t < len) {
                const float x = in.g[tt];
                const float uarg = 0.7978845608028654f * (x + 0.044715f * x * x * x);
                PROJ[(size_t)key_row(b, gbase + t) * PC + C_LG + cidx] = f2bf(hst * x * __builtin_amdgcn_rcpf(1.f + __builtin_amdgcn_exp2f(-2.885390081777927f * uarg)));
            }
        }
    }
}

__device__ __forceinline__ void lru_loadB(const Ctx& c, int b, int chunk, int n, int tid, LruIn& in, LruIn2& in2) {
    const int ch = tid & 63, sg = tid >> 6;
    const bf16_t* P0 = c.PROJ() + (size_t)(b * S + chunk * LCH + sg * TPT) * PC + n * 64 + ch;
#pragma unroll
    for (int tt = 0; tt < TPT; ++tt) {
        in.x[tt] = bf2f(P0[(size_t)tt * PC + C_FV]);
        in2.ci[tt] = bf2f(P0[(size_t)tt * PC + C_SV]);
        in.g[tt] = bf2f(P0[(size_t)tt * PC + C_LG]);
    }
    in.carry = c.CARRY()[(size_t)(b * NLC + chunk) * 512 + n * 64 + ch];
}
__device__ __forceinline__ void lru_itemB(const Ctx& c, int b, int chunk, int n, const LruIn& in, const LruIn2& in2) {
    float* sgP = c.smem; float* sgE = sgP + 8 * 64;
    int tid = threadIdx.x; asm volatile("" : "+v"(tid));
    const int ch = tid & 63, sg = tid >> 6;
    float P = 1.f, E = 0.f;
#pragma unroll
    for (int tt = 0; tt < TPT; ++tt) { const float a = 1.f - in.x[tt]; E = a * E + in2.ci[tt]; P *= a; }
    lds_barrier();
    sgP[sg * 64 + ch] = P; sgE[sg * 64 + ch] = E;
    lds_barrier();
    float hst = in.carry;
#pragma unroll
    for (int q = 0; q < 7; ++q) if (q < sg) hst = sgP[q * 64 + ch] * hst + sgE[q * 64 + ch];
    bf16_t* O0 = c.PROJ() + (size_t)(b * S + chunk * LCH + sg * TPT) * PC + C_LG + n * 64 + ch;
#pragma unroll
    for (int tt = 0; tt < TPT; ++tt) {
        hst = (1.f - in.x[tt]) * hst + in2.ci[tt];
        const float x = in.g[tt];
        const float uarg = 0.7978845608028654f * (x + 0.044715f * x * x * x);
        O0[(size_t)tt * PC] = f2bf(hst * x * __builtin_amdgcn_rcpf(1.f + __builtin_amdgcn_exp2f(-2.885390081777927f * uarg)));
    }
}

__device__ __forceinline__ void phase_lru(const Ctx& c, int layer, int pass) {
    const int n = blockIdx.x & 7, G8 = gridDim.x >> 3;
    lru_bf16x8 wbh[4], wbl[4];
    LruCh kc;
    {
        const int wv = c.tid >> 6, lane = c.tid & 63, j = 32 * (wv & 1) + (lane & 31), kg = lane >> 5;
        const float* w = ((wv >> 2) ? c.wx() : c.wa()) + ((size_t)layer * 8 + n) * 4096 + j;
#pragma unroll
        for (int ks = 0; ks < 4; ++ks) {
            float x[8];
#pragma unroll
            for (int e = 0; e < 8; ++e) x[e] = w[(16 * ks + 8 * kg + e) * 64];
            split8(x, wbh[ks], wbl[ks]);
        }
        const int cidx = n * 64 + (c.tid & 63);
        const float* cw = c.conv_w() + (size_t)layer * 4 * 512 + cidx;
        kc.w0 = cw[0]; kc.w1 = cw[512]; kc.w2 = cw[1024]; kc.w3 = cw[1536]; kc.cb = c.conv_b()[layer * 512 + cidx];
        kc.bav = c.ba()[layer * 512 + cidx]; kc.bxv = c.bx()[layer * 512 + cidx]; kc.spl = softplusf_(-c.lam()[layer * 512 + cidx]);
    }
    if ((blockIdx.x >> 3) == 0) { LruIn mi; lru_load<true>(c, 4, 0, n, pass, c.tid, mi); lru_item<true>(c, 4, 0, n, pass, mi, kc, wbh, wbl); }
    int j = blockIdx.x >> 3;
    if (pass == 1) {
        LruIn cur, nx1; LruIn2 cur2, nx12;
        if (j < NB * NLC) lru_loadB(c, j / NLC, j % NLC, n, c.tid, cur, cur2);
        { const int j1 = j + G8 < NB * NLC ? j + G8 : j; if (j < NB * NLC) lru_loadB(c, j1 / NLC, j1 % NLC, n, c.tid, nx1, nx12); }
        for (; j < NB * NLC; j += G8) {
            LruIn nx2; LruIn2 nx22;
            const int jn = j + 2 * G8 < NB * NLC ? j + 2 * G8 : j;
            lru_loadB(c, jn / NLC, jn % NLC, n, c.tid, nx2, nx22);
            lru_itemB(c, j / NLC, j % NLC, n, cur, cur2);
            cur = nx1; cur2 = nx12; nx1 = nx2; nx12 = nx22;
        }
    } else {
        LruIn cur;
        if (j < NB * NLC) lru_load<false>(c, j / NLC, j % NLC, n, pass, c.tid, cur);
        for (; j < NB * NLC; j += G8) {
            LruIn nxt;
            const int jn = j + G8 < NB * NLC ? j + G8 : j;
            lru_load<false>(c, jn / NLC, jn % NLC, n, pass, c.tid, nxt);
            lru_item<false>(c, j / NLC, j % NLC, n, pass, cur, kc, wbh, wbl);
            cur = nxt;
        }
    }
    __syncthreads();
}
__device__ __forceinline__ void phase_lru_carry(const Ctx& c) {
    if (blockIdx.x >= 32 || threadIdx.x >= 64) return;
    const int b = blockIdx.x >> 3, ch = (blockIdx.x & 7) * 64 + threadIdx.x;
    const float* Pp = c.SUMP() + (size_t)b * NLC * 512 + ch; const float* Ep = c.SUME() + (size_t)b * NLC * 512 + ch;
    float* Cp = c.CARRY() + (size_t)b * NLC * 512 + ch;
    float hst = c.SUME()[(size_t)(4 * NLC) * 512 + ch];
    for (int c0 = 0; c0 < NLC; c0 += 8) {
        float pv[8], ev[8];
#pragma unroll
        for (int q = 0; q < 8; ++q) { pv[q] = Pp[(size_t)(c0 + q) * 512]; ev[q] = Ep[(size_t)(c0 + q) * 512]; }
#pragma unroll
        for (int q = 0; q < 8; ++q) { Cp[(size_t)(c0 + q) * 512] = hst; hst = pv[q] * hst + ev[q]; }
    }
}

__device__ __forceinline__ void phase_attn(const Ctx& c, int layer) {
    phase_lru(c, layer, 0);
    const int nitems = layer == 1 ? 0 : NM * 8;
    for (int it = blockIdx.x * 8 + c.wave; it < nitems; it += gridDim.x * 8) {
        const int rr = R + it % NM, hh = it / NM;
        attn_query(c, hh >> 2, rr, hh & 3);
    }
}

namespace g8 {
constexpr int BM = 256, BK = 64, HALF = 128, HTB = HALF * BK * 2, STAGE_BYTES = 8 * HTB, NXCD = 8, WGM = 8;
typedef short bf16x8 __attribute__((ext_vector_type(8)));
typedef float f32x4 __attribute__((ext_vector_type(4)));
typedef unsigned u32x4 __attribute__((ext_vector_type(4)));
__device__ __forceinline__ int lds_byte(int r, int c) { const int st = (r >> 4) * 2 + (c >> 5), rr = r & 15, cc = c & 31, ob = rr * 64 + cc * 2; return st * 1024 + (ob ^ (((ob >> 9) & 1) << 5)); }
__device__ __forceinline__ void stage_rc(int b, int& R_, int& C_) { const int st = b / 1024, sb = b % 1024, swz = sb ^ (((sb >> 9) & 1) << 5); R_ = (st >> 1) * 16 + swz / 64; C_ = (st & 1) * 32 + (swz % 64) / 2; }
__device__ __forceinline__ int perm32(int rho) { const int n = rho >> 4, i = rho & 15; return 8 * (i >> 2) + 4 * n + (i & 3); }
__device__ __forceinline__ unsigned cvt_pk_bf16(float lo, float hi) { const cvt_f32x2 f = {lo, hi}; return __builtin_bit_cast(unsigned, __builtin_convertvector(f, cvt_bf16x2)); }

struct Unit {
    unsigned A;
    unsigned B;
    const int* gidx;
    int gcnt;
    int lda;
    int K;
    int tag;
    int pm, pn;
};

__device__ __forceinline__ void tile_of(int L, int nM, int nN, int& pm, int& pn) {
    const int nwg = nM * nN; int wgid = L;
    { const int q = nwg / NXCD, r = nwg % NXCD, xcd = wgid % NXCD, off = wgid / NXCD; wgid = (xcd < r ? xcd * (q + 1) : r * (q + 1) + (xcd - r) * q) + off; }
    const int nig = WGM * nN, gid = wgid / nig, fm = gid * WGM, gsz = (nM - fm) < WGM ? (nM - fm) : WGM;
    pm = fm + ((wgid % nig) % gsz); pn = (wgid % nig) / gsz;
}

template <bool PERM, bool GATHER>
__device__ __forceinline__ void mk_off(const Unit& u, int tid, unsigned (&vA)[2][2], unsigned (&vB)[2]) {
    int sR[2], sC[2];
#pragma unroll
    for (int i = 0; i < 2; ++i) stage_rc(tid * 16 + i * 8192, sR[i], sC[i]);
#pragma unroll
    for (int i = 0; i < 2; ++i) {
        if (GATHER) {
#pragma unroll
            for (int h = 0; h < 2; ++h) { const int r = h * HALF + sR[i]; const int idx = u.gidx[r < u.gcnt ? r : 0]; vA[h][i] = (unsigned)idx * (unsigned)u.lda + (unsigned)sC[i] * 2u; }
        } else {
            vA[0][i] = (unsigned)sR[i] * (unsigned)u.lda + (unsigned)sC[i] * 2u; vA[1][i] = 0u;
        }
        const int Rb = PERM ? ((sR[i] & ~31) + perm32(sR[i] & 31)) : sR[i];
        vB[i] = ((unsigned)Rb * (unsigned)u.K + (unsigned)sC[i]) * 2u;
    }
}

#define G8_SA(b, h) (((b) * 2 + (h)) * HTB)
#define G8_SB(b, h) ((4 + (b) * 2 + (h)) * HTB)
#define G8_GLL(gp, lp) __builtin_amdgcn_global_load_lds((const unsigned*)(gp), (LAS unsigned*)(lp), 16, 0, 0)
#define G8_STAGE(bufoff, gbase, v0, v1) do { G8_GLL(wsb + (unsigned)((gbase) + (v0)), lds + (bufoff) + ldsw); G8_GLL(wsb + (unsigned)((gbase) + (v1)), lds + (bufoff) + ldsw + 8192); } while (0)
#define G8_LDA(dst, b, h) do { _Pragma("unroll") for (int m = 0; m < 4; ++m) _Pragma("unroll") for (int k = 0; k < 2; ++k) dst[m][k] = *(const LAS bf16x8*)(lds + G8_SA(b, h) + aoff + m * 2048 + k * 1024); } while (0)
#define G8_LDB(dst, b, h) do { _Pragma("unroll") for (int n = 0; n < 2; ++n) _Pragma("unroll") for (int k = 0; k < 2; ++k) dst[n][k] = *(const LAS bf16x8*)(lds + G8_SB(b, h) + boff + n * 2048 + k * 1024); } while (0)
#define G8_MMA(ai, bj, At, Bt) do { __builtin_amdgcn_s_setprio(1); _Pragma("unroll") for (int m = 0; m < 4; ++m) _Pragma("unroll") for (int n = 0; n < 2; ++n) _Pragma("unroll") for (int k = 0; k < 2; ++k) \
        acc[ai][bj][m][n] = __builtin_amdgcn_mfma_f32_16x16x32_bf16(Bt[n][k], At[m][k], acc[ai][bj][m][n], 0, 0, 0); __builtin_amdgcn_s_setprio(0); } while (0)
#define G8_WAIT_V(n) asm volatile("s_waitcnt vmcnt(" #n ")" ::: "memory")
#define G8_WAIT_L(n) asm volatile("s_waitcnt lgkmcnt(" #n ")" ::: "memory")
#define G8_BAR __builtin_amdgcn_s_barrier()
#define G8_SCHED __builtin_amdgcn_sched_barrier(0)

template <bool PERM, bool GATHER, class Sched, class Epi>
__device__ __forceinline__ void gemm_stream(LAS unsigned char* lds, const char* wsb, const Sched& S, const Epi& E) {
    int tid = threadIdx.x; asm volatile("" : "+v"(tid));
    const int wid = __builtin_amdgcn_readfirstlane(tid >> 6), lane = tid & 63, wr = wid >> 2, wc = wid & 3, fr = lane & 15, fq = lane >> 4;
    const unsigned ldsw = (unsigned)wid * 1024u;
    const int aoff = lds_byte(wr * 64 + fr, fq * 8), boff = lds_byte(wc * 32 + fr, fq * 8);
    Unit cur, nxt; int ui = 0;
    if (!S.next(0, cur)) return;
    f32x4 acc[2][2][4][2];
#pragma unroll
    for (int a = 0; a < 2; ++a)
#pragma unroll
        for (int b = 0; b < 2; ++b)
#pragma unroll
            for (int m = 0; m < 4; ++m)
#pragma unroll
                for (int n = 0; n < 2; ++n) acc[a][b][m][n] = (f32x4){0.f, 0.f, 0.f, 0.f};
    bf16x8 At[4][2], B0[2][2], B1[2][2];
    unsigned cvA[2][2], cvB[2], nvA[2][2], nvB[2];
    mk_off<PERM, GATHER>(cur, tid, cvA, cvB);
    constexpr int H1 = GATHER ? 1 : 0;
    unsigned cA = cur.A, cB = cur.B; unsigned chB = (unsigned)HALF * cur.K * 2; unsigned chA = GATHER ? 0u : (unsigned)HALF * cur.lda;
    const unsigned kstep = (unsigned)(BK * 2);
    G8_STAGE(G8_SB(0, 0), cB, cvB[0], cvB[1]); G8_STAGE(G8_SA(0, 0), cA, cvA[0][0], cvA[0][1]); G8_STAGE(G8_SB(0, 1), cB + chB, cvB[0], cvB[1]); G8_STAGE(G8_SA(0, 1), cA + chA, cvA[H1][0], cvA[H1][1]);
    if (wr == 1) G8_BAR;
    G8_WAIT_V(4); G8_BAR;
    G8_STAGE(G8_SB(1, 0), cB + kstep, cvB[0], cvB[1]); G8_STAGE(G8_SA(1, 0), cA + kstep, cvA[0][0], cvA[0][1]); G8_STAGE(G8_SB(1, 1), cB + chB + kstep, cvB[0], cvB[1]);
    G8_WAIT_V(6); G8_BAR;
    for (;;) {
        const bool has_next = S.next(ui + 1, nxt);
        if (!has_next) nxt = cur;
        mk_off<PERM, GATHER>(nxt, tid, nvA, nvB);
        const unsigned nA = nxt.A, nB = nxt.B; const unsigned nhB = (unsigned)HALF * nxt.K * 2; const unsigned nhA = GATHER ? 0u : (unsigned)HALF * nxt.lda;
        const int nt = cur.K / BK;
        for (int t = 0; t < nt; t += 2) {
            const bool last = (t == nt - 2);
            const unsigned a1 = cA + (unsigned)(t + 1) * kstep;
            const unsigned a2 = last ? nA : cA + (unsigned)(t + 2) * kstep, b2 = last ? nB : cB + (unsigned)(t + 2) * kstep;
            const unsigned a3 = a2 + kstep, b3 = b2 + kstep;
            const unsigned hB2 = last ? nhB : chB, hA2 = last ? nhA : chA;
            G8_LDB(B0, 0, 0); G8_SCHED; G8_LDA(At, 0, 0); G8_STAGE(G8_SA(1, 1), a1 + chA, cvA[H1][0], cvA[H1][1]);
            if (last) {
#pragma unroll
                for (int i = 0; i < 2; ++i) { cvA[0][i] = nvA[0][i]; cvA[1][i] = nvA[1][i]; cvB[i] = nvB[i]; }
            }
            G8_WAIT_L(8); G8_BAR; G8_WAIT_L(0); G8_MMA(0, 0, At, B0); G8_BAR; G8_SCHED;
            G8_LDB(B1, 0, 1); G8_STAGE(G8_SB(0, 0), b2, cvB[0], cvB[1]);
            G8_BAR; G8_WAIT_L(0); G8_MMA(0, 1, At, B1); G8_BAR;
            G8_LDA(At, 0, 1); G8_STAGE(G8_SA(0, 0), a2, cvA[0][0], cvA[0][1]);
            G8_BAR; G8_WAIT_L(0); G8_MMA(1, 0, At, B0); G8_BAR; G8_SCHED;
            G8_STAGE(G8_SB(0, 1), b2 + hB2, cvB[0], cvB[1]);
            G8_WAIT_V(6); G8_BAR; G8_MMA(1, 1, At, B1); G8_BAR;
            G8_LDB(B0, 1, 0); G8_SCHED; G8_LDA(At, 1, 0); G8_STAGE(G8_SA(0, 1), a2 + hA2, cvA[H1][0], cvA[H1][1]);
            G8_WAIT_L(8); G8_BAR; G8_WAIT_L(0); G8_MMA(0, 0, At, B0); G8_BAR; G8_SCHED;
            G8_LDB(B1, 1, 1); G8_STAGE(G8_SB(1, 0), b3, cvB[0], cvB[1]);
            G8_BAR; G8_WAIT_L(0); G8_MMA(0, 1, At, B1); G8_BAR;
            G8_LDA(At, 1, 1); G8_STAGE(G8_SA(1, 0), a3, cvA[0][0], cvA[0][1]);
            G8_BAR; G8_WAIT_L(0); G8_MMA(1, 0, At, B0); G8_BAR; G8_SCHED;
            G8_STAGE(G8_SB(1, 1), b3 + hB2, cvB[0], cvB[1]);
            G8_WAIT_V(6); G8_BAR; G8_MMA(1, 1, At, B1); G8_BAR;
        }
        E(acc, cur, wr, wc, fr, fq);
        if (!has_next) break;
#pragma unroll
        for (int a = 0; a < 2; ++a)
#pragma unroll
            for (int b = 0; b < 2; ++b)
#pragma unroll
                for (int m = 0; m < 4; ++m)
#pragma unroll
                    for (int n = 0; n < 2; ++n) acc[a][b][m][n] = (f32x4){0.f, 0.f, 0.f, 0.f};
        cur = nxt; cA = nA; cB = nB; chB = nhB; chA = nhA; ++ui;
    }
    G8_WAIT_V(0);
    if (wr == 0) G8_BAR;
    G8_BAR;
}
}

using g8::f32x4; using g8::u32x4; using g8::Unit;
namespace at { constexpr float QSCALE_ = 0.08838834764831845f * 1.4426950408889634f; }
#define ACC_T const f32x4 (&acc)[2][2][4][2]

struct SchedStd {
    unsigned A, B; int lda, K, nM, nN, G, c;
    __device__ __forceinline__ bool next(int i, Unit& u) const {
        const int L = i * G + c; if (L >= nM * nN) return false;
        int pm, pn; g8::tile_of(L, nM, nN, pm, pn);
        u.A = A + (unsigned)pm * 256u * (unsigned)lda; u.B = B + (unsigned)pn * 256u * (unsigned)K * 2u; u.gidx = nullptr; u.gcnt = 0; u.lda = lda; u.K = K; u.tag = 0; u.pm = pm; u.pn = pn;
        return true;
    }
};
struct EpiBf16 {
    bf16_t* O; int ldc;
    __device__ __forceinline__ void operator()(ACC_T, const Unit& u, int wr, int wc, int fr, int fq) const {
        const int row0 = u.pm * 256 + wr * 64 + fr, col0 = u.pn * 256 + wc * 32 + 8 * fq;
#pragma unroll
        for (int ai = 0; ai < 2; ++ai)
#pragma unroll
            for (int m = 0; m < 4; ++m) {
                bf16_t* rowp = O + (size_t)(row0 + ai * 128 + m * 16) * ldc + col0;
#pragma unroll
                for (int bj = 0; bj < 2; ++bj) {
                    const f32x4 v0 = acc[ai][bj][m][0], v1 = acc[ai][bj][m][1];
                    u32x4 w; w.x = g8::cvt_pk_bf16(v0[0], v0[1]); w.y = g8::cvt_pk_bf16(v0[2], v0[3]); w.z = g8::cvt_pk_bf16(v1[0], v1[1]); w.w = g8::cvt_pk_bf16(v1[2], v1[3]);
                    *(u32x4*)(rowp + bj * 128) = w;
                }
            }
    }
};
struct EpiResid {
    const float* src; float* dst;
    __device__ __forceinline__ void operator()(ACC_T, const Unit& u, int wr, int wc, int fr, int fq) const {
        const int row0 = u.pm * 256 + wr * 64 + fr, col0 = u.pn * 256 + wc * 32 + 4 * fq;
        f32x4 sv[2][4];
#pragma unroll
        for (int q = 0; q < 4; ++q) sv[0][q] = *(const f32x4*)(src + (size_t)row0 * D + col0 + (q >> 1) * 128 + (q & 1) * 16);
#pragma unroll
        for (int k = 0; k < 8; ++k) {
            const int ai = k >> 2, m = k & 3;
            if (k < 7) {
                const size_t rn = (size_t)(row0 + ((k + 1) >> 2) * 128 + ((k + 1) & 3) * 16) * D + col0;
#pragma unroll
                for (int q = 0; q < 4; ++q) sv[(k + 1) & 1][q] = *(const f32x4*)(src + rn + (q >> 1) * 128 + (q & 1) * 16);
            }
            const size_t ro = (size_t)(row0 + ai * 128 + m * 16) * D + col0;
#pragma unroll
            for (int q = 0; q < 4; ++q) *(f32x4*)(dst + ro + (q >> 1) * 128 + (q & 1) * 16) = sv[k & 1][q] + acc[ai][q >> 1][m][q & 1];
        }
    }
};
constexpr int LDS_SSQRED = 131072 + 2048;
struct EpiResidNorm {
    const float* src; float* dst; bf16_t* XNo; float* SSQ; LAS float* red;
    __device__ __forceinline__ void operator()(ACC_T, const Unit& u, int wr, int wc, int fr, int fq) const {
        const int row0 = u.pm * 256 + wr * 64 + fr, col0 = u.pn * 256 + wc * 32 + 4 * fq;
        f32x4 sv[2][4];
#pragma unroll
        for (int q = 0; q < 4; ++q) sv[0][q] = *(const f32x4*)(src + (size_t)row0 * D + col0 + (q >> 1) * 128 + (q & 1) * 16);
#pragma unroll
        for (int k = 0; k < 8; ++k) {
            const int ai = k >> 2, m = k & 3;
            if (k < 7) {
                const size_t rn = (size_t)(row0 + ((k + 1) >> 2) * 128 + ((k + 1) & 3) * 16) * D + col0;
#pragma unroll
                for (int q = 0; q < 4; ++q) sv[(k + 1) & 1][q] = *(const f32x4*)(src + rn + (q >> 1) * 128 + (q & 1) * 16);
            }
            const size_t ro = (size_t)(row0 + ai * 128 + m * 16) * D + col0;
            float ss = 0.f;
#pragma unroll
            for (int q = 0; q < 4; ++q) {
                const f32x4 hv = sv[k & 1][q] + acc[ai][q >> 1][m][q & 1];
                *(f32x4*)(dst + ro + (q >> 1) * 128 + (q & 1) * 16) = hv;
                uint2 w; w.x = g8::cvt_pk_bf16(hv[0], hv[1]); w.y = g8::cvt_pk_bf16(hv[2], hv[3]);
                *(uint2*)(XNo + ro + (q >> 1) * 128 + (q & 1) * 16) = w;
                ss += hv[0] * hv[0] + hv[1] * hv[1] + hv[2] * hv[2] + hv[3] * hv[3];
            }
            ss += __shfl_xor(ss, 16); ss += __shfl_xor(ss, 32);
            if (fq == 0) red[(wr * 64 + ai * 128 + m * 16 + fr) * 4 + wc] = ss;
        }
        asm volatile("s_waitcnt lgkmcnt(0)" ::: "memory"); __builtin_amdgcn_s_barrier(); asm volatile("" ::: "memory");
        const int lane = fq * 16 + fr;
        if (lane < 32) {
            const int jj = wc * 32 + lane;
            const int lrow = wr * 64 + (jj >> 6) * 128 + (jj & 63);
            const f32x4 r4 = *(const LAS f32x4*)(red + lrow * 4);
            SSQ[(size_t)(u.pm * 256 + lrow) * 4 + u.pn] = r4[0] + r4[1] + r4[2] + r4[3];
        }
    }
};
struct EpiSwiglu {
    bf16_t* Hd; int ldh; const float* SSQ = nullptr;
    __device__ __forceinline__ void operator()(ACC_T, const Unit& u, int wr, int wc, int fr, int fq) const {
        const int row0 = u.pm * 256 + wr * 64 + fr, col0 = u.pn * 128 + wc * 16 + 4 * fq;
        float rs[8];
#pragma unroll
        for (int k = 0; k < 8; ++k) rs[k] = 1.f;
        if (SSQ) {
            f32x4 q4[8];
#pragma unroll
            for (int k = 0; k < 8; ++k) q4[k] = *(const f32x4*)(SSQ + (size_t)(row0 + (k >> 2) * 128 + (k & 3) * 16) * 4);
#pragma unroll
            for (int k = 0; k < 8; ++k) rs[k] = rsqrtf((q4[k][0] + q4[k][1] + q4[k][2] + q4[k][3]) * (1.f / D) + RMS_EPS);
        }
#pragma unroll
        for (int ai = 0; ai < 2; ++ai)
#pragma unroll
            for (int m = 0; m < 4; ++m) {
                bf16_t* rowp = Hd + (size_t)(row0 + ai * 128 + m * 16) * ldh + col0;
#pragma unroll
                for (int bj = 0; bj < 2; ++bj) {
                    const f32x4 g = acc[ai][bj][m][0] * rs[ai * 4 + m], uu = acc[ai][bj][m][1] * rs[ai * 4 + m];
                    float hv[4];
#pragma unroll
                    for (int j = 0; j < 4; ++j) hv[j] = g[j] * uu[j] * __builtin_amdgcn_rcpf(1.f + __builtin_amdgcn_exp2f(-1.4426950408889634f * g[j]));
                    uint2 w; w.x = g8::cvt_pk_bf16(hv[0], hv[1]); w.y = g8::cvt_pk_bf16(hv[2], hv[3]);
                    *(uint2*)(rowp + bj * 64) = w;
                }
            }
    }
};

struct EpiProj {
    bf16_t* O; bf16_t* VT; unsigned* KP;
    __device__ __forceinline__ void operator()(ACC_T, const Unit& u, int wr, int wc, int fr, int fq) const {
        const int pn = u.pn;
        const bool isV = (pn == 4 || pn == 5 || pn == 10 || pn == 11);
        const int row0 = u.pm * 256 + wr * 64 + fr;
        if (!isV) {
            const float sc = (pn < 2 || pn == 6 || pn == 7) ? at::QSCALE_ : 1.f;
            const int col0 = pn * 256 + wc * 32 + 8 * fq;
            const bool isFK = (pn == 2 || pn == 3);
            float kmx[2] = {0.f, 0.f};
#pragma unroll
            for (int ai = 0; ai < 2; ++ai)
#pragma unroll
                for (int m = 0; m < 4; ++m) {
                    bf16_t* rowp = O + (size_t)(row0 + ai * 128 + m * 16) * PC + col0;
#pragma unroll
                    for (int bj = 0; bj < 2; ++bj) {
                        const f32x4 v0 = acc[ai][bj][m][0] * sc, v1 = acc[ai][bj][m][1] * sc;
                        u32x4 w; w.x = g8::cvt_pk_bf16(v0[0], v0[1]); w.y = g8::cvt_pk_bf16(v0[2], v0[3]); w.z = g8::cvt_pk_bf16(v1[0], v1[1]); w.w = g8::cvt_pk_bf16(v1[2], v1[3]);
                        *(u32x4*)(rowp + bj * 128) = w;
                        if (isFK) {
                            float ss = bflo(w.x) * bflo(w.x) + bfhi(w.x) * bfhi(w.x) + bflo(w.y) * bflo(w.y) + bfhi(w.y) * bfhi(w.y)
                                     + bflo(w.z) * bflo(w.z) + bfhi(w.z) * bfhi(w.z) + bflo(w.w) * bflo(w.w) + bfhi(w.w) * bfhi(w.w);
                            ss += __shfl_xor(ss, 16); ss += __shfl_xor(ss, 32);
                            kmx[bj] = fmaxf(kmx[bj], ss);
                        }
                    }
                }
            if (isFK) {
#pragma unroll
                for (int bj = 0; bj < 2; ++bj) {
                    float v = kmx[bj];
                    v = fmaxf(v, __shfl_xor(v, 1)); v = fmaxf(v, __shfl_xor(v, 2)); v = fmaxf(v, __shfl_xor(v, 4)); v = fmaxf(v, __shfl_xor(v, 8));
                    if (fr == 0 && fq == 0) atomicMax(KP + (((u.pm * 256) >> 13) * 4 + 2 * (pn & 1) + bj) * 4 + wc, __float_as_uint(v));
                }
            }
        } else {
            const int type = pn >= 10 ? 1 : 0, hp = (pn & 1) * 2, d0 = wc * 32 + 8 * fq;
#pragma unroll
            for (int ai = 0; ai < 2; ++ai)
#pragma unroll
                for (int m = 0; m < 4; ++m) {
                    const int row = row0 + ai * 128 + m * 16; const int b = row >> 13, sq = row & (S - 1);
#pragma unroll
                    for (int bj = 0; bj < 2; ++bj) {
                        bf16_t* base = VT + ((size_t)((type * 16 + b * 4 + hp + bj) * 128 + d0)) * S + sq;
#pragma unroll
                        for (int n = 0; n < 2; ++n)
#pragma unroll
                            for (int j = 0; j < 4; ++j) base[(size_t)(4 * n + j) * S] = f2bf(acc[ai][bj][m][n][j]);
                    }
                }
        }
    }
};

__device__ __forceinline__ void phase_proj_main(const Ctx& c, int layer, LAS unsigned char* lds) {
    SchedStd S{(unsigned)WS_XN, (unsigned)(WS_WB + layer * WB_LAYER + WB_IN), D * 2, D, R / 256, PC / 256, (int)gridDim.x, (int)blockIdx.x};
    EpiProj E{c.PROJ(), (bf16_t*)(c.a->ws + WS_VT), (unsigned*)(c.a->ws + WS_KPART)};
    g8::gemm_stream<true, false>(lds, (const char*)c.a->ws, S, E);
}
__device__ __forceinline__ void phase_resid_main(const Ctx& c, const float* src, unsigned A, int lda_bytes, unsigned Bt, int K, LAS unsigned char* lds) {
    SchedStd S{A, Bt, lda_bytes, K, R / 256, D / 256, (int)gridDim.x, (int)blockIdx.x};
    EpiResid E{src, c.out()};
    g8::gemm_stream<false, false>(lds, (const char*)c.a->ws, S, E);
}
__device__ __forceinline__ void phase_resid_norm_main(const Ctx& c, const float* src, unsigned A, int lda_bytes, unsigned Bt, int K, LAS unsigned char* lds) {
    SchedStd S{A, Bt, lda_bytes, K, R / 256, D / 256, (int)gridDim.x, (int)blockIdx.x};
    EpiResidNorm E{src, c.out(), c.XN(), (float*)(c.a->ws + WS_SSQ), (LAS float*)(lds + LDS_SSQRED)};
    g8::gemm_stream<false, false>(lds, (const char*)c.a->ws, S, E);
}
__device__ __forceinline__ void phase_ffn_up_main(const Ctx& c, LAS unsigned char* lds) {
    SchedStd S{(unsigned)WS_XN, (unsigned)WS_WGU, D * 2, D, R / 256, 2 * DFF / 256, (int)gridDim.x, (int)blockIdx.x};
    EpiSwiglu E{c.PROJ(), DFF, (const float*)(c.a->ws + WS_SSQ)};
    g8::gemm_stream<true, false>(lds, (const char*)c.a->ws, S, E);
}

struct SchedMerge {
    unsigned WB; int G, c;
    __device__ __forceinline__ bool next(int i, Unit& u) const {
        const int ti = i / 6, sub = i - ti * 6, j = sub >> 1;
        const int L = ti * G + c; if (L >= (R / 256) * (D / 256)) return false;
        int pm, pn; g8::tile_of(L, R / 256, D / 256, pm, pn);
        if ((sub & 1) == 0) { u.A = (unsigned)WS_XN + (unsigned)pm * 256u * (D * 2); u.lda = D * 2; u.K = D; u.B = WB + (unsigned)WB_G + ((unsigned)j * D + (unsigned)pn * 256u) * D * 2; }
        else {
            const int acol = j == 0 ? C_FQ : j == 1 ? C_SQ : C_LG;
            u.A = (unsigned)WS_PROJ + (unsigned)pm * 256u * (PC * 2) + acol * 2; u.lda = PC * 2; u.K = 512;
            u.B = WB + (unsigned)(j == 0 ? WB_FO : j == 1 ? WB_SO : WB_LO) + (unsigned)pn * 256u * 512 * 2;
        }
        u.gidx = nullptr; u.gcnt = 0; u.tag = sub; u.pm = pm; u.pn = pn;
        return true;
    }
};
struct EpiMerge {
    bf16_t* G; bf16_t* MRG; const float* bgate;
    __device__ __forceinline__ void operator()(ACC_T, const Unit& u, int wr, int wc, int fr, int fq) const {
        const int lr0 = wr * 64 + fr, lc0 = wc * 32 + 8 * fq;
        const int j = u.tag >> 1;
        if ((u.tag & 1) == 0) {
            f32x4 bb[2][2];
#pragma unroll
            for (int bj = 0; bj < 2; ++bj) { const float* bp = bgate + j * D + u.pn * 256 + lc0 + bj * 128; bb[bj][0] = *(const f32x4*)bp; bb[bj][1] = *(const f32x4*)(bp + 4); }
#pragma unroll
            for (int ai = 0; ai < 2; ++ai)
#pragma unroll
                for (int m = 0; m < 4; ++m)
#pragma unroll
                    for (int bj = 0; bj < 2; ++bj) {
                        const int lr = lr0 + ai * 128 + m * 16, lc = lc0 + bj * 128;
                        const f32x4 v0 = acc[ai][bj][m][0], v1 = acc[ai][bj][m][1];
                        const f32x4 b0 = bb[bj][0], b1 = bb[bj][1];
                        float s[8];
#pragma unroll
                        for (int q = 0; q < 4; ++q) { s[q] = __builtin_amdgcn_rcpf(1.f + __builtin_amdgcn_exp2f(-1.4426950408889634f * (v0[q] + b0[q]))); s[4 + q] = __builtin_amdgcn_rcpf(1.f + __builtin_amdgcn_exp2f(-1.4426950408889634f * (v1[q] + b1[q]))); }
                        u32x4 w; w.x = g8::cvt_pk_bf16(s[0], s[1]); w.y = g8::cvt_pk_bf16(s[2], s[3]); w.z = g8::cvt_pk_bf16(s[4], s[5]); w.w = g8::cvt_pk_bf16(s[6], s[7]);
                        *(u32x4*)(G + lr * 256 + lc) = w;
                    }
        } else {
            const char* Gc = (const char*)G; char* Mc = (char*)(MRG + (size_t)u.pm * 256 * PC + u.pn * 256);
            u32x4 gw[2][2], pw[2][2];
            {
                int lz = lr0 * 128 + lc0; asm volatile("" : "+v"(lz));
                const unsigned lr = (unsigned)(lz >> 7), lc = (unsigned)(lz & 127);
                const unsigned go = (lr * 256 + lc) * 2u, mo = (lr * PC + lc) * 2u;
#pragma unroll
                for (int bj = 0; bj < 2; ++bj) {
                    gw[0][bj] = *(const u32x4*)(Gc + (go + bj * 256));
                    pw[0][bj] = (u32x4){0u, 0u, 0u, 0u};
                    if (u.tag > 1) pw[0][bj] = *(const u32x4*)(Mc + (mo + bj * 256));
                }
            }
#pragma unroll
            for (int k = 0; k < 8; ++k) {
                const int ai = k >> 2, m = k & 3;
                int lz = lr0 * 128 + lc0; asm volatile("" : "+v"(lz));
                if (k < 7) {
                    const unsigned lrn = (unsigned)(lz >> 7) + ((k + 1) >> 2) * 128 + ((k + 1) & 3) * 16, lcn = (unsigned)(lz & 127);
                    const unsigned gon = (lrn * 256 + lcn) * 2u, mon = (lrn * PC + lcn) * 2u;
#pragma unroll
                    for (int bj = 0; bj < 2; ++bj) {
                        gw[(k + 1) & 1][bj] = *(const u32x4*)(Gc + (gon + bj * 256));
                        pw[(k + 1) & 1][bj] = (u32x4){0u, 0u, 0u, 0u};
                        if (u.tag > 1) pw[(k + 1) & 1][bj] = *(const u32x4*)(Mc + (mon + bj * 256));
                    }
                }
                const unsigned lr = (unsigned)(lz >> 7) + ai * 128 + m * 16, lc = (unsigned)(lz & 127);
                const unsigned mo = (lr * PC + lc) * 2u;
#pragma unroll
                for (int bj = 0; bj < 2; ++bj) {
                    const u32x4 g4 = gw[k & 1][bj], p4 = pw[k & 1][bj];
                    const f32x4 v0 = acc[ai][bj][m][0], v1 = acc[ai][bj][m][1];
                    float o[8];
                    o[0] = bflo(g4.x) * v0[0] + bflo(p4.x); o[1] = bfhi(g4.x) * v0[1] + bfhi(p4.x);
                    o[2] = bflo(g4.y) * v0[2] + bflo(p4.y); o[3] = bfhi(g4.y) * v0[3] + bfhi(p4.y);
                    o[4] = bflo(g4.z) * v1[0] + bflo(p4.z); o[5] = bfhi(g4.z) * v1[1] + bfhi(p4.z);
                    o[6] = bflo(g4.w) * v1[2] + bflo(p4.w); o[7] = bfhi(g4.w) * v1[3] + bfhi(p4.w);
                    u32x4 w; w.x = g8::cvt_pk_bf16(o[0], o[1]); w.y = g8::cvt_pk_bf16(o[2], o[3]); w.z = g8::cvt_pk_bf16(o[4], o[5]); w.w = g8::cvt_pk_bf16(o[6], o[7]);
                    *(u32x4*)(Mc + (mo + bj * 256)) = w;
                }
            }
        }
    }
};
__device__ __forceinline__ void phase_merge_main(const Ctx& c, int layer, LAS unsigned char* lds) {
    SchedMerge S{(unsigned)(WS_WB + layer * WB_LAYER), (int)gridDim.x, (int)blockIdx.x};
    EpiMerge E{(bf16_t*)(c.a->ws + WS_GSCR + (size_t)blockIdx.x * 131072), c.PROJ() + C_MRG, c.b_gate() + layer * 3 * D};
    g8::gemm_stream<true, false>(lds, (const char*)c.a->ws, S, E);
}

struct MoeMap { int ebase[9]; int cnt[8]; };
__device__ __forceinline__ void moe_map(const Ctx& c, MoeMap& m) {
    int acc = 0;
#pragma unroll
    for (int e = 0; e < 8; ++e) { m.cnt[e] = c.CNT()[e]; m.ebase[e] = acc; acc += (m.cnt[e] + 255) & ~255; }
    m.ebase[8] = acc;
}
constexpr int LDS_MOETAB = 131072 + 64;
struct SchedMoe {
    const LAS int* tab; unsigned Asrc, W; const int* LIST; int chunk, nrt, nct, G, c, up;
    __device__ __forceinline__ bool next(int i, Unit& u) const {
        const int L = i * G + c; if (L >= nrt * nct) return false;
        const int rt = L % nrt, ct = L / nrt;
        const int e = tab[rt * 4 + 0], pos0 = tab[rt * 4 + 1], gc = tab[rt * 4 + 2];
        if (up) {
            u.A = Asrc; u.lda = D * 2; u.K = D; u.gidx = LIST + (size_t)e * R + pos0; u.gcnt = gc;
            u.B = W + (unsigned)e * (2 * DFE) * D * 2 + (unsigned)ct * 256u * D * 2; u.pm = rt; u.pn = ct;
        } else {
            u.A = Asrc + (unsigned)rt * 256u * (DFE * 2); u.lda = DFE * 2; u.K = DFE; u.gidx = nullptr; u.gcnt = 0;
            u.B = W + (unsigned)e * D * DFE * 2 + (unsigned)ct * 256u * DFE * 2; u.pm = chunk * (MOE_CH / 256) + rt; u.pn = ct;
        }
        u.tag = 0;
        return true;
    }
};
__device__ __forceinline__ int moe_table(const Ctx& c, int chunk, LAS unsigned char* lds) {
    LAS int* tab = (LAS int*)(lds + LDS_MOETAB);
    MoeMap m; moe_map(c, m);
    int n = (m.ebase[8] - chunk * MOE_CH) / 256; n = n < 0 ? 0 : (n > MOE_CH / 256 ? MOE_CH / 256 : n);
    __syncthreads();
    if (c.tid < MOE_CH / 256) {
        const int slot0 = chunk * MOE_CH + c.tid * 256;
        int e = 0;
#pragma unroll
        for (int k = 1; k < 8; ++k) if (slot0 >= m.ebase[k]) e = k;
        int eb = 0, ec = 0;
#pragma unroll
        for (int k = 0; k < 8; ++k) if (k == e) { eb = m.ebase[k]; ec = m.cnt[k]; }
        tab[c.tid * 4 + 0] = e; tab[c.tid * 4 + 1] = slot0 - eb; tab[c.tid * 4 + 2] = ec - (slot0 - eb);
    }
    __syncthreads();
    return __builtin_amdgcn_readfirstlane(n);
}
__device__ __forceinline__ void phase_moe_up(const Ctx& c, int chunk, LAS unsigned char* lds) {
    const int nrt = moe_table(c, chunk, lds);
    SchedMoe S{(const LAS int*)(lds + LDS_MOETAB), (unsigned)WS_XN, (unsigned)WS_MOE_GU, c.LIST(), chunk, nrt, 2 * DFE / 256, (int)gridDim.x, (int)blockIdx.x, 1};
    EpiSwiglu E{c.HIDC(), DFE};
    g8::gemm_stream<true, true>(lds, (const char*)c.a->ws, S, E);
}
__device__ __forceinline__ void phase_moe_down(const Ctx& c, int chunk, LAS unsigned char* lds) {
    const int nrt = moe_table(c, chunk, lds);
    SchedMoe S{(const LAS int*)(lds + LDS_MOETAB), (unsigned)(WS_PROJ + WS_HIDC_OFF), (unsigned)WS_MOE_D, c.LIST(), chunk, nrt, D / 256, (int)gridDim.x, (int)blockIdx.x, 0};
    EpiBf16 E{c.Y(), D};
    g8::gemm_stream<true, false>(lds, (const char*)c.a->ws, S, E);
}


namespace fx {
typedef short bf16x8 __attribute__((ext_vector_type(8)));
typedef float f32x16 __attribute__((ext_vector_type(16)));
typedef float f32x4 __attribute__((ext_vector_type(4)));
constexpr int L_K = 0, L_V = 32768, L_CB = 65536, L_CBB = 65536 + 512, L_VOTE = 65536 + 1024, L_END = 65536 + 1024 + 64;
constexpr float LOG2E = 1.4426950408889634f;
constexpr float FOX_THR = 10.f;
__device__ __forceinline__ int swap23(int i) { return (i & ~12) | ((i & 4) << 1) | ((i & 8) >> 1); }

__device__ __forceinline__ void dma_k(const char* wsb, LAS unsigned char* lds, int kbuf, int b, int h, int jt, int tid) {
    const int wv = __builtin_amdgcn_readfirstlane(tid >> 6), lane = tid & 63;
    const unsigned kbase = (unsigned)WS_PROJ + ((unsigned)(b * S + 64 * jt) * PC + (unsigned)(C_FK + h * 128)) * 2u;
#pragma unroll
    for (int i = 0; i < 2; ++i) {
        const int id = (wv * 2 + i) * 64 + lane; const int rp = id >> 4, slot = id & 15;
        const unsigned ko = kbase + ((unsigned)swap23(rp) * PC + (unsigned)((slot ^ (rp & 15)) * 8)) * 2u;
        __builtin_amdgcn_global_load_lds((const unsigned*)(wsb + ko), (LAS unsigned*)(lds + L_K + kbuf * 16384 + (wv * 2 + i) * 1024), 16, 0, 0);
    }
}
__device__ __forceinline__ void dma_v(const char* wsb, LAS unsigned char* lds, int vbuf, int b, int h, int jt, int tid) {
    const int wv = __builtin_amdgcn_readfirstlane(tid >> 6), lane = tid & 63;
    const unsigned vbase = (unsigned)WS_VT + ((unsigned)((b * 4 + h) * 128) * S + 64u * jt) * 2u;
#pragma unroll
    for (int i = 0; i < 2; ++i) {
        const int id = (wv * 2 + i) * 64 + lane; const int d = id >> 3, vs = id & 7;
        const unsigned vo = vbase + ((unsigned)d * S + (unsigned)((vs ^ ((d >> 1) & 7)) * 8)) * 2u;
        __builtin_amdgcn_global_load_lds((const unsigned*)(wsb + vo), (LAS unsigned*)(lds + L_V + vbuf * 16384 + (wv * 2 + i) * 1024), 16, 0, 0);
    }
}
__device__ __forceinline__ float load_cb(const char* wsb, LAS unsigned char* lds, int b, int h, int jt, int tid) {
    float v = 0.f;
    if (tid < 64) v = -(*(const float*)(wsb + ((unsigned)WS_C + ((unsigned)(b * S + 64 * jt + tid) * 4 + h) * 4u)) + *(const LAS float*)(lds + L_CBB + jt * 4)) * LOG2E;
    return v;
}
__device__ __forceinline__ void meta_kv(const char* wsb, LAS unsigned char* lds, int h, int tid) {
    const unsigned kbase = (unsigned)WS_PROJ + ((unsigned)R * PC + (unsigned)(C_FK + h * 128)) * 2u, vbase = (unsigned)WS_PROJ + ((unsigned)R * PC + (unsigned)(C_FV + h * 128)) * 2u;
#pragma unroll
    for (int i = 0; i < 2; ++i) {
        const int id = tid + 512 * i;
        const int rp = id >> 4, slot = id & 15; const int key = swap23(rp);
        g8::u32x4 kv = {0u, 0u, 0u, 0u};
        if (key < NM) { const uint4 t = *(const uint4*)(wsb + (kbase + ((unsigned)key * PC + (unsigned)((slot ^ (rp & 15)) * 8)) * 2u)); kv = (g8::u32x4){t.x, t.y, t.z, t.w}; }
        *(LAS g8::u32x4*)(lds + L_K + id * 16) = kv;
        const int d = id >> 3, vs = id & 7; const int ch = vs ^ ((d >> 1) & 7);
        g8::u32x4 vv = {0u, 0u, 0u, 0u};
        if (ch < 2) {
            const unsigned vo = vbase + ((unsigned)(ch * 8) * PC + (unsigned)d) * 2u;
            unsigned e[8];
#pragma unroll
            for (int q = 0; q < 8; ++q) e[q] = *(const bf16_t*)(wsb + (vo + (unsigned)q * PC * 2u));
            vv = (g8::u32x4){e[0] | (e[1] << 16), e[2] | (e[3] << 16), e[4] | (e[5] << 16), e[6] | (e[7] << 16)};
        }
        *(LAS g8::u32x4*)(lds + L_V + id * 16) = vv;
    }
    if (tid < 64) {
        float cbv = 0.f;
        if (tid < NM) cbv = -*(const float*)(wsb + ((unsigned)WS_C + ((unsigned)(R + tid) * 4 + h) * 4u)) * LOG2E;
        *(LAS float*)(lds + L_CB + tid * 4) = cbv;
    }
}

struct WaveState { f32x16 O[4]; f32x16 s0, s1; unsigned pk0[8], pk1[8]; float m, l; };

__device__ __forceinline__ void qk(WaveState& w, const bf16x8 (&qf)[8], LAS unsigned char* lds, int kbuf, int lane) {
    const int ql = lane & 31, hi = lane >> 5, kx = ql & 15;
    const LAS unsigned char* Kb = lds + L_K + kbuf * 16384 + ql * 256;
#pragma unroll
    for (int r = 0; r < 16; ++r) { w.s0[r] = 0.f; w.s1[r] = 0.f; }
    bf16x8 fa[2], fb[2];
    { const LAS unsigned char* kp = Kb + (((0 + hi) ^ kx) << 4); fa[0] = *(const LAS bf16x8*)kp; fb[0] = *(const LAS bf16x8*)(kp + 32 * 256); }
#pragma unroll
    for (int ks = 0; ks < 8; ++ks) {
        if (ks + 1 < 8) { const LAS unsigned char* kp = Kb + (((2 * (ks + 1) + hi) ^ kx) << 4); fa[(ks + 1) & 1] = *(const LAS bf16x8*)kp; fb[(ks + 1) & 1] = *(const LAS bf16x8*)(kp + 32 * 256); }
        w.s0 = __builtin_amdgcn_mfma_f32_32x32x16_bf16(fa[ks & 1], qf[ks], w.s0, 0, 0, 0);
        w.s1 = __builtin_amdgcn_mfma_f32_32x32x16_bf16(fb[ks & 1], qf[ks], w.s1, 0, 0, 0);
        __builtin_amdgcn_sched_barrier(0);
    }
}
__device__ __forceinline__ void pv(WaveState& w, LAS unsigned char* lds, int vbuf, int lane) {
    const int ql = lane & 31, hi = lane >> 5, vx = (ql >> 1) & 7;
    const LAS unsigned char* Vb = lds + L_V + vbuf * 16384 + ql * 128;
    bf16x8 fv[2][4];
    { const LAS unsigned char* vp = Vb + (((0 + hi) ^ vx) << 4);
#pragma unroll
      for (int db = 0; db < 4; ++db) fv[0][db] = *(const LAS bf16x8*)(vp + db * 4096); }
#pragma unroll
    for (int g = 0; g < 4; ++g) {
        const int kb = g >> 1, sl = g & 1;
        if (g + 1 < 4) { const int kb2 = (g + 1) >> 1, sl2 = (g + 1) & 1; const LAS unsigned char* vp = Vb + (((4 * kb2 + 2 * sl2 + hi) ^ vx) << 4);
#pragma unroll
            for (int db = 0; db < 4; ++db) fv[(g + 1) & 1][db] = *(const LAS bf16x8*)(vp + db * 4096); }
        g8::u32x4 bv;
        if (kb == 0) bv = (g8::u32x4){w.pk0[4 * sl], w.pk0[4 * sl + 1], w.pk0[4 * sl + 2], w.pk0[4 * sl + 3]};
        else         bv = (g8::u32x4){w.pk1[4 * sl], w.pk1[4 * sl + 1], w.pk1[4 * sl + 2], w.pk1[4 * sl + 3]};
#pragma unroll
        for (int db = 0; db < 4; ++db) w.O[db] = __builtin_amdgcn_mfma_f32_32x32x16_bf16(fv[g & 1][db], __builtin_bit_cast(bf16x8, bv), w.O[db], 0, 0, 0);
        __builtin_amdgcn_sched_barrier(0);
    }
}
__device__ __forceinline__ void softmax(WaveState& w, LAS unsigned char* lds, int cbuf, int lim, int lane) {
    const int hi = lane >> 5;
    const LAS float* cb = (const LAS float*)(lds + L_CB + cbuf * 256) + 8 * hi;
#pragma unroll
    for (int g = 0; g < 4; ++g) {
        const f32x4 c0 = *(const LAS f32x4*)(cb + 16 * (g >> 1) + 4 * (g & 1)), c1 = *(const LAS f32x4*)(cb + 32 + 16 * (g >> 1) + 4 * (g & 1));
#pragma unroll
        for (int j = 0; j < 4; ++j) { w.s0[4 * g + j] += c0[j]; w.s1[4 * g + j] += c1[j]; }
    }
    if (lim < 64) {
        const float NEG = -__builtin_inff();
#pragma unroll
        for (int r = 0; r < 16; ++r) {
            const int kap = 16 * (r >> 3) + 8 * hi + (r & 7);
            if (kap > lim) w.s0[r] = NEG;
            if (kap + 32 > lim) w.s1[r] = NEG;
        }
    }
    float pmax = w.s0[0];
#pragma unroll
    for (int r = 1; r < 16; ++r) pmax = fmaxf(pmax, w.s0[r]);
#pragma unroll
    for (int r = 0; r < 16; ++r) pmax = fmaxf(pmax, w.s1[r]);
    pmax = fmaxf(pmax, __shfl_xor(pmax, 32));
    float mn = w.m;
    if (!__all(pmax - w.m <= FOX_THR)) {
        mn = fmaxf(w.m, pmax);
        const float alpha = __builtin_amdgcn_exp2f(w.m - mn);
        w.m = mn; w.l *= alpha;
#pragma unroll
        for (int db = 0; db < 4; ++db)
#pragma unroll
            for (int r = 0; r < 16; ++r) w.O[db][r] *= alpha;
    }
    float ls = 0.f;
#pragma unroll
    for (int r = 0; r < 16; ++r) { w.s0[r] = __builtin_amdgcn_exp2f(w.s0[r] - mn); w.s1[r] = __builtin_amdgcn_exp2f(w.s1[r] - mn); ls += w.s0[r] + w.s1[r]; }
    ls += __shfl_xor(ls, 32);
    w.l += ls;
#pragma unroll
    for (int i = 0; i < 8; ++i) { w.pk0[i] = g8::cvt_pk_bf16(w.s0[2 * i], w.s0[2 * i + 1]); w.pk1[i] = g8::cvt_pk_bf16(w.s1[2 * i], w.s1[2 * i + 1]); }
}

__device__ __forceinline__ bool block_and(LAS unsigned char* lds, bool pred, int wv, int lane) {
    const bool wall = __builtin_amdgcn_ballot_w64(pred) == 0xFFFFFFFFFFFFFFFFull;
    if (lane == 0) *(LAS int*)(lds + L_VOTE + wv * 4) = wall ? 1 : 0;
    __syncthreads();
    int r = 1;
#pragma unroll
    for (int q = 0; q < 8; ++q) r &= *(const LAS int*)(lds + L_VOTE + q * 4);
    return r != 0;
}
__device__ __forceinline__ void qblock(char* wsb, LAS unsigned char* lds, int b, int h, int qb, int tid_in) {
    int tid = tid_in; asm volatile("" : "+v"(tid));
    const int lane = tid & 63, wv = __builtin_amdgcn_readfirstlane(tid >> 6), ql = lane & 31, hi = lane >> 5;
    const int grp = wv >> 2;
    const int qcol = C_FQ + h * 128;
    const unsigned qoff = (unsigned)WS_PROJ + ((unsigned)(b * S + 256 * qb + 32 * wv + ql) * PC + qcol + hi * 8) * 2u;
    bf16x8 qf[8];
#pragma unroll
    for (int ks = 0; ks < 8; ++ks) qf[ks] = *(const bf16x8*)(wsb + (qoff + ks * 32));
    float qkb;
    {
        float ss = 0.f;
#pragma unroll
        for (int ks = 0; ks < 8; ++ks) {
            const g8::u32x4 qw = __builtin_bit_cast(g8::u32x4, qf[ks]);
            ss += bflo(qw.x) * bflo(qw.x) + bfhi(qw.x) * bfhi(qw.x) + bflo(qw.y) * bflo(qw.y) + bfhi(qw.y) * bfhi(qw.y)
                + bflo(qw.z) * bflo(qw.z) + bfhi(qw.z) * bfhi(qw.z) + bflo(qw.w) * bflo(qw.w) + bfhi(qw.w) * bfhi(qw.w);
        }
        ss += __shfl_xor(ss, 32);
        const unsigned* KP = (const unsigned*)(wsb + WS_KPART) + (b * 4 + h) * 4;
        const float k2 = __uint_as_float(KP[0]) + __uint_as_float(KP[1]) + __uint_as_float(KP[2]) + __uint_as_float(KP[3]);
        qkb = sqrtf(ss) * sqrtf(k2) * 1.002f + 0.05f;
    }
    WaveState w;
#pragma unroll
    for (int db = 0; db < 4; ++db)
#pragma unroll
        for (int r = 0; r < 16; ++r) w.O[db][r] = 0.f;
    w.m = -1e30f; w.l = 0.f;
    const int n = 4 * qb + 5;
    const int jd = 4 * qb + (wv >> 1);
    const int tf = 4 - (wv >> 1);
    const int dlim = 32 * (wv & 1) + ql;
#define FX_JT(t_) (4 * qb + 4 - (t_))
#define FX_ACT(t_) ((t_) == 0 || (t_) >= tf)
    __syncthreads();
    if (tid < 64) {
        const float* CTp = (const float*)(wsb + WS_CT) + ((b * 4 + h) * 128 + 2 * tid);
        const float t0 = CTp[0], t1 = CTp[1];
        float sc = t0 + t1;
#pragma unroll
        for (int o = 1; o < 64; o <<= 1) { const float t = __shfl_up(sc, o); if (tid >= o) sc += t; }
        const float meta_tot = *(const float*)(wsb + ((unsigned)WS_C + ((unsigned)(R + NM - 1) * 4 + h) * 4u));
        const float e0 = meta_tot + sc - (t0 + t1);
        *(LAS float*)(lds + L_CBB + (2 * tid) * 4) = e0; *(LAS float*)(lds + L_CBB + (2 * tid + 1) * 4) = e0 + t0;
    }
    __syncthreads();
    meta_kv(wsb, lds, h, tid);
    dma_k(wsb, lds, 1, b, h, FX_JT(1), tid);
    { const float c1 = load_cb(wsb, lds, b, h, FX_JT(1), tid); if (tid < 64) *(LAS float*)(lds + L_CB + 256 + tid * 4) = c1; }
    asm volatile("s_waitcnt vmcnt(0)" ::: "memory");
    __syncthreads();
    float cbreg = 0.f;
#define FX_EVEN(m_) do { const int m__ = (m_); if (m__ >= 1) { int tq = tid; asm volatile("" : "+v"(tq)); \
        if (m__ + 1 < n) { dma_k(wsb, lds, (m__ + 1) & 1, b, h, FX_JT(m__ + 1), tq); cbreg = load_cb(wsb, lds, b, h, FX_JT(m__ + 1), tq); } \
        if (m__ < n) dma_v(wsb, lds, m__ & 1, b, h, FX_JT(m__), tq); } } while (0)
#define FX_ODD(m_) do { const int m__ = (m_); asm volatile("s_waitcnt vmcnt(0)" ::: "memory"); \
        if (m__ >= 1 && m__ + 1 < n && tid < 64) *(LAS float*)(lds + L_CB + ((m__ + 1) & 1) * 256 + tid * 4) = cbreg; } while (0)
#define FX_SM(t_) do { const int t__ = (t_); if (FX_ACT(t__)) softmax(w, lds, t__ & 1, t__ == 0 ? NM - 1 : (FX_JT(t__) < jd ? 64 : dlim), lane); } while (0)
#define FX_VOTE(t_) (((t_) >= 1 && (t_) < n - 1) ? (qkb - *(const LAS float*)(lds + L_CBB + FX_JT(t_) * 4) * LOG2E < w.m - 152.f) : false)
    if (grp == 0) {
        qk(w, qf, lds, 0, lane);
        __syncthreads();
        for (int t = 0; ; ++t) {
            FX_SM(t); FX_ODD(t);
            const bool last = block_and(lds, FX_VOTE(t), wv, lane) || t == n - 1;
            if (!last) FX_EVEN(t + 1);
            if (FX_ACT(t)) pv(w, lds, t & 1, lane);
            if (!last && FX_ACT(t + 1)) qk(w, qf, lds, (t + 1) & 1, lane);
            __syncthreads();
            if (last) break;
        }
        asm volatile("s_waitcnt vmcnt(0)" ::: "memory");
        (void)block_and(lds, false, wv, lane);
    } else {
        __syncthreads();
        qk(w, qf, lds, 0, lane); FX_ODD(0);
        bool last = block_and(lds, false, wv, lane);
        for (int t = 0; ; ++t) {
            if (!last) FX_EVEN(t + 1);
            FX_SM(t);
            __syncthreads();
            if (FX_ACT(t)) pv(w, lds, t & 1, lane);
            if (!last && FX_ACT(t + 1)) qk(w, qf, lds, (t + 1) & 1, lane);
            FX_ODD(t + 1);
            const bool stop_next = block_and(lds, FX_VOTE(t + 1), wv, lane);
            if (last) break;
            last = stop_next || (t + 1 == n - 1);
        }
    }
#undef FX_EVEN
#undef FX_ODD
#undef FX_SM
#undef FX_VOTE
#undef FX_JT
#undef FX_ACT
    const float inv = 1.f / w.l;
    int tz = tid; asm volatile("" : "+v"(tz));
    const unsigned ooff = (unsigned)WS_PROJ + ((unsigned)(b * S + 256 * qb + 32 * wv + (tz & 31)) * PC + qcol + ((tz >> 5) & 1) * 4) * 2u;
#pragma unroll
    for (int db = 0; db < 4; ++db)
#pragma unroll
        for (int g = 0; g < 4; ++g) {
            uint2 o; o.x = g8::cvt_pk_bf16(w.O[db][4 * g] * inv, w.O[db][4 * g + 1] * inv); o.y = g8::cvt_pk_bf16(w.O[db][4 * g + 2] * inv, w.O[db][4 * g + 3] * inv);
            *(uint2*)(wsb + (ooff + (32 * db + 8 * g) * 2)) = o;
        }
}
}

namespace sx {
using fx::bf16x8; using fx::f32x16; using fx::WaveState; using fx::swap23; using fx::L_K; using fx::L_V;
__device__ __forceinline__ void dma_k(const char* wsb, LAS unsigned char* lds, int kbuf, int b, int h, int jt, int tid) {
    const int wv = __builtin_amdgcn_readfirstlane(tid >> 6), lane = tid & 63;
    const unsigned kbase = (unsigned)WS_PROJ + ((unsigned)(b * S + 64 * jt) * PC + (unsigned)(C_SK + h * 128)) * 2u;
#pragma unroll
    for (int i = 0; i < 2; ++i) {
        const int id = (wv * 2 + i) * 64 + lane; const int rp = id >> 4, slot = id & 15;
        const unsigned ko = kbase + ((unsigned)swap23(rp) * PC + (unsigned)((slot ^ (rp & 15)) * 8)) * 2u;
        __builtin_amdgcn_global_load_lds((const unsigned*)(wsb + ko), (LAS unsigned*)(lds + L_K + kbuf * 16384 + (wv * 2 + i) * 1024), 16, 0, 0);
    }
}
__device__ __forceinline__ void dma_v(const char* wsb, LAS unsigned char* lds, int vbuf, int b, int h, int jt, int tid) {
    const int wv = __builtin_amdgcn_readfirstlane(tid >> 6), lane = tid & 63;
    const unsigned vbase = (unsigned)WS_VT + ((unsigned)((16 + b * 4 + h) * 128) * S + 64u * jt) * 2u;
#pragma unroll
    for (int i = 0; i < 2; ++i) {
        const int id = (wv * 2 + i) * 64 + lane; const int d = id >> 3, vs = id & 7;
        const unsigned vo = vbase + ((unsigned)d * S + (unsigned)((vs ^ ((d >> 1) & 7)) * 8)) * 2u;
        __builtin_amdgcn_global_load_lds((const unsigned*)(wsb + vo), (LAS unsigned*)(lds + L_V + vbuf * 16384 + (wv * 2 + i) * 1024), 16, 0, 0);
    }
}
__device__ __forceinline__ void meta_k(const char* wsb, LAS unsigned char* lds, int kbuf, int h, int tid) {
    const unsigned kbase = (unsigned)WS_PROJ + ((unsigned)R * PC + (unsigned)(C_SK + h * 128)) * 2u;
#pragma unroll
    for (int i = 0; i < 2; ++i) {
        const int id = tid + 512 * i;
        const int rp = id >> 4, slot = id & 15; const int key = swap23(rp);
        g8::u32x4 kv = {0u, 0u, 0u, 0u};
        if (key < NM) { const uint4 t = *(const uint4*)(wsb + (kbase + ((unsigned)key * PC + (unsigned)((slot ^ (rp & 15)) * 8)) * 2u)); kv = (g8::u32x4){t.x, t.y, t.z, t.w}; }
        *(LAS g8::u32x4*)(lds + L_K + kbuf * 16384 + id * 16) = kv;
    }
}
__device__ __forceinline__ void meta_v(const char* wsb, LAS unsigned char* lds, int vbuf, int h, int tid) {
    const unsigned vbase = (unsigned)WS_PROJ + ((unsigned)R * PC + (unsigned)(C_SV + h * 128)) * 2u;
#pragma unroll
    for (int i = 0; i < 2; ++i) {
        const int id = tid + 512 * i;
        const int d = id >> 3, vs = id & 7; const int ch = vs ^ ((d >> 1) & 7);
        g8::u32x4 vv = {0u, 0u, 0u, 0u};
        if (ch < 2) {
            const unsigned vo = vbase + ((unsigned)(ch * 8) * PC + (unsigned)d) * 2u;
            unsigned e[8];
#pragma unroll
            for (int q = 0; q < 8; ++q) e[q] = *(const bf16_t*)(wsb + (vo + (unsigned)q * PC * 2u));
            vv = (g8::u32x4){e[0] | (e[1] << 16), e[2] | (e[3] << 16), e[4] | (e[5] << 16), e[6] | (e[7] << 16)};
        }
        *(LAS g8::u32x4*)(lds + L_V + vbuf * 16384 + id * 16) = vv;
    }
}
__device__ __forceinline__ void sbweights(WaveState& w, float& rr, int lim, int lane) {
    const int hi = lane >> 5;
    float T[4];
#pragma unroll
    for (int rho = 0; rho < 4; ++rho) {
        float mv[8], dv[8];
#pragma unroll
        for (int e = 0; e < 8; ++e) {
            const int r = 8 * (rho & 1) + e;
            const float z = rho < 2 ? w.s0[r] : w.s1[r];
            const float ex = __builtin_amdgcn_exp2f(-fabsf(z));
            const float sp = fmaxf(z, 0.f) + __builtin_amdgcn_logf(1.f + ex);
            const bool valid = (32 * (rho >> 1) + 16 * (rho & 1) + e) < lim - 8 * hi;
            mv[e] = valid ? -sp : 0.f;
            dv[e] = valid ? z - sp : -__builtin_inff();
        }
        float suf = 0.f;
#pragma unroll
        for (int e = 7; e >= 0; --e) { dv[e] += suf; suf += mv[e]; }
        T[rho] = suf;
#pragma unroll
        for (int e = 0; e < 8; ++e) { const int r = 8 * (rho & 1) + e; if (rho < 2) w.s0[r] = dv[e]; else w.s1[r] = dv[e]; }
    }
    float run = rr;
#pragma unroll
    for (int rho = 3; rho >= 0; --rho) {
        const float Tp = __shfl_xor(T[rho], 32);
        const float base = run + (hi == 0 ? Tp : 0.f);
#pragma unroll
        for (int e = 0; e < 8; ++e) {
            const int r = 8 * (rho & 1) + e;
            if (rho < 2) w.s0[r] = __builtin_amdgcn_exp2f(w.s0[r] + base); else w.s1[r] = __builtin_amdgcn_exp2f(w.s1[r] + base);
        }
        run += T[rho] + Tp;
    }
    rr = run;
#pragma unroll
    for (int i = 0; i < 8; ++i) { w.pk0[i] = g8::cvt_pk_bf16(w.s0[2 * i], w.s0[2 * i + 1]); w.pk1[i] = g8::cvt_pk_bf16(w.s1[2 * i], w.s1[2 * i + 1]); }
}

__device__ __forceinline__ void qblock(char* wsb, LAS unsigned char* lds, int b, int h, int qb, int tid_in) {
    int tid = tid_in; asm volatile("" : "+v"(tid));
    const int lane = tid & 63, wv = __builtin_amdgcn_readfirstlane(tid >> 6), ql = lane & 31, hi = lane >> 5;
    const int grp = wv >> 2;
    const int qcol = C_SQ + h * 128;
    const unsigned qoff = (unsigned)WS_PROJ + ((unsigned)(b * S + 256 * qb + 32 * wv + ql) * PC + qcol + hi * 8) * 2u;
    bf16x8 qf[8];
#pragma unroll
    for (int ks = 0; ks < 8; ++ks) qf[ks] = *(const bf16x8*)(wsb + (qoff + ks * 32));
    WaveState w;
#pragma unroll
    for (int db = 0; db < 4; ++db)
#pragma unroll
        for (int r = 0; r < 16; ++r) w.O[db][r] = 0.f;
    w.m = 0.f; w.l = 0.f;
    float rr = 0.f;
    const int n = 4 * qb + 5;
    const int tf = 3 - (wv >> 1);
    const int dlim = 32 * (wv & 1) + ql;
#define SX_JT(t_) (4 * qb + 3 - (t_))
#define SX_LIM(t_) ((t_) == n - 1 ? NM : ((t_) == tf ? dlim : 64))
    __syncthreads();
    dma_k(wsb, lds, 0, b, h, SX_JT(0), tid); dma_v(wsb, lds, 0, b, h, SX_JT(0), tid); dma_k(wsb, lds, 1, b, h, SX_JT(1), tid);
    asm volatile("s_waitcnt vmcnt(0)" ::: "memory");
    __syncthreads();
#define SX_EVEN(m_) do { const int m__ = (m_); if (m__ >= 1) { int tq = tid; asm volatile("" : "+v"(tq)); \
        if (m__ + 1 < n) { if (m__ + 1 == n - 1) meta_k(wsb, lds, (m__ + 1) & 1, h, tq); else dma_k(wsb, lds, (m__ + 1) & 1, b, h, SX_JT(m__ + 1), tq); } \
        if (m__ < n) { if (m__ == n - 1) meta_v(wsb, lds, m__ & 1, h, tq); else dma_v(wsb, lds, m__ & 1, b, h, SX_JT(m__), tq); } } } while (0)
#define SX_ODD() asm volatile("s_waitcnt vmcnt(0)" ::: "memory")
#define SX_SM(t_) do { const int t__ = (t_); if (t__ >= tf) sbweights(w, rr, SX_LIM(t__), lane); } while (0)
#define SX_VOTE(t_) ((t_) < n - 1 ? (rr < -152.f) : false)
    if (grp == 0) {
        if (0 >= tf) fx::qk(w, qf, lds, 0, lane);
        __syncthreads();
        for (int t = 0; ; ++t) {
            SX_SM(t); SX_ODD();
            const bool last = fx::block_and(lds, SX_VOTE(t), wv, lane) || t == n - 1;
            if (!last) SX_EVEN(t + 1);
            if (t >= tf) fx::pv(w, lds, t & 1, lane);
            if (!last && t + 1 >= tf) fx::qk(w, qf, lds, (t + 1) & 1, lane);
            __syncthreads();
            if (last) break;
        }
        SX_ODD();
        (void)fx::block_and(lds, false, wv, lane);
    } else {
        __syncthreads();
        if (0 >= tf) fx::qk(w, qf, lds, 0, lane);
        SX_ODD();
        bool last = fx::block_and(lds, SX_VOTE(0), wv, lane);
        for (int t = 0; ; ++t) {
            if (!last) SX_EVEN(t + 1);
            SX_SM(t);
            __syncthreads();
            if (t >= tf) fx::pv(w, lds, t & 1, lane);
            if (!last && t + 1 >= tf) fx::qk(w, qf, lds, (t + 1) & 1, lane);
            SX_ODD();
            const bool stop_next = fx::block_and(lds, SX_VOTE(t + 1), wv, lane);
            if (last) break;
            last = stop_next || (t + 1 == n - 1);
        }
    }
#undef SX_EVEN
#undef SX_ODD
#undef SX_SM
#undef SX_VOTE
#undef SX_JT
#undef SX_LIM
    int tz = tid; asm volatile("" : "+v"(tz));
    const unsigned ooff = (unsigned)WS_PROJ + ((unsigned)(b * S + 256 * qb + 32 * wv + (tz & 31)) * PC + qcol + ((tz >> 5) & 1) * 4) * 2u;
#pragma unroll
    for (int db = 0; db < 4; ++db)
#pragma unroll
        for (int g = 0; g < 4; ++g) {
            uint2 o; o.x = g8::cvt_pk_bf16(w.O[db][4 * g], w.O[db][4 * g + 1]); o.y = g8::cvt_pk_bf16(w.O[db][4 * g + 2], w.O[db][4 * g + 3]);
            *(uint2*)(wsb + (ooff + (32 * db + 8 * g) * 2)) = o;
        }
}
}

__device__ __forceinline__ void phase_attn_main(const Ctx& c, int layer, LAS unsigned char* lds) {
    char* wsb = (char*)c.a->ws;
    {
        unsigned* ctr = (unsigned*)(c.a->ws + WS_FOXQ) + layer * 16;
        LAS int* slot = (LAS int*)(lds + 65536 + 1024 + 32);
        for (;;) {
            __syncthreads();
            if (c.tid == 0) *slot = (int)__hip_atomic_fetch_add(ctr, 1u, __ATOMIC_RELAXED, __HIP_MEMORY_SCOPE_AGENT);
            __syncthreads();
            const int it = *slot;
            if (it >= 512) break;
            const int bh = it & 15, qb = 31 - (it >> 4);
            fx::qblock(wsb, lds, bh >> 2, bh & 3, qb, c.tid);
        }
    }
    for (int it = blockIdx.x; it < 512; it += gridDim.x) {
        const int bh = it >> 5, qb = it & 31;
        sx::qblock(wsb, lds, bh >> 2, bh & 3, qb, c.tid);
    }
    __syncthreads();
}

namespace mg {
typedef short bf16x8 __attribute__((ext_vector_type(8)));
typedef float f32x4 __attribute__((ext_vector_type(4)));
__device__ __forceinline__ void mma16(f32x4& acc, const bf16_t* ap, const bf16_t* bp, int k0, int klen) {
#pragma unroll 4
    for (int k = k0; k < k0 + klen; k += 32) {
        const bf16x8 a = *(const bf16x8*)(ap + k), b = *(const bf16x8*)(bp + k);
        acc = __builtin_amdgcn_mfma_f32_16x16x32_bf16(a, b, acc, 0, 0, 0);
    }
}
template <int SLOTS>
__device__ __forceinline__ void put_partial(float* red, int slot, const f32x4& acc, int tid) {
    const int wv = tid >> 6, lane = tid & 63, fr = lane & 15, fq = lane >> 4;
#pragma unroll
    for (int j = 0; j < 4; ++j) red[((slot * 8 + wv) * 16 + 4 * fq + j) * 16 + fr] = acc[j];
}
__device__ __forceinline__ float get_sum(const float* red, int slot, int tid) {
    float v = 0.f;
#pragma unroll
    for (int w = 0; w < 8; ++w) v += red[(slot * 8 + w) * 256 + tid];
    return v;
}
__device__ __forceinline__ int item0() { return (int)gridDim.x - 1 - (int)blockIdx.x; }
}

__device__ __forceinline__ void meta_proj(const Ctx& c, int layer) {
    const int tid = c.tid, wv = tid >> 6, lane = tid & 63, fr = lane & 15, fq = lane >> 4;
    const bf16_t* A = c.XN() + (size_t)(R + fr) * D + fq * 8;
    const bf16_t* W = (const bf16_t*)(c.a->ws + WS_WB + layer * WB_LAYER + WB_IN);
    float* red = c.smem;
    for (int g = mg::item0(); g < PC / 16; g += gridDim.x) {
        mg::f32x4 acc = {0.f, 0.f, 0.f, 0.f};
        mg::mma16(acc, A, W + (size_t)(g * 16 + fr) * D + fq * 8, wv * (D / 8), D / 8);
        __syncthreads();
        mg::put_partial<1>(red, 0, acc, tid);
        __syncthreads();
        if (tid < 256) c.PROJ()[(size_t)(R + (tid >> 4)) * PC + g * 16 + (tid & 15)] = f2bf(mg::get_sum(red, 0, tid));
    }
}
__device__ __forceinline__ void meta_merge(const Ctx& c, int layer) {
    const int tid = c.tid, wv = tid >> 6, lane = tid & 63, fr = lane & 15, fq = lane >> 4;
    const unsigned char* wb = c.a->ws + WS_WB + layer * WB_LAYER;
    float* red = c.smem;
    for (int g = mg::item0(); g < D / 16; g += gridDim.x) {
        const int n = g * 16 + fr;
        mg::f32x4 ga[3], ya[3];
#pragma unroll
        for (int j3 = 0; j3 < 3; ++j3) {
            ga[j3] = (mg::f32x4){0.f, 0.f, 0.f, 0.f}; ya[j3] = (mg::f32x4){0.f, 0.f, 0.f, 0.f};
            mg::mma16(ga[j3], c.XN() + (size_t)(R + fr) * D + fq * 8, (const bf16_t*)(wb + WB_G) + (size_t)(j3 * D + n) * D + fq * 8, wv * (D / 8), D / 8);
            const int acol = j3 == 0 ? C_FQ : j3 == 1 ? C_SQ : C_LG;
            const bf16_t* Wo = (const bf16_t*)(wb + (j3 == 0 ? WB_FO : j3 == 1 ? WB_SO : WB_LO));
            mg::mma16(ya[j3], c.PROJ() + (size_t)(R + fr) * PC + acol + fq * 8, Wo + (size_t)n * 512 + fq * 8, wv * 64, 64);
        }
        __syncthreads();
#pragma unroll
        for (int j3 = 0; j3 < 3; ++j3) { mg::put_partial<6>(red, 2 * j3, ga[j3], tid); mg::put_partial<6>(red, 2 * j3 + 1, ya[j3], tid); }
        __syncthreads();
        if (tid < 256) {
            const int col = g * 16 + (tid & 15);
            float m = 0.f;
#pragma unroll
            for (int j3 = 0; j3 < 3; ++j3) {
                const float gv = mg::get_sum(red, 2 * j3, tid) + c.b_gate()[layer * 3 * D + j3 * D + col];
                m += mg::get_sum(red, 2 * j3 + 1, tid) * __builtin_amdgcn_rcpf(1.f + __builtin_amdgcn_exp2f(-1.4426950408889634f * gv));
            }
            c.PROJ()[(size_t)(R + (tid >> 4)) * PC + C_MRG + col] = f2bf(m);
        }
    }
}
__device__ __forceinline__ void meta_resid(const Ctx& c, const float* src, const bf16_t* A, int lda, const bf16_t* Wt, int K, bool fuse_norm = false) {
    const int tid = c.tid, wv = tid >> 6, lane = tid & 63, fr = lane & 15, fq = lane >> 4;
    float* red = c.smem;
    const int kl = K / 8;
    for (int g = mg::item0(); g < D / 16; g += gridDim.x) {
        const int n = g * 16 + fr;
        mg::f32x4 acc = {0.f, 0.f, 0.f, 0.f};
        mg::mma16(acc, A + (size_t)(R + fr) * lda + fq * 8, Wt + (size_t)n * K + fq * 8, wv * kl, kl);
        __syncthreads();
        mg::put_partial<1>(red, 0, acc, tid);
        __syncthreads();
        if (tid < 256) {
            const size_t o = (size_t)(tid >> 4) * D + g * 16 + (tid & 15);
            const float hv = src[o] + mg::get_sum(red, 0, tid);
            c.hmeta()[o] = hv;
            if (fuse_norm) {
                c.XN()[(size_t)R * D + o] = f2bf(hv);
                float ss = hv * hv;
                ss += __shfl_xor(ss, 1); ss += __shfl_xor(ss, 2); ss += __shfl_xor(ss, 4); ss += __shfl_xor(ss, 8);
                if ((tid & 15) == 0) ((float*)(c.a->ws + WS_SSQM))[g * 16 + (tid >> 4)] = ss;
            }
        }
    }
}
__device__ __forceinline__ void meta_ffn_up(const Ctx& c) {
    const int tid = c.tid, wv = tid >> 6, lane = tid & 63, fr = lane & 15, fq = lane >> 4;
    const bf16_t* W = (const bf16_t*)(c.a->ws + WS_WGU);
    const bf16_t* A = c.XN() + (size_t)(R + fr) * D + fq * 8;
    float* red = c.smem;
    float rstd = 1.f;
    if (mg::item0() < DFF / 16 && tid < 256) {
        const float* sq = (const float*)(c.a->ws + WS_SSQM) + (tid >> 4);
        float ss = sq[((tid & 15)) * 16] + sq[((tid & 15) + 16) * 16] + sq[((tid & 15) + 32) * 16] + sq[((tid & 15) + 48) * 16];
        ss += __shfl_xor(ss, 1); ss += __shfl_xor(ss, 2); ss += __shfl_xor(ss, 4); ss += __shfl_xor(ss, 8);
        rstd = rsqrtf(ss * (1.f / D) + RMS_EPS);
    }
    for (int g = mg::item0(); g < DFF / 16; g += gridDim.x) {
        const int h = g * 16 + fr; const int rg = 8 * (h >> 2) + (h & 3);
        mg::f32x4 ga = {0.f, 0.f, 0.f, 0.f}, ua = {0.f, 0.f, 0.f, 0.f};
        mg::mma16(ga, A, W + (size_t)rg * D + fq * 8, wv * (D / 8), D / 8);
        mg::mma16(ua, A, W + (size_t)(rg + 4) * D + fq * 8, wv * (D / 8), D / 8);
        __syncthreads();
        mg::put_partial<2>(red, 0, ga, tid); mg::put_partial<2>(red, 1, ua, tid);
        __syncthreads();
        if (tid < 256) {
            const float gs = mg::get_sum(red, 0, tid) * rstd, us = mg::get_sum(red, 1, tid) * rstd;
            c.PROJ()[(size_t)(R + (tid >> 4)) * DFF + g * 16 + (tid & 15)] = f2bf(gs * us * __builtin_amdgcn_rcpf(1.f + __builtin_amdgcn_exp2f(-1.4426950408889634f * gs)));
        }
    }
}

struct CvtJob { const float* src; bf16_t* dst; int ldw, K, N, mode; const float* ks = nullptr; };
__device__ __forceinline__ void cvt_load(const CvtJob& j, int t, int nk, int g, int ko, float4 (&v)[8]) {
    const int kt = t % nk, ntile = t / nk;
    const float* sp = j.src + (size_t)(kt * 128 + ko * 8) * j.ldw + ntile * 128 + g * 4;
#pragma unroll
    for (int i = 0; i < 8; ++i) v[i] = *(const float4*)(sp + (size_t)i * j.ldw);
    if (j.ks) {
#pragma unroll
        for (int i = 0; i < 8; ++i) { const float sk = j.ks[kt * 128 + ko * 8 + i]; v[i].x *= sk; v[i].y *= sk; v[i].z *= sk; v[i].w *= sk; }
    }
}
__device__ __forceinline__ void cvt_store(const CvtJob& j, int t, int nk, int g, int ko, const float4 (&v)[8], uint4* img, int tid) {
    const int kt = t % nk, ntile = t / nk;
    lds_barrier();
#pragma unroll
    for (int q = 0; q < 4; ++q) {
        float e[8];
#pragma unroll
        for (int i = 0; i < 8; ++i) e[i] = q == 0 ? v[i].x : q == 1 ? v[i].y : q == 2 ? v[i].z : v[i].w;
        uint4 o; o.x = pack2(e[0], e[1]); o.y = pack2(e[2], e[3]); o.z = pack2(e[4], e[5]); o.w = pack2(e[6], e[7]);
        img[(4 * g + q) * 16 + (ko ^ (g & 15))] = o;
    }
    lds_barrier();
    const int c16 = tid & 15, r0 = tid >> 4;
#pragma unroll
    for (int i = 0; i < 4; ++i) {
        const int r = r0 + 32 * i;
        const uint4 o = img[r * 16 + (c16 ^ ((r >> 2) & 15))];
        const int ng = ntile * 128 + r;
        const int row = j.mode == 0 ? ng : (8 * (ng >> 2) + (ng & 3) + (j.mode == 2 ? 4 : 0));
        *(uint4*)(j.dst + (size_t)row * j.K + kt * 128 + c16 * 8) = o;
    }
}
__device__ __forceinline__ void cvt_tiles(const CvtJob& j, int& base, float* lds, int tid) {
    const int nk = j.K / 128, nn = j.N / 128, nt = nk * nn;
    const int G = gridDim.x;
    const int g = tid & 31, ko = tid >> 5;
    uint4* img = (uint4*)lds;
    const int first = ((int)blockIdx.x - base % G + G) % G;
    float4 va[8], vb[8];
    if (first < nt) cvt_load(j, first, nk, g, ko, va);
    for (int t = first; t < nt; t += 2 * G) {
        if (t + G < nt) cvt_load(j, t + G, nk, g, ko, vb);
        cvt_store(j, t, nk, g, ko, va, img, tid);
        if (t + G < nt) {
            if (t + 2 * G < nt) cvt_load(j, t + 2 * G, nk, g, ko, va);
            cvt_store(j, t + G, nk, g, ko, vb, img, tid);
        }
    }
    base += nt;
}
__device__ __forceinline__ void phase_cvt_dense(const Ctx& c) {
    int base = 0; float* tile = c.smem; unsigned char* ws = c.a->ws;
#pragma unroll 1
    for (int l = 0; l < 2; ++l) {
        const float* win = c.w_in() + (size_t)l * D * INC; unsigned char* wb = ws + WS_WB + l * WB_LAYER;
        cvt_tiles(CvtJob{win, (bf16_t*)(wb + WB_IN), INC, D, 1536, 0}, base, tile, c.tid);
        cvt_tiles(CvtJob{win + 1540, (bf16_t*)(wb + WB_IN) + (size_t)1536 * D, INC, D, 2560, 0}, base, tile, c.tid);
        cvt_tiles(CvtJob{win + WI_GATES, (bf16_t*)(wb + WB_G), INC, D, 3 * D, 0}, base, tile, c.tid);
        cvt_tiles(CvtJob{c.w_fox_o() + (size_t)l * 512 * D, (bf16_t*)(wb + WB_FO), D, 512, D, 0}, base, tile, c.tid);
        cvt_tiles(CvtJob{c.w_sb_o() + (size_t)l * 512 * D, (bf16_t*)(wb + WB_SO), D, 512, D, 0}, base, tile, c.tid);
        cvt_tiles(CvtJob{c.w_lru_o() + (size_t)l * 512 * D, (bf16_t*)(wb + WB_LO), D, 512, D, 0}, base, tile, c.tid);
        cvt_tiles(CvtJob{c.w_out() + (size_t)l * D * D, (bf16_t*)(wb + WB_OUT), D, D, D, 0}, base, tile, c.tid);
    }
    cvt_tiles(CvtJob{c.ffn_wg(), (bf16_t*)(ws + WS_WGU), DFF, D, DFF, 1, c.g_ffn()}, base, tile, c.tid);
    cvt_tiles(CvtJob{c.ffn_wu(), (bf16_t*)(ws + WS_WGU), DFF, D, DFF, 2, c.g_ffn()}, base, tile, c.tid);
    cvt_tiles(CvtJob{c.ffn_wd(), (bf16_t*)(ws + WS_WD), D, DFF, D, 0}, base, tile, c.tid);
}
__device__ __forceinline__ void phase_cvt_moe(const Ctx& c) {
    int base = 0; float* tile = c.smem; unsigned char* ws = c.a->ws;
#pragma unroll 1
    for (int e = 0; e < NE; ++e) {
        cvt_tiles(CvtJob{c.moe_wg() + (size_t)e * D * DFE, (bf16_t*)(ws + WS_MOE_GU) + (size_t)e * 2 * DFE * D, DFE, D, DFE, 1}, base, tile, c.tid);
        cvt_tiles(CvtJob{c.moe_wu() + (size_t)e * D * DFE, (bf16_t*)(ws + WS_MOE_GU) + (size_t)e * 2 * DFE * D, DFE, D, DFE, 2}, base, tile, c.tid);
        cvt_tiles(CvtJob{c.moe_wd() + (size_t)e * DFE * D, (bf16_t*)(ws + WS_MOE_D) + (size_t)e * D * DFE, D, DFE, D, 0}, base, tile, c.tid);
    }
}

__device__ __forceinline__ void final_row(const Ctx& c, const float4 (&gv)[4], int rr, const bf16_t* y0, const bf16_t* y1, float w0, float w1, int lane) {
    float* hrow = c.out() + (size_t)rr * D;
    float v[16];
    float ss = 0.f;
#pragma unroll
    for (int i = 0; i < 4; ++i) {
        const float4 t = *(const float4*)(hrow + i * 256 + lane * 4);
        const uint2 a = *(const uint2*)(y0 + i * 256 + lane * 4), bq = *(const uint2*)(y1 + i * 256 + lane * 4);
        v[4 * i] = t.x + w0 * bflo(a.x) + w1 * bflo(bq.x); v[4 * i + 1] = t.y + w0 * bfhi(a.x) + w1 * bfhi(bq.x);
        v[4 * i + 2] = t.z + w0 * bflo(a.y) + w1 * bflo(bq.y); v[4 * i + 3] = t.w + w0 * bfhi(a.y) + w1 * bfhi(bq.y);
    }
#pragma unroll
    for (int k = 0; k < 16; ++k) ss += v[k] * v[k];
    ss = wave_sum(ss);
    const float rstd = rsqrtf(ss * (1.f / D) + RMS_EPS);
#pragma unroll
    for (int i = 0; i < 4; ++i) {
        const float4 g = gv[i];
        float4 o; o.x = v[4 * i] * rstd * g.x; o.y = v[4 * i + 1] * rstd * g.y; o.z = v[4 * i + 2] * rstd * g.z; o.w = v[4 * i + 3] * rstd * g.w;
        *(float4*)(hrow + i * 256 + lane * 4) = o;
    }
}
__device__ __forceinline__ void phase_final(const Ctx& c, int part) {
    MoeMap m; moe_map(c, m);
    const int lane = c.lane;
    float4 gv[4]; gain_load(c.g_final(), gv, lane);
    constexpr int SLOT_LIM = (MOE_NCH - 1) * MOE_CH;
    int nlast = (m.ebase[8] - SLOT_LIM) / 256; nlast = nlast < 0 ? 0 : (nlast > MOE_CH / 256 ? MOE_CH / 256 : nlast);
    int nbusy = nlast * (D / 256);
    if (nbusy > (int)gridDim.x - 64) nbusy = (int)gridDim.x - 64;
    int wgi = blockIdx.x, nwg = gridDim.x;
    if (part == 0) { wgi = (int)blockIdx.x - nbusy; nwg = (int)gridDim.x - nbusy; if (wgi < 0) return; }
    const int rfirst = wgi * 8 + c.wave, rstep = nwg * 8;
    int mp0 = 0, mp1 = 0;
    { const int rl = rfirst + lane * rstep; if (rl < R) { mp0 = c.PAIR()[(size_t)rl * 2]; mp1 = c.PAIR()[(size_t)rl * 2 + 1]; } }
    int ri = 0;
    for (int rr = rfirst; rr < R; rr += rstep, ++ri) {
        const int p0 = __shfl(mp0, ri), p1 = __shfl(mp1, ri);
        int b0 = 0, b1 = 0;
#pragma unroll
        for (int k = 0; k < 8; ++k) { if (k == (p0 >> 20)) b0 = m.ebase[k]; if (k == (p1 >> 20)) b1 = m.ebase[k]; }
        const int s0 = b0 + (p0 & 0xFFFFF), s1 = b1 + (p1 & 0xFFFFF);
        const bool early = s0 < SLOT_LIM && s1 < SLOT_LIM;
        if (early != (part == 0)) continue;
        const float w0 = c.TOPW()[(size_t)rr * 2], w1 = c.TOPW()[(size_t)rr * 2 + 1];
        final_row(c, gv, rr, c.Y() + (size_t)s0 * D, c.Y() + (size_t)s1 * D, w0, w1, lane);
    }
}

constexpr int LDS_BYTES = 147456;
__global__ void __launch_bounds__(NTHR, 2) fwd(Args args) {
    extern __shared__ __attribute__((aligned(16))) unsigned char lds[];
    if (threadIdx.x < 4) ((unsigned*)(lds + 131072))[threadIdx.x] = 0u;
    __syncthreads();
    XcdBarrier bar = xcd_barrier_post((unsigned*)(args.ws + WS_BAR), (volatile LAS unsigned*)(lds + 131072));
#if defined(PROBE_G1)
    unsigned long long pr_t = __builtin_amdgcn_s_memrealtime(), pr_a1 = 0, pr_a2 = 0; int pr_k = 0;
#define SEAM_N(nk) do { xcd_barrier(bar); if (blockIdx.x == 0) { const unsigned long long t_ = __builtin_amdgcn_s_memrealtime(); \
        if ((PROBE_G1 >> pr_k) & 1u) pr_a1 += t_ - pr_t; if ((PROBE_G2 >> pr_k) & 1u) pr_a2 += t_ - pr_t; pr_t = t_; } pr_k = (nk); } while (0)
#define SEAM() SEAM_N(pr_k + 1)
#define MIDSEAM(k2) SEAM_N(k2)
#else
#define MIDSEAM(k2)
#define SEAM() xcd_barrier(bar)
#define SEAM_N(nk) xcd_barrier(bar)
#endif
#ifndef PHMASK
#define PHMASK 0xFFFFFFFFu
#endif
#define PH(k) (((PHMASK & args.phmask) >> (k)) & 1u)
#define MKCTX() Ctx c; c.a = &args; c.smem = (float*)lds; { int t_ = threadIdx.x; asm volatile("" : "+v"(t_)); c.tid = t_; c.lane = t_ & 63; c.wave = __builtin_amdgcn_readfirstlane(t_ >> 6); }
    LAS unsigned char* L = (LAS unsigned char*)lds;
    if (PH(0)) { MKCTX(); phase_cvt_dense(c); }
    if (PH(0)) { MKCTX(); phase_norm(c, 0, 0); }
    SEAM();
    if (PH(1)) { MKCTX(); side_cumsum(c); }
    if (PH(1)) { MKCTX(); meta_proj(c, 0); }
    if (PH(1)) { MKCTX(); phase_proj_main(c, 0, L); }
    SEAM();
    if (PH(2)) { MKCTX(); phase_attn_main(c, 0, L); }
    if (PH(2)) { MKCTX(); phase_attn(c, 0); }
    SEAM();
    if (PH(3)) { MKCTX(); phase_lru_carry(c); }
    SEAM();
    if (PH(4)) { MKCTX(); phase_lru(c, 0, 1); }
    SEAM();
    if (PH(5)) { MKCTX(); meta_merge(c, 0); }
    if (PH(5)) { MKCTX(); phase_merge_main(c, 0, L); }
    SEAM();
    if (PH(6)) { MKCTX(); meta_resid(c, c.meta(), c.PROJ() + C_MRG, PC, (const bf16_t*)(args.ws + WS_WB + WB_OUT), D, true); }
    if (PH(6)) { MKCTX(); phase_resid_norm_main(c, c.x(), (unsigned)(WS_PROJ + C_MRG * 2), PC * 2, (unsigned)(WS_WB + WB_OUT), D, L); }
    SEAM_N(8);
    if (PH(8)) { MKCTX(); meta_ffn_up(c); }
    if (PH(8)) { MKCTX(); phase_ffn_up_main(c, L); }
    SEAM();
    if (PH(9)) { MKCTX(); meta_resid(c, c.hmeta(), c.PROJ(), DFF, (const bf16_t*)(args.ws + WS_WD), DFF); }
    if (PH(9)) { MKCTX(); phase_resid_main(c, c.out(), (unsigned)WS_PROJ, DFF * 2, (unsigned)WS_WD, DFF, L); }
    SEAM();
    if (PH(10)) { MKCTX(); phase_norm(c, 1, 0); }
    SEAM();
    if (PH(11)) { MKCTX(); side_cumsum(c); }
    if (PH(11)) { MKCTX(); meta_proj(c, 1); }
    if (PH(11)) { MKCTX(); phase_proj_main(c, 1, L); }
    SEAM();
    if (PH(12)) { MKCTX(); phase_attn_main(c, 1, L); }
    if (PH(12)) { MKCTX(); phase_attn(c, 1); }
    SEAM();
    if (PH(13)) { MKCTX(); phase_lru_carry(c); }
    SEAM();
    if (PH(14)) { MKCTX(); phase_lru(c, 1, 1); }
    SEAM();
    if (PH(15)) { MKCTX(); phase_merge_main(c, 1, L); }
    SEAM();
    if (PH(16)) { MKCTX(); phase_resid_main(c, c.out(), (unsigned)(WS_PROJ + C_MRG * 2), PC * 2, (unsigned)(WS_WB + WB_LAYER + WB_OUT), D, L); }
    SEAM();
    if (PH(17)) { MKCTX(); phase_cvt_moe(c); }
    if (PH(17)) { MKCTX(); phase_norm(c, 1, 1); }
    SEAM();
#pragma unroll 1
    for (int ch = 0; ch < MOE_NCH; ++ch) {
        if (PH(18)) { MKCTX(); phase_moe_up(c, ch, L); }
        SEAM_N(19);
        if (PH(19)) { MKCTX(); phase_moe_down(c, ch, L); }
        if (ch < MOE_NCH - 1) SEAM_N(18);
    }
    if (PH(20)) { MKCTX(); phase_final(c, 0); }
    SEAM_N(20);
    if (PH(20)) { MKCTX(); phase_final(c, 1); }
#if defined(PROBE_G1)
    if (blockIdx.x == 0) {
        __syncthreads();
        if (threadIdx.x == 0) {
            const unsigned long long t_ = __builtin_amdgcn_s_memrealtime();
            if ((PROBE_G1 >> 20) & 1u) pr_a1 += t_ - pr_t; if ((PROBE_G2 >> 20) & 1u) pr_a2 += t_ - pr_t;
            const unsigned long long wait = 16ull * pr_a1 + 0ull * pr_a2;
            while (__builtin_amdgcn_s_memrealtime() - t_ < wait) __builtin_amdgcn_s_sleep(32);
        }
    }
#endif
}

extern "C" void kernel_launch(void* const* d_in, const int* in_sizes, int n_in, void* d_out, int out_size, void* d_ws, size_t ws_size, hipStream_t stream) {
    static int grid = 0;
    if (grid == 0) {
        if (n_in != 26 || out_size != R * D || ws_size < WS_END) { fprintf(stderr, "kernel_launch: unexpected problem (n_in %d out %d ws %zu)\n", n_in, out_size, ws_size); grid = -1; return; }
        int dev = 0, cus = 0, per_cu = 0;
        if (hipGetDevice(&dev) != hipSuccess || hipDeviceGetAttribute(&cus, hipDeviceAttributeMultiprocessorCount, dev) != hipSuccess) { grid = -1; return; }
        if (hipFuncSetAttribute((const void*)fwd, hipFuncAttributeMaxDynamicSharedMemorySize, LDS_BYTES) != hipSuccess) { grid = -1; return; }
        if (hipOccupancyMaxActiveBlocksPerMultiprocessor(&per_cu, (const void*)fwd, NTHR, LDS_BYTES) != hipSuccess || per_cu < 1) { fprintf(stderr, "occupancy query: %d\n", per_cu); }
        (void)hipGetLastError();
        grid = cus;
    }
    if (grid < 0) return;
    (void)hipMemsetAsync(d_ws, 0, WS_ZERO_BYTES, stream);
    Args a{};
    for (int i = 0; i < 26; ++i) a.in[i] = (const float*)d_in[i];
    a.out = (float*)d_out; a.ws = (unsigned char*)d_ws; a.phmask = 0xFFFFFFFFu; a.pad = 0u;
    hipLaunchKernelGGL(fwd, dim3(grid), dim3(NTHR), LDS_BYTES, stream, a);
}
```

```cpp
#include <hip/hip_runtime.h>
#include <cstdio>
#include <cstdint>


typedef unsigned short bf16_t;
#define LAS __attribute__((address_space(3)))

constexpr int D = 1024, NB = 4, S = 8192, NM = 16, R = NB * S, RT = R + NM;
constexpr int INC = 7172;
constexpr int PC = 4096;
constexpr int C_FQ = 0, C_FK = 512, C_FV = 1024, C_SQ = 1536, C_SK = 2048, C_SV = 2560, C_LX = 3072, C_LG = 3584, C_MRG = 512;
constexpr int WI_GATES = 4100;
constexpr int DFF = 2816, DFE = 3584, NE = 8;
constexpr int LCH = 128, NLC = S / LCH;
constexpr int MOE_CH = 16384;
constexpr int MOE_NCH = 5;
constexpr int NTHR = 512;
constexpr float RMS_EPS = 1e-6f;

constexpr size_t MiB = 1ull << 20;
constexpr size_t WS_BAR = 0;
constexpr size_t WS_CNT = 16384;
constexpr size_t WS_KPART = 16384 + 1024;
constexpr size_t WS_FOXQ = 16384 + 2048;
constexpr size_t WS_ZERO_BYTES = 16384 + 4096;
constexpr size_t WS_HMETA = 32768;
constexpr size_t WS_LF = 1 * MiB;
constexpr size_t WS_C = 2 * MiB;
constexpr size_t WS_SUMP = 3 * MiB;
constexpr size_t WS_SUME = 4 * MiB + 65536;
constexpr size_t WS_CARRY = 5 * MiB + 131072;
constexpr size_t WS_LIST = 6 * MiB + 262144;
constexpr size_t WS_PAIR = 7 * MiB + 524288;
constexpr size_t WS_TOPW = 7 * MiB + 786432;
constexpr size_t WS_XN = 8 * MiB;
constexpr size_t WS_PROJ = 73 * MiB;
constexpr size_t WS_HIDC_OFF = 0;
constexpr size_t WS_Y_OFF = 112 * MiB;
constexpr size_t WS_WB = 331 * MiB;
constexpr size_t WB_LAYER = 19 * MiB, WB_IN = 0, WB_G = 8 * MiB, WB_FO = 14 * MiB, WB_SO = 15 * MiB, WB_LO = 16 * MiB, WB_OUT = 17 * MiB;
constexpr size_t WS_WGU = 369 * MiB;
constexpr size_t WS_WD = 380 * MiB;
constexpr size_t WS_GSCR = 400 * MiB;
constexpr size_t WS_VT = 432 * MiB;
constexpr size_t WS_MOE_GU = 331 * MiB;
constexpr size_t WS_MOE_D = 443 * MiB;
constexpr size_t WS_END = 499 * MiB;

__device__ __forceinline__ float bf2f(bf16_t v) { return __uint_as_float(((unsigned)v) << 16); }
__device__ __forceinline__ float bflo(unsigned v) { return __uint_as_float(v << 16); }
__device__ __forceinline__ float bfhi(unsigned v) { return __uint_as_float(v & 0xFFFF0000u); }
__device__ __forceinline__ bf16_t f2bf(float f) { unsigned u = __float_as_uint(f); u += 0x7FFFu + ((u >> 16) & 1u); return (bf16_t)(u >> 16); }
__device__ __forceinline__ unsigned pack2(float a, float b) { return (unsigned)f2bf(a) | ((unsigned)f2bf(b) << 16); }
__device__ __forceinline__ void lds_barrier() { asm volatile("s_waitcnt lgkmcnt(0)" ::: "memory"); __builtin_amdgcn_s_barrier(); asm volatile("" ::: "memory"); }
__device__ __forceinline__ float wave_sum(float v) {
#pragma unroll
    for (int o = 32; o; o >>= 1) v += __shfl_xor(v, o);
    return v;
}
__device__ __forceinline__ float wave_max(float v) {
#pragma unroll
    for (int o = 32; o; o >>= 1) v = fmaxf(v, __shfl_xor(v, o));
    return v;
}
__device__ __forceinline__ float sigmoidf_(float x) { return 1.f / (1.f + expf(-x)); }
__device__ __forceinline__ float softplusf_(float x) { return fmaxf(x, 0.f) + log1pf(expf(-fabsf(x))); }
__device__ __forceinline__ float logsigf_(float x) { return fminf(x, 0.f) - log1pf(expf(-fabsf(x))); }
__device__ __forceinline__ float gelu_tanh(float x) { return 0.5f * x * (1.f + tanhf(0.7978845608028654f * (x + 0.044715f * x * x * x))); }

#define XB_TMO      128
#define XB_XCNT(j)  (256  + 64 * (j))
#define XB_XSUB(j)  (1280 + 64 * (j))
#define XB_XGEN(j)  (2304 + 64 * (j))
#define XB_TOP      3328
#define XB_TOPGEN   3392
#define XCD_BAR_WORDS 3456
#define XB_SPIN_CAP (1u << 24)
__device__ __forceinline__ unsigned xb_ld(unsigned* p)              { return __hip_atomic_load(p, __ATOMIC_RELAXED, __HIP_MEMORY_SCOPE_AGENT); }
__device__ __forceinline__ unsigned xb_add(unsigned* p, unsigned v) { return __hip_atomic_fetch_add(p, v, __ATOMIC_RELAXED, __HIP_MEMORY_SCOPE_AGENT); }
__device__ __forceinline__ unsigned xb_xcc_id() { return (unsigned)__builtin_amdgcn_s_getreg((3 << 11) | 20) & 0xFu; }
#define XB_SPIN(cond, bar) do { unsigned _sp = 0; while (cond) { __builtin_amdgcn_s_sleep(1); \
    if ((++_sp & 255u) == 0u) { if (xb_ld(&(bar)[XB_TMO])) break; if (_sp > XB_SPIN_CAP) { atomicAdd(&(bar)[XB_TMO], 1u); break; } } } } while (0)
struct XcdBarrier { unsigned* bar; unsigned x; volatile LAS unsigned* st; };
__device__ __forceinline__ XcdBarrier xcd_barrier_post(unsigned* bar, volatile LAS unsigned* st) {
    XcdBarrier b; b.bar = bar; b.x = xb_xcc_id(); b.st = st;
    if (threadIdx.x == 0) (void)xb_add(&bar[XB_XCNT(b.x)], 1u);
    return b;
}
__device__ __forceinline__ void xcd_barrier_complete(unsigned* bar, unsigned x, unsigned& nloc, unsigned& nx) {
    const unsigned G = gridDim.x * gridDim.y * gridDim.z;
    unsigned sum, cnt, mine, sp = 0u;
    for (;;) {
        sum = 0u; cnt = 0u; mine = 0u;
#pragma unroll
        for (unsigned j = 0; j < 16; ++j) { const unsigned c = xb_ld(&bar[XB_XCNT(j)]); sum += c; cnt += (c > 0u) ? 1u : 0u; mine = (j == x) ? c : mine; }
        if (sum == G) break;
        __builtin_amdgcn_s_sleep(1);
        if ((++sp & 255u) == 0u) { if (xb_ld(&bar[XB_TMO])) break; if (sp > XB_SPIN_CAP) { atomicAdd(&bar[XB_TMO], 1u); break; } }
    }
    nloc = mine > 0u ? mine : 1u; nx = cnt > 0u ? cnt : 1u;
}
__device__ __forceinline__ void xcd_barrier(const XcdBarrier& b) {
    asm volatile("s_waitcnt vmcnt(0)" ::: "memory");
    __syncthreads();
    if (threadIdx.x == 0) {
        unsigned* bar = b.bar;
        __builtin_amdgcn_s_waitcnt(0);
        unsigned nloc = b.st[0], nx = b.st[1];
        if (nloc == 0u) { xcd_barrier_complete(bar, b.x, nloc, nx); b.st[0] = nloc; b.st[1] = nx; }
        const unsigned old = xb_add(&bar[XB_XSUB(b.x)], 1u);
        const unsigned gen = old / nloc;
        if (old + 1u == (gen + 1u) * nloc) {
            __builtin_amdgcn_fence(__ATOMIC_RELEASE, "agent");
            asm volatile("s_waitcnt vmcnt(0)" ::: "memory");
            const unsigned og = xb_add(&bar[XB_TOP], 1u);
            const unsigned tg = og / nx;
            if (og + 1u == (tg + 1u) * nx) xb_add(&bar[XB_TOPGEN], 1u);
            else XB_SPIN(xb_ld(&bar[XB_TOPGEN]) == tg, bar);
            __builtin_amdgcn_fence(__ATOMIC_ACQUIRE, "agent");
            xb_add(&bar[XB_XGEN(b.x)], 1u);
            asm volatile("s_waitcnt vmcnt(0)" ::: "memory");
        } else {
            XB_SPIN(xb_ld(&bar[XB_XGEN(b.x)]) == gen, bar);
            __builtin_amdgcn_fence(__ATOMIC_ACQUIRE, "agent");
            asm volatile("s_waitcnt vmcnt(0)" ::: "memory");
        }
    }
    __syncthreads();
}

struct Args { const float* in[26]; float* out; unsigned char* ws; unsigned phmask; unsigned pad; };

struct Ctx {
    const Args* a; float* smem; int tid, lane, wave;
    __device__ __forceinline__ const float* x() const { return a->in[0]; }
    __device__ __forceinline__ const float* meta() const { return a->in[1]; }
    __device__ __forceinline__ const float* g_mix() const { return a->in[2]; }
    __device__ __forceinline__ const float* w_in() const { return a->in[3]; }
    __device__ __forceinline__ const float* b_forget() const { return a->in[4]; }
    __device__ __forceinline__ const float* b_gate() const { return a->in[5]; }
    __device__ __forceinline__ const float* conv_w() const { return a->in[6]; }
    __device__ __forceinline__ const float* conv_b() const { return a->in[7]; }
    __device__ __forceinline__ const float* wa() const { return a->in[8]; }
    __device__ __forceinline__ const float* ba() const { return a->in[9]; }
    __device__ __forceinline__ const float* wx() const { return a->in[10]; }
    __device__ __forceinline__ const float* bx() const { return a->in[11]; }
    __device__ __forceinline__ const float* lam() const { return a->in[12]; }
    __device__ __forceinline__ const float* w_fox_o() const { return a->in[13]; }
    __device__ __forceinline__ const float* w_sb_o() const { return a->in[14]; }
    __device__ __forceinline__ const float* w_lru_o() const { return a->in[15]; }
    __device__ __forceinline__ const float* w_out() const { return a->in[16]; }
    __device__ __forceinline__ const float* g_ffn() const { return a->in[17]; }
    __device__ __forceinline__ const float* ffn_wg() const { return a->in[18]; }
    __device__ __forceinline__ const float* ffn_wu() const { return a->in[19]; }
    __device__ __forceinline__ const float* ffn_wd() const { return a->in[20]; }
    __device__ __forceinline__ const float* router_w() const { return a->in[21]; }
    __device__ __forceinline__ const float* moe_wg() const { return a->in[22]; }
    __device__ __forceinline__ const float* moe_wu() const { return a->in[23]; }
    __device__ __forceinline__ const float* moe_wd() const { return a->in[24]; }
    __device__ __forceinline__ const float* g_final() const { return a->in[25]; }
    __device__ __forceinline__ float* out() const { return a->out; }
    __device__ __forceinline__ float* hmeta() const { return (float*)(a->ws + WS_HMETA); }
    __device__ __forceinline__ float* LF() const { return (float*)(a->ws + WS_LF); }
    __device__ __forceinline__ float* C() const { return (float*)(a->ws + WS_C); }
    __device__ __forceinline__ float* SUMP() const { return (float*)(a->ws + WS_SUMP); }
    __device__ __forceinline__ float* SUME() const { return (float*)(a->ws + WS_SUME); }
    __device__ __forceinline__ float* CARRY() const { return (float*)(a->ws + WS_CARRY); }
    __device__ __forceinline__ int* LIST() const { return (int*)(a->ws + WS_LIST); }
    __device__ __forceinline__ int* PAIR() const { return (int*)(a->ws + WS_PAIR); }
    __device__ __forceinline__ float* TOPW() const { return (float*)(a->ws + WS_TOPW); }
    __device__ __forceinline__ int* CNT() const { return (int*)(a->ws + WS_CNT); }
    __device__ __forceinline__ bf16_t* XN() const { return (bf16_t*)(a->ws + WS_XN); }
    __device__ __forceinline__ bf16_t* PROJ() const { return (bf16_t*)(a->ws + WS_PROJ); }
    __device__ __forceinline__ bf16_t* HIDC() const { return (bf16_t*)(a->ws + WS_PROJ + WS_HIDC_OFF); }
    __device__ __forceinline__ bf16_t* Y() const { return (bf16_t*)(a->ws + WS_PROJ + WS_Y_OFF); }
};

__device__ __forceinline__ const float* hsrc_row(const Ctx& c, int layer, int rr) {
    if (layer == 0) return rr < R ? c.x() + (size_t)rr * D : c.meta() + (size_t)(rr - R) * D;
    return rr < R ? c.out() + (size_t)rr * D : c.hmeta() + (size_t)(rr - R) * D;
}
__device__ __forceinline__ float* hdst_row(const Ctx& c, int rr) {
    return rr < R ? c.out() + (size_t)rr * D : c.hmeta() + (size_t)(rr - R) * D;
}

__device__ __forceinline__ void norm_load(const float* src, float4 (&nx)[4], int lane) {
#pragma unroll
    for (int i = 0; i < 4; ++i) nx[i] = *(const float4*)(src + i * 256 + lane * 4);
}
__device__ __forceinline__ void norm_take(const float4 (&nx)[4], float (&v)[16]) {
#pragma unroll
    for (int i = 0; i < 4; ++i) { v[4 * i] = nx[i].x; v[4 * i + 1] = nx[i].y; v[4 * i + 2] = nx[i].z; v[4 * i + 3] = nx[i].w; }
}
__device__ __forceinline__ void gain_load(const float* gain, float4 (&gv)[4], int lane) {
#pragma unroll
    for (int i = 0; i < 4; ++i) gv[i] = *(const float4*)(gain + i * 256 + lane * 4);
}
__device__ __forceinline__ void norm_row(const float4 (&gv)[4], bf16_t* dst, float (&v)[16], int lane) {
    float ss = 0.f;
#pragma unroll
    for (int k = 0; k < 16; ++k) ss += v[k] * v[k];
    ss = wave_sum(ss);
    const float rstd = rsqrtf(ss * (1.f / D) + RMS_EPS);
#pragma unroll
    for (int i = 0; i < 4; ++i) {
        const float4 g = gv[i];
        v[4 * i] *= rstd * g.x; v[4 * i + 1] *= rstd * g.y; v[4 * i + 2] *= rstd * g.z; v[4 * i + 3] *= rstd * g.w;
        uint2 o; o.x = pack2(v[4 * i], v[4 * i + 1]); o.y = pack2(v[4 * i + 2], v[4 * i + 3]);
        *(uint2*)(dst + i * 256 + lane * 4) = o;
    }
}
__device__ __forceinline__ void phase_norm(const Ctx& c, int layer, int mode) {
    const int lane = c.lane;
    const float* gain = (mode == 0 ? c.g_mix() : c.g_ffn()) + layer * D;
    float4 gv[4]; gain_load(gain, gv, lane);
    if (mode == 1 && layer == 1) {
        int* lcnt = (int*)c.smem;
        int* ent = lcnt + 16;
        float* entw = (float*)(ent + 512);
        float4* rw = (float4*)(c.smem + 1024);
        __syncthreads();
        for (int idx = c.tid; idx < 2 * D; idx += NTHR) {
            const int col = idx >> 1, h = idx & 1;
            rw[(((col >> 8) * 4 + (col & 3)) * 2 + h) * 64 + ((col >> 2) & 63)] = *(const float4*)(c.router_w() + (size_t)col * 8 + h * 4);
        }
        for (int chunk = blockIdx.x; chunk < R / 128; chunk += gridDim.x) {
            __syncthreads();
            if (c.tid < 16) lcnt[c.tid] = 0;
            __syncthreads();
            float4 nx[4];
            norm_load(c.out() + (size_t)(chunk * 128 + c.wave * 16) * D, nx, lane);
            for (int i = 0; i < 16; ++i) {
                const int lr = c.wave * 16 + i, rr = chunk * 128 + lr;
                float v[16];
                norm_take(nx, v);
                if (i < 15) norm_load(c.out() + (size_t)(rr + 1) * D, nx, lane);
                norm_row(gv, c.XN() + (size_t)rr * D, v, lane);
                float lg[8];
#pragma unroll
                for (int e = 0; e < 8; ++e) lg[e] = 0.f;
#pragma unroll
                for (int q = 0; q < 4; ++q)
#pragma unroll
                    for (int j = 0; j < 4; ++j) {
                        const float4 w0 = rw[((q * 4 + j) * 2) * 64 + lane];
                        const float4 w1 = rw[((q * 4 + j) * 2 + 1) * 64 + lane];
                        const float y = v[4 * q + j];
                        lg[0] += y * w0.x; lg[1] += y * w0.y; lg[2] += y * w0.z; lg[3] += y * w0.w;
                        lg[4] += y * w1.x; lg[5] += y * w1.y; lg[6] += y * w1.z; lg[7] += y * w1.w;
                    }
#pragma unroll
                for (int e = 0; e < 8; ++e) lg[e] = wave_sum(lg[e]);
                int i1 = 0; float v1 = lg[0];
#pragma unroll
                for (int e = 1; e < 8; ++e) if (lg[e] > v1) { v1 = lg[e]; i1 = e; }
                int i2 = -1; float v2 = -3.0e38f;
#pragma unroll
                for (int e = 0; e < 8; ++e) if (e != i1 && lg[e] > v2) { v2 = lg[e]; i2 = e; }
                const float w1 = 1.f / (1.f + expf(v2 - v1)), w2 = 1.f - w1;
                if (lane == 0) {
                    const int r1 = atomicAdd(&lcnt[i1], 1), r2 = atomicAdd(&lcnt[i2], 1);
                    ent[(lr * 2) * 2] = (rr << 3) | i1; ent[(lr * 2) * 2 + 1] = r1; entw[lr * 2] = w1;
                    ent[(lr * 2 + 1) * 2] = (rr << 3) | i2; ent[(lr * 2 + 1) * 2 + 1] = r2; entw[lr * 2 + 1] = w2;
                }
            }
            __syncthreads();
            if (c.tid < 8) lcnt[8 + c.tid] = atomicAdd(&c.CNT()[c.tid], lcnt[c.tid]);
            __syncthreads();
            if (c.tid < 256) {
                const int k = c.tid;
                const int re = ent[k * 2], e = re & 7, rr = re >> 3;
                const int pos = lcnt[8 + e] + ent[k * 2 + 1];
                c.LIST()[(size_t)e * R + pos] = rr;
                c.PAIR()[(size_t)rr * 2 + (k & 1)] = (e << 20) | pos;
                c.TOPW()[(size_t)rr * 2 + (k & 1)] = entw[k];
            }
        }
        return;
    }
    const int nrows = RT;
    float4* wfs = (float4*)c.smem;
    if (mode == 0) {
        const float* wf = c.w_in() + (size_t)layer * D * INC + 1536;
        __syncthreads();
        for (int k = c.tid; k < D; k += NTHR) wfs[((k >> 8) * 4 + (k & 3)) * 64 + ((k >> 2) & 63)] = *(const float4*)(wf + (size_t)k * INC);
        __syncthreads();
    }
    float4 nx[4];
    const float bfg = mode == 0 ? c.b_forget()[layer * 4 + (lane & 3)] : 0.f;
    const int rstep = gridDim.x * 8;
    { const int r0 = blockIdx.x * 8 + c.wave; if (r0 < nrows) norm_load((mode == 0) ? hsrc_row(c, layer, r0) : hdst_row(c, r0), nx, lane); }
    for (int rr = blockIdx.x * 8 + c.wave; rr < nrows; rr += rstep) {
        float v[16];
        norm_take(nx, v);
        if (rr + rstep < nrows) norm_load((mode == 0) ? hsrc_row(c, layer, rr + rstep) : hdst_row(c, rr + rstep), nx, lane);
        norm_row(gv, c.XN() + (size_t)rr * D, v, lane);
        if (mode == 0) {
            float d0 = 0.f, d1 = 0.f, d2 = 0.f, d3 = 0.f;
#pragma unroll
            for (int i = 0; i < 4; ++i)
#pragma unroll
                for (int j = 0; j < 4; ++j) {
                    const float4 w = wfs[(i * 4 + j) * 64 + lane];
                    const float y = v[4 * i + j];
                    d0 += y * w.x; d1 += y * w.y; d2 += y * w.z; d3 += y * w.w;
                }
            d0 = wave_sum(d0); d1 = wave_sum(d1); d2 = wave_sum(d2); d3 = wave_sum(d3);
            if (lane < 4) {
                const float dsel = lane == 0 ? d0 : lane == 1 ? d1 : lane == 2 ? d2 : d3;
                c.LF()[(size_t)rr * 4 + lane] = logsigf_(dsel + bfg);
            }
        }
    }
}

constexpr size_t WS_CT = 131072;
__device__ __forceinline__ void side_cumsum(const Ctx& c) {
    const int lane = c.lane;
    float* CT = (float*)(c.a->ws + WS_CT);
    for (int idx = blockIdx.x * 8 + c.wave; idx < 16 * (S / 64); idx += gridDim.x * 8) {
        const int seq = idx >> 7, chunk = idx & 127, b = seq >> 2, h = seq & 3;
        const size_t rr = (size_t)b * S + 64 * chunk + lane;
        float sc = c.LF()[rr * 4 + h];
#pragma unroll
        for (int o = 1; o < 64; o <<= 1) { const float t = __shfl_up(sc, o); if (lane >= o) sc += t; }
        c.C()[rr * 4 + h] = sc;
        if (lane == 63) CT[seq * 128 + chunk] = sc;
        if (b == 0 && chunk == 0) {
            float v = lane < NM ? c.LF()[(size_t)(R + lane) * 4 + h] : 0.f;
#pragma unroll
            for (int o = 1; o < 16; o <<= 1) { const float t = __shfl_up(v, o); if (lane >= o) v += t; }
            if (lane < NM) c.C()[(size_t)(R + lane) * 4 + h] = v;
        }
    }
}

__device__ __forceinline__ int key_row(int b, int g) { return g < NM ? R + g : b * S + g - NM; }

__device__ __forceinline__ float qk_dot(const float* qs, const bf16_t* kp) {
    float dot = 0.f;
#pragma unroll 4
    for (int dd = 0; dd < 16; ++dd) {
        const uint4 kk = *(const uint4*)(kp + dd * 8);
        const float4 qa = *(const float4*)(qs + dd * 8), qb = *(const float4*)(qs + dd * 8 + 4);
        dot += qa.x * bflo(kk.x) + qa.y * bfhi(kk.x) + qa.z * bflo(kk.y) + qa.w * bfhi(kk.y)
             + qb.x * bflo(kk.z) + qb.y * bfhi(kk.z) + qb.z * bflo(kk.w) + qb.w * bfhi(kk.w);
    }
    return dot;
}

__device__ __forceinline__ void attn_query(const Ctx& c, int type, int rr, int h) {
    const int lane = c.lane;
    int b, pg;
    if (rr < R) { b = rr >> 13; pg = NM + (rr & (S - 1)); } else { b = 0; pg = rr - R; }
    const int cq = type == 0 ? C_FQ : C_SQ, ck = type == 0 ? C_FK : C_SK, cv = type == 0 ? C_FV : C_SV;
    bf16_t* qrow = c.PROJ() + (size_t)rr * PC + cq + h * 128;
    float* q = c.smem + c.wave * 128;
    const float scale = 0.08838834764831845f;
    q[lane] = bf2f(qrow[lane]) * scale; q[lane + 64] = bf2f(qrow[lane + 64]) * scale;
    float a0 = 0.f, a1 = 0.f;
    if (type == 0) {
        float m = -1e30f, l = 0.f;
        const float cqv = c.C()[(size_t)rr * 4 + h];
        const int nk = pg + 1;
        for (int g0 = 0; g0 < nk; g0 += 64) {
            const int g = g0 + lane; const bool valid = g < nk;
            const int krow = key_row(b, valid ? g : 0);
            const float dot = qk_dot(q, c.PROJ() + (size_t)krow * PC + ck + h * 128);
            const float sc = valid ? dot + cqv - c.C()[(size_t)krow * 4 + h] : -__builtin_inff();
            const float mn = fmaxf(m, wave_max(sc));
            const float p = valid ? expf(sc - mn) : 0.f;
            const float alpha = expf(m - mn);
            l = l * alpha + wave_sum(p); a0 *= alpha; a1 *= alpha; m = mn;
            const int cnt = min(64, nk - g0);
            for (int j = 0; j < cnt; ++j) {
                const float pj = __shfl(p, j);
                const int vrow = key_row(b, g0 + j);
                const unsigned vv = *(const unsigned*)(c.PROJ() + (size_t)vrow * PC + cv + h * 128 + lane * 2);
                a0 += pj * bflo(vv); a1 += pj * bfhi(vv);
            }
        }
        const float inv = 1.f / l; a0 *= inv; a1 *= inv;
    } else {
        float Rrun = 0.f;
        for (int gtop = pg - 1; gtop >= 0; gtop -= 64) {
            const int g = gtop - lane; const bool valid = g >= 0;
            const int krow = key_row(b, valid ? g : 0);
            const float z = qk_dot(q, c.PROJ() + (size_t)krow * PC + ck + h * 128);
            const float sp = softplusf_(z);
            const float mval = valid ? -sp : 0.f;
            float sc = mval;
#pragma unroll
            for (int o = 1; o < 64; o <<= 1) { const float t = __shfl_up(sc, o); if (lane >= o) sc += t; }
            const float excl = sc - mval;
            const float p = valid ? expf(z - sp + Rrun + excl) : 0.f;
            const int cnt = min(64, gtop + 1);
            for (int j = 0; j < cnt; ++j) {
                const float pj = __shfl(p, j);
                const int vrow = key_row(b, gtop - j);
                const unsigned vv = *(const unsigned*)(c.PROJ() + (size_t)vrow * PC + cv + h * 128 + lane * 2);
                a0 += pj * bflo(vv); a1 += pj * bfhi(vv);
            }
            Rrun += __shfl(sc, 63);
            if (Rrun < -110.f) break;
        }
    }
    *(unsigned*)(qrow + lane * 2) = pack2(a0, a1);
}

typedef short lru_bf16x8 __attribute__((ext_vector_type(8)));
typedef float lru_f32x16 __attribute__((ext_vector_type(16)));
typedef unsigned lru_u32x4 __attribute__((ext_vector_type(4)));
constexpr int USS = 68;
typedef float cvt_f32x2 __attribute__((ext_vector_type(2)));
typedef __bf16 cvt_bf16x2 __attribute__((ext_vector_type(2)));
__device__ __forceinline__ unsigned lru_cvt_pk(float lo, float hi) { const cvt_f32x2 f = {lo, hi}; return __builtin_bit_cast(unsigned, __builtin_convertvector(f, cvt_bf16x2)); }
__device__ __forceinline__ void split8(const float (&x)[8], lru_bf16x8& hi, lru_bf16x8& lo) {
    unsigned h[4], l[4];
#pragma unroll
    for (int e = 0; e < 4; ++e) {
        h[e] = lru_cvt_pk(x[2 * e], x[2 * e + 1]);
        l[e] = lru_cvt_pk(x[2 * e] - __uint_as_float(h[e] << 16), x[2 * e + 1] - __uint_as_float(h[e] & 0xFFFF0000u));
    }
    const lru_u32x4 hv = {h[0], h[1], h[2], h[3]};
    const lru_u32x4 lv = {l[0], l[1], l[2], l[3]};
    hi = __builtin_bit_cast(lru_bf16x8, hv); lo = __builtin_bit_cast(lru_bf16x8, lv);
}
constexpr int TPT = LCH / 8;
struct LruIn { float x[TPT + 3]; float g[TPT]; float carry; };
struct LruIn2 { float ci[TPT]; };
struct LruCh { float w0, w1, w2, w3, cb, bav, bxv, spl; };
template <bool META>
__device__ __forceinline__ void lru_load(const Ctx& c, int seq, int chunk, int n, int pass, int tid, LruIn& in) {
    const int len = META ? NM : LCH;
    const int gbase = seq == 4 ? 0 : NM + chunk * LCH;
    const int b = seq == 4 ? 0 : seq;
    const int ch = tid & 63, sg = tid >> 6;
    const bf16_t* PROJ = c.PROJ();
#pragma unroll
    for (int k = 0; k < TPT + 3; ++k) {
        const int t = sg * TPT + k - 3; const int g = gbase + t;
        const bool ok = META ? (t < len && g >= 0) : true;
        const float v = bf2f(PROJ[(size_t)key_row(b, ok ? g : 0) * PC + C_LX + n * 64 + ch]);
        in.x[k] = ok ? v : 0.f;
    }
    in.carry = 0.f;
    if (pass == 1) {
#pragma unroll
        for (int tt = 0; tt < TPT; ++tt) { const int t = sg * TPT + tt; const float gv = bf2f(PROJ[(size_t)key_row(b, gbase + (t < len ? t : 0)) * PC + C_LG + n * 64 + ch]); in.g[tt] = t < len ? gv : 0.f; }
        if (seq != 4) in.carry = c.CARRY()[(size_t)(seq * NLC + chunk) * 512 + n * 64 + ch];
    }
}
template <bool META>
__device__ __forceinline__ void lru_item(const Ctx& c, int seq, int chunk, int n, int pass, const LruIn& in, const LruCh& kc, const lru_bf16x8 (&wbh)[4], const lru_bf16x8 (&wbl)[4]) {
    float* us = c.smem;
    float* as_ = us + LCH * USS;
    float* is_ = as_ + LCH * 64;
    float* sgP = is_ + LCH * 64;
    float* sgE = sgP + 8 * 64;
    int tid = threadIdx.x; asm volatile("" : "+v"(tid));
    const int len = META ? NM : LCH;
    const int gbase = seq == 4 ? 0 : NM + chunk * LCH;
    const int b = seq == 4 ? 0 : seq;
    const int ch = tid & 63, sg = tid >> 6;
    const int cidx = n * 64 + ch;
    bf16_t* PROJ = c.PROJ();
    lds_barrier();
    __builtin_amdgcn_sched_barrier(0);
#pragma unroll
    for (int tt = 0; tt < TPT; ++tt) {
        const int t = sg * TPT + tt;
        us[t * USS + ch] = (!META || t < len) ? kc.cb + kc.w0 * in.x[tt] + kc.w1 * in.x[tt + 1] + kc.w2 * in.x[tt + 2] + kc.w3 * in.x[tt + 3] : 0.f;
    }
    lds_barrier();
    __builtin_amdgcn_sched_barrier(0);
    {
        const int wv = tid >> 6, lane = tid & 63, tj = wv & 1, ql = lane & 31, kg = lane >> 5;
        float* dst = (wv >> 2) ? is_ : as_;
#pragma unroll
        for (int tb = 0; tb < LCH / 64; ++tb) {
            const int tq = ((wv >> 1) & 1) + 2 * tb;
            lru_f32x16 acc;
#pragma unroll
            for (int r = 0; r < 16; ++r) acc[r] = 0.f;
            const float* urow = us + (32 * tq + ql) * USS + 8 * kg;
#pragma unroll
            for (int ks = 0; ks < 4; ++ks) {
                const float4 u0 = *(const float4*)(urow + 16 * ks), u1 = *(const float4*)(urow + 16 * ks + 4);
                const float x[8] = {u0.x, u0.y, u0.z, u0.w, u1.x, u1.y, u1.z, u1.w};
                lru_bf16x8 ah, al; split8(x, ah, al);
                acc = __builtin_amdgcn_mfma_f32_32x32x16_bf16(ah, wbh[ks], acc, 0, 0, 0);
                acc = __builtin_amdgcn_mfma_f32_32x32x16_bf16(al, wbh[ks], acc, 0, 0, 0);
                acc = __builtin_amdgcn_mfma_f32_32x32x16_bf16(ah, wbl[ks], acc, 0, 0, 0);
            }
#pragma unroll
            for (int r = 0; r < 16; ++r) dst[(32 * tq + (r & 3) + 8 * (r >> 2) + 4 * kg) * 64 + 32 * tj + ql] = acc[r];
        }
    }
    lds_barrier();
    __builtin_amdgcn_sched_barrier(0);
    float P = 1.f, E = 0.f;
    bf16_t* cp0 = PROJ + (size_t)(b * S + chunk * LCH + sg * TPT) * PC + cidx;
#pragma unroll
    for (int tt = 0; tt < TPT; ++tt) {
        const int t = sg * TPT + tt;
        const float r = __builtin_amdgcn_rcpf(1.f + __builtin_amdgcn_exp2f(-1.4426950408889634f * (as_[t * 64 + ch] + kc.bav)));
        const float gi = __builtin_amdgcn_rcpf(1.f + __builtin_amdgcn_exp2f(-1.4426950408889634f * (is_[t * 64 + ch] + kc.bxv)));
        const float la = -8.f * r * kc.spl;
        const float av = __builtin_amdgcn_exp2f(1.4426950408889634f * la);
        const float a = (!META || t < len) ? av : 1.f;
        const float inp = (!META || t < len) ? __builtin_amdgcn_sqrtf(fmaxf(1.f - av * av, 0.f)) * gi * us[t * USS + ch] : 0.f;
        if (META || pass != 0) { as_[t * 64 + ch] = a; is_[t * 64 + ch] = inp; }
        E = a * E + inp; P *= a;
        if (!META && pass == 0) {
            cp0[(size_t)tt * PC + C_FV] = f2bf(1.f - av); cp0[(size_t)tt * PC + C_SV] = f2bf(inp);
        }
    }
    sgP[sg * 64 + ch] = P; sgE[sg * 64 + ch] = E;
    lds_barrier();
    __builtin_amdgcn_sched_barrier(0);
    const size_t sidx = (size_t)(seq == 4 ? 4 * NLC : seq * NLC + chunk) * 512 + cidx;
    if (pass == 0) {
        if (sg == 0) {
            float Pt = 1.f, Et = 0.f;
#pragma unroll
            for (int q = 0; q < 8; ++q) { const float pq = sgP[q * 64 + ch]; Et = pq * Et + sgE[q * 64 + ch]; Pt *= pq; }
            c.SUMP()[sidx] = Pt; c.SUME()[sidx] = Et;
        }
    } else {
        float hst = in.carry;
#pragma unroll
        for (int q = 0; q < 7; ++q) if (q < sg) hst = sgP[q * 64 + ch] * hst + sgE[q * 64 + ch];
#pragma unroll
        for (int tt = 0; tt < TPT; ++tt) {
            const int t = sg * TPT + tt;
            hst = as_[t * 64 + ch] * hst + is_[t * 64 + ch];
            if (t < len) {
                const float x = in.g[tt];
                const float uarg = 0.7978845608028654f * (x + 0.044715f * x * x * x);
                PROJ[(size_t)key_row(b, gbase + t) * PC + C_LG + cidx] = f2bf(hst * x * __builtin_amdgcn_rcpf(1.f + __builtin_amdgcn_exp2f(-2.885390081777927f * uarg)));
            }
        }
    }
}

__device__ __forceinline__ void lru_loadB(const Ctx& c, int b, int chunk, int n, int tid, LruIn& in, LruIn2& in2) {
    const int ch = tid & 63, sg = tid >> 6;
    const bf16_t* P0 = c.PROJ() + (size_t)(b * S + chunk * LCH + sg * TPT) * PC + n * 64 + ch;
#pragma unroll
    for (int tt = 0; tt < TPT; ++tt) {
        in.x[tt] = bf2f(P0[(size_t)tt * PC + C_FV]);
        in2.ci[tt] = bf2f(P0[(size_t)tt * PC + C_SV]);
        in.g[tt] = bf2f(P0[(size_t)tt * PC + C_LG]);
    }
    in.carry = c.CARRY()[(size_t)(b * NLC + chunk) * 512 + n * 64 + ch];
}
__device__ __forceinline__ void lru_itemB(const Ctx& c, int b, int chunk, int n, const LruIn& in, const LruIn2& in2) {
    float* sgP = c.smem; float* sgE = sgP + 8 * 64;
    int tid = threadIdx.x; asm volatile("" : "+v"(tid));
    const int ch = tid & 63, sg = tid >> 6;
    float P = 1.f, E = 0.f;
#pragma unroll
    for (int tt = 0; tt < TPT; ++tt) { const float a = 1.f - in.x[tt]; E = a * E + in2.ci[tt]; P *= a; }
    lds_barrier();
    sgP[sg * 64 + ch] = P; sgE[sg * 64 + ch] = E;
    lds_barrier();
    float hst = in.carry;
#pragma unroll
    for (int q = 0; q < 7; ++q) if (q < sg) hst = sgP[q * 64 + ch] * hst + sgE[q * 64 + ch];
    bf16_t* O0 = c.PROJ() + (size_t)(b * S + chunk * LCH + sg * TPT) * PC + C_LG + n * 64 + ch;
#pragma unroll
    for (int tt = 0; tt < TPT; ++tt) {
        hst = (1.f - in.x[tt]) * hst + in2.ci[tt];
        const float x = in.g[tt];
        const float uarg = 0.7978845608028654f * (x + 0.044715f * x * x * x);
        O0[(size_t)tt * PC] = f2bf(hst * x * __builtin_amdgcn_rcpf(1.f + __builtin_amdgcn_exp2f(-2.885390081777927f * uarg)));
    }
}

__device__ __forceinline__ void phase_lru(const Ctx& c, int layer, int pass) {
    const int n = blockIdx.x & 7, G8 = gridDim.x >> 3;
    lru_bf16x8 wbh[4], wbl[4];
    LruCh kc;
    {
        const int wv = c.tid >> 6, lane = c.tid & 63, j = 32 * (wv & 1) + (lane & 31), kg = lane >> 5;
        const float* w = ((wv >> 2) ? c.wx() : c.wa()) + ((size_t)layer * 8 + n) * 4096 + j;
#pragma unroll
        for (int ks = 0; ks < 4; ++ks) {
            float x[8];
#pragma unroll
            for (int e = 0; e < 8; ++e) x[e] = w[(16 * ks + 8 * kg + e) * 64];
            split8(x, wbh[ks], wbl[ks]);
        }
        const int cidx = n * 64 + (c.tid & 63);
        const float* cw = c.conv_w() + (size_t)layer * 4 * 512 + cidx;
        kc.w0 = cw[0]; kc.w1 = cw[512]; kc.w2 = cw[1024]; kc.w3 = cw[1536]; kc.cb = c.conv_b()[layer * 512 + cidx];
        kc.bav = c.ba()[layer * 512 + cidx]; kc.bxv = c.bx()[layer * 512 + cidx]; kc.spl = softplusf_(-c.lam()[layer * 512 + cidx]);
    }
    if ((blockIdx.x >> 3) == 0) { LruIn mi; lru_load<true>(c, 4, 0, n, pass, c.tid, mi); lru_item<true>(c, 4, 0, n, pass, mi, kc, wbh, wbl); }
    int j = blockIdx.x >> 3;
    if (pass == 1) {
        LruIn cur, nx1; LruIn2 cur2, nx12;
        if (j < NB * NLC) lru_loadB(c, j / NLC, j % NLC, n, c.tid, cur, cur2);
        { const int j1 = j + G8 < NB * NLC ? j + G8 : j; if (j < NB * NLC) lru_loadB(c, j1 / NLC, j1 % NLC, n, c.tid, nx1, nx12); }
        for (; j < NB * NLC; j += G8) {
            LruIn nx2; LruIn2 nx22;
            const int jn = j + 2 * G8 < NB * NLC ? j + 2 * G8 : j;
            lru_loadB(c, jn / NLC, jn % NLC, n, c.tid, nx2, nx22);
            lru_itemB(c, j / NLC, j % NLC, n, cur, cur2);
            cur = nx1; cur2 = nx12; nx1 = nx2; nx12 = nx22;
        }
    } else {
        LruIn cur;
        if (j < NB * NLC) lru_load<false>(c, j / NLC, j % NLC, n, pass, c.tid, cur);
        for (; j < NB * NLC; j += G8) {
            LruIn nxt;
            const int jn = j + G8 < NB * NLC ? j + G8 : j;
            lru_load<false>(c, jn / NLC, jn % NLC, n, pass, c.tid, nxt);
            lru_item<false>(c, j / NLC, j % NLC, n, pass, cur, kc, wbh, wbl);
            cur = nxt;
        }
    }
    __syncthreads();
}
__device__ __forceinline__ void phase_lru_carry(const Ctx& c) {
    if (blockIdx.x >= 32 || threadIdx.x >= 64) return;
    const int b = blockIdx.x >> 3, ch = (blockIdx.x & 7) * 64 + threadIdx.x;
    const float* Pp = c.SUMP() + (size_t)b * NLC * 512 + ch; const float* Ep = c.SUME() + (size_t)b * NLC * 512 + ch;
    float* Cp = c.CARRY() + (size_t)b * NLC * 512 + ch;
    float hst = c.SUME()[(size_t)(4 * NLC) * 512 + ch];
    for (int c0 = 0; c0 < NLC; c0 += 8) {
        float pv[8], ev[8];
#pragma unroll
        for (int q = 0; q < 8; ++q) { pv[q] = Pp[(size_t)(c0 + q) * 512]; ev[q] = Ep[(size_t)(c0 + q) * 512]; }
#pragma unroll
        for (int q = 0; q < 8; ++q) { Cp[(size_t)(c0 + q) * 512] = hst; hst = pv[q] * hst + ev[q]; }
    }
}

__device__ __forceinline__ void phase_attn(const Ctx& c, int layer) {
    phase_lru(c, layer, 0);
    const int nitems = layer == 1 ? 0 : NM * 8;
    for (int it = blockIdx.x * 8 + c.wave; it < nitems; it += gridDim.x * 8) {
        const int rr = R + it % NM, hh = it / NM;
        attn_query(c, hh >> 2, rr, hh & 3);
    }
}

namespace g8 {
constexpr int BM = 256, BK = 64, HALF = 128, HTB = HALF * BK * 2, STAGE_BYTES = 8 * HTB, NXCD = 8, WGM = 8;
typedef short bf16x8 __attribute__((ext_vector_type(8)));
typedef float f32x4 __attribute__((ext_vector_type(4)));
typedef unsigned u32x4 __attribute__((ext_vector_type(4)));
__device__ __forceinline__ int lds_byte(int r, int c) { const int st = (r >> 4) * 2 + (c >> 5), rr = r & 15, cc = c & 31, ob = rr * 64 + cc * 2; return st * 1024 + (ob ^ (((ob >> 9) & 1) << 5)); }
__device__ __forceinline__ void stage_rc(int b, int& R_, int& C_) { const int st = b / 1024, sb = b % 1024, swz = sb ^ (((sb >> 9) & 1) << 5); R_ = (st >> 1) * 16 + swz / 64; C_ = (st & 1) * 32 + (swz % 64) / 2; }
__device__ __forceinline__ int perm32(int rho) { const int n = rho >> 4, i = rho & 15; return 8 * (i >> 2) + 4 * n + (i & 3); }
__device__ __forceinline__ unsigned cvt_pk_bf16(float lo, float hi) { const cvt_f32x2 f = {lo, hi}; return __builtin_bit_cast(unsigned, __builtin_convertvector(f, cvt_bf16x2)); }

struct Unit {
    unsigned A;
    unsigned B;
    const int* gidx;
    int gcnt;
    int lda;
    int K;
    int tag;
    int pm, pn;
};

__device__ __forceinline__ void tile_of(int L, int nM, int nN, int& pm, int& pn) {
    const int nwg = nM * nN; int wgid = L;
    { const int q = nwg / NXCD, r = nwg % NXCD, xcd = wgid % NXCD, off = wgid / NXCD; wgid = (xcd < r ? xcd * (q + 1) : r * (q + 1) + (xcd - r) * q) + off; }
    const int nig = WGM * nN, gid = wgid / nig, fm = gid * WGM, gsz = (nM - fm) < WGM ? (nM - fm) : WGM;
    pm = fm + ((wgid % nig) % gsz); pn = (wgid % nig) / gsz;
}

template <bool PERM, bool GATHER>
__device__ __forceinline__ void mk_off(const Unit& u, int tid, unsigned (&vA)[2][2], unsigned (&vB)[2]) {
    int sR[2], sC[2];
#pragma unroll
    for (int i = 0; i < 2; ++i) stage_rc(tid * 16 + i * 8192, sR[i], sC[i]);
#pragma unroll
    for (int i = 0; i < 2; ++i) {
        if (GATHER) {
#pragma unroll
            for (int h = 0; h < 2; ++h) { const int r = h * HALF + sR[i]; const int idx = u.gidx[r < u.gcnt ? r : 0]; vA[h][i] = (unsigned)idx * (unsigned)u.lda + (unsigned)sC[i] * 2u; }
        } else {
            vA[0][i] = (unsigned)sR[i] * (unsigned)u.lda + (unsigned)sC[i] * 2u; vA[1][i] = 0u;
        }
        const int Rb = PERM ? ((sR[i] & ~31) + perm32(sR[i] & 31)) : sR[i];
        vB[i] = ((unsigned)Rb * (unsigned)u.K + (unsigned)sC[i]) * 2u;
    }
}

#define G8_SA(b, h) (((b) * 2 + (h)) * HTB)
#define G8_SB(b, h) ((4 + (b) * 2 + (h)) * HTB)
#define G8_GLL(gp, lp) __builtin_amdgcn_global_load_lds((const unsigned*)(gp), (LAS unsigned*)(lp), 16, 0, 0)
#define G8_STAGE(bufoff, gbase, v0, v1) do { G8_GLL(wsb + (unsigned)((gbase) + (v0)), lds + (bufoff) + ldsw); G8_GLL(wsb + (unsigned)((gbase) + (v1)), lds + (bufoff) + ldsw + 8192); } while (0)
#define G8_LDA(dst, b, h) do { _Pragma("unroll") for (int m = 0; m < 4; ++m) _Pragma("unroll") for (int k = 0; k < 2; ++k) dst[m][k] = *(const LAS bf16x8*)(lds + G8_SA(b, h) + aoff + m * 2048 + k * 1024); } while (0)
#define G8_LDB(dst, b, h) do { _Pragma("unroll") for (int n = 0; n < 2; ++n) _Pragma("unroll") for (int k = 0; k < 2; ++k) dst[n][k] = *(const LAS bf16x8*)(lds + G8_SB(b, h) + boff + n * 2048 + k * 1024); } while (0)
#define G8_MMA(ai, bj, At, Bt) do { __builtin_amdgcn_s_setprio(1); _Pragma("unroll") for (int m = 0; m < 4; ++m) _Pragma("unroll") for (int n = 0; n < 2; ++n) _Pragma("unroll") for (int k = 0; k < 2; ++k) \
        acc[ai][bj][m][n] = __builtin_amdgcn_mfma_f32_16x16x32_bf16(Bt[n][k], At[m][k], acc[ai][bj][m][n], 0, 0, 0); __builtin_amdgcn_s_setprio(0); } while (0)
#define G8_WAIT_V(n) asm volatile("s_waitcnt vmcnt(" #n ")" ::: "memory")
#define G8_WAIT_L(n) asm volatile("s_waitcnt lgkmcnt(" #n ")" ::: "memory")
#define G8_BAR __builtin_amdgcn_s_barrier()
#define G8_SCHED __builtin_amdgcn_sched_barrier(0)

template <bool PERM, bool GATHER, class Sched, class Epi>
__device__ __forceinline__ void gemm_stream(LAS unsigned char* lds, const char* wsb, const Sched& S, const Epi& E) {
    int tid = threadIdx.x; asm volatile("" : "+v"(tid));
    const int wid = __builtin_amdgcn_readfirstlane(tid >> 6), lane = tid & 63, wr = wid >> 2, wc = wid & 3, fr = lane & 15, fq = lane >> 4;
    const unsigned ldsw = (unsigned)wid * 1024u;
    const int aoff = lds_byte(wr * 64 + fr, fq * 8), boff = lds_byte(wc * 32 + fr, fq * 8);
    Unit cur, nxt; int ui = 0;
    if (!S.next(0, cur)) return;
    f32x4 acc[2][2][4][2];
#pragma unroll
    for (int a = 0; a < 2; ++a)
#pragma unroll
        for (int b = 0; b < 2; ++b)
#pragma unroll
            for (int m = 0; m < 4; ++m)
#pragma unroll
                for (int n = 0; n < 2; ++n) acc[a][b][m][n] = (f32x4){0.f, 0.f, 0.f, 0.f};
    bf16x8 At[4][2], B0[2][2], B1[2][2];
    unsigned cvA[2][2], cvB[2], nvA[2][2], nvB[2];
    mk_off<PERM, GATHER>(cur, tid, cvA, cvB);
    constexpr int H1 = GATHER ? 1 : 0;
    unsigned cA = cur.A, cB = cur.B; unsigned chB = (unsigned)HALF * cur.K * 2; unsigned chA = GATHER ? 0u : (unsigned)HALF * cur.lda;
    const unsigned kstep = (unsigned)(BK * 2);
    G8_STAGE(G8_SB(0, 0), cB, cvB[0], cvB[1]); G8_STAGE(G8_SA(0, 0), cA, cvA[0][0], cvA[0][1]); G8_STAGE(G8_SB(0, 1), cB + chB, cvB[0], cvB[1]); G8_STAGE(G8_SA(0, 1), cA + chA, cvA[H1][0], cvA[H1][1]);
    if (wr == 1) G8_BAR;
    G8_WAIT_V(4); G8_BAR;
    G8_STAGE(G8_SB(1, 0), cB + kstep, cvB[0], cvB[1]); G8_STAGE(G8_SA(1, 0), cA + kstep, cvA[0][0], cvA[0][1]); G8_STAGE(G8_SB(1, 1), cB + chB + kstep, cvB[0], cvB[1]);
    G8_WAIT_V(6); G8_BAR;
    for (;;) {
        const bool has_next = S.next(ui + 1, nxt);
        if (!has_next) nxt = cur;
        mk_off<PERM, GATHER>(nxt, tid, nvA, nvB);
        const unsigned nA = nxt.A, nB = nxt.B; const unsigned nhB = (unsigned)HALF * nxt.K * 2; const unsigned nhA = GATHER ? 0u : (unsigned)HALF * nxt.lda;
        const int nt = cur.K / BK;
        for (int t = 0; t < nt; t += 2) {
            const bool last = (t == nt - 2);
            const unsigned a1 = cA + (unsigned)(t + 1) * kstep;
            const unsigned a2 = last ? nA : cA + (unsigned)(t + 2) * kstep, b2 = last ? nB : cB + (unsigned)(t + 2) * kstep;
            const unsigned a3 = a2 + kstep, b3 = b2 + kstep;
            const unsigned hB2 = last ? nhB : chB, hA2 = last ? nhA : chA;
            G8_LDB(B0, 0, 0); G8_SCHED; G8_LDA(At, 0, 0); G8_STAGE(G8_SA(1, 1), a1 + chA, cvA[H1][0], cvA[H1][1]);
            if (last) {
#pragma unroll
                for (int i = 0; i < 2; ++i) { cvA[0][i] = nvA[0][i]; cvA[1][i] = nvA[1][i]; cvB[i] = nvB[i]; }
            }
            G8_WAIT_L(8); G8_BAR; G8_WAIT_L(0); G8_MMA(0, 0, At, B0); G8_BAR; G8_SCHED;
            G8_LDB(B1, 0, 1); G8_STAGE(G8_SB(0, 0), b2, cvB[0], cvB[1]);
            G8_BAR; G8_WAIT_L(0); G8_MMA(0, 1, At, B1); G8_BAR;
            G8_LDA(At, 0, 1); G8_STAGE(G8_SA(0, 0), a2, cvA[0][0], cvA[0][1]);
            G8_BAR; G8_WAIT_L(0); G8_MMA(1, 0, At, B0); G8_BAR; G8_SCHED;
            G8_STAGE(G8_SB(0, 1), b2 + hB2, cvB[0], cvB[1]);
            G8_WAIT_V(6); G8_BAR; G8_MMA(1, 1, At, B1); G8_BAR;
            G8_LDB(B0, 1, 0); G8_SCHED; G8_LDA(At, 1, 0); G8_STAGE(G8_SA(0, 1), a2 + hA2, cvA[H1][0], cvA[H1][1]);
            G8_WAIT_L(8); G8_BAR; G8_WAIT_L(0); G8_MMA(0, 0, At, B0); G8_BAR; G8_SCHED;
            G8_LDB(B1, 1, 1); G8_STAGE(G8_SB(1, 0), b3, cvB[0], cvB[1]);
            G8_BAR; G8_WAIT_L(0); G8_MMA(0, 1, At, B1); G8_BAR;
            G8_LDA(At, 1, 1); G8_STAGE(G8_SA(1, 0), a3, cvA[0][0], cvA[0][1]);
            G8_BAR; G8_WAIT_L(0); G8_MMA(1, 0, At, B0); G8_BAR; G8_SCHED;
            G8_STAGE(G8_SB(1, 1), b3 + hB2, cvB[0], cvB[1]);
            G8_WAIT_V(6); G8_BAR; G8_MMA(1, 1, At, B1); G8_BAR;
        }
        E(acc, cur, wr, wc, fr, fq);
        if (!has_next) break;
#pragma unroll
        for (int a = 0; a < 2; ++a)
#pragma unroll
            for (int b = 0; b < 2; ++b)
#pragma unroll
                for (int m = 0; m < 4; ++m)
#pragma unroll
                    for (int n = 0; n < 2; ++n) acc[a][b][m][n] = (f32x4){0.f, 0.f, 0.f, 0.f};
        cur = nxt; cA = nA; cB = nB; chB = nhB; chA = nhA; ++ui;
    }
    G8_WAIT_V(0);
    if (wr == 0) G8_BAR;
    G8_BAR;
}
}

using g8::f32x4; using g8::u32x4; using g8::Unit;
namespace at { constexpr float QSCALE_ = 0.08838834764831845f * 1.4426950408889634f; }
#define ACC_T const f32x4 (&acc)[2][2][4][2]

struct SchedStd {
    unsigned A, B; int lda, K, nM, nN, G, c;
    __device__ __forceinline__ bool next(int i, Unit& u) const {
        const int L = i * G + c; if (L >= nM * nN) return false;
        int pm, pn; g8::tile_of(L, nM, nN, pm, pn);
        u.A = A + (unsigned)pm * 256u * (unsigned)lda; u.B = B + (unsigned)pn * 256u * (unsigned)K * 2u; u.gidx = nullptr; u.gcnt = 0; u.lda = lda; u.K = K; u.tag = 0; u.pm = pm; u.pn = pn;
        return true;
    }
};
struct EpiBf16 {
    bf16_t* O; int ldc;
    __device__ __forceinline__ void operator()(ACC_T, const Unit& u, int wr, int wc, int fr, int fq) const {
        const int row0 = u.pm * 256 + wr * 64 + fr, col0 = u.pn * 256 + wc * 32 + 8 * fq;
#pragma unroll
        for (int ai = 0; ai < 2; ++ai)
#pragma unroll
            for (int m = 0; m < 4; ++m) {
                bf16_t* rowp = O + (size_t)(row0 + ai * 128 + m * 16) * ldc + col0;
#pragma unroll
                for (int bj = 0; bj < 2; ++bj) {
                    const f32x4 v0 = acc[ai][bj][m][0], v1 = acc[ai][bj][m][1];
                    u32x4 w; w.x = g8::cvt_pk_bf16(v0[0], v0[1]); w.y = g8::cvt_pk_bf16(v0[2], v0[3]); w.z = g8::cvt_pk_bf16(v1[0], v1[1]); w.w = g8::cvt_pk_bf16(v1[2], v1[3]);
                    *(u32x4*)(rowp + bj * 128) = w;
                }
            }
    }
};
struct EpiResid {
    const float* src; float* dst;
    __device__ __forceinline__ void operator()(ACC_T, const Unit& u, int wr, int wc, int fr, int fq) const {
        const int row0 = u.pm * 256 + wr * 64 + fr, col0 = u.pn * 256 + wc * 32 + 4 * fq;
        f32x4 sv[2][4];
#pragma unroll
        for (int q = 0; q < 4; ++q) sv[0][q] = *(const f32x4*)(src + (size_t)row0 * D + col0 + (q >> 1) * 128 + (q & 1) * 16);
#pragma unroll
        for (int k = 0; k < 8; ++k) {
            const int ai = k >> 2, m = k & 3;
            if (k < 7) {
                const size_t rn = (size_t)(row0 + ((k + 1) >> 2) * 128 + ((k + 1) & 3) * 16) * D + col0;
#pragma unroll
                for (int q = 0; q < 4; ++q) sv[(k + 1) & 1][q] = *(const f32x4*)(src + rn + (q >> 1) * 128 + (q & 1) * 16);
            }
            const size_t ro = (size_t)(row0 + ai * 128 + m * 16) * D + col0;
#pragma unroll
            for (int q = 0; q < 4; ++q) *(f32x4*)(dst + ro + (q >> 1) * 128 + (q & 1) * 16) = sv[k & 1][q] + acc[ai][q >> 1][m][q & 1];
        }
    }
};
struct EpiSwiglu {
    bf16_t* Hd; int ldh;
    __device__ __forceinline__ void operator()(ACC_T, const Unit& u, int wr, int wc, int fr, int fq) const {
        const int row0 = u.pm * 256 + wr * 64 + fr, col0 = u.pn * 128 + wc * 16 + 4 * fq;
#pragma unroll
        for (int ai = 0; ai < 2; ++ai)
#pragma unroll
            for (int m = 0; m < 4; ++m) {
                bf16_t* rowp = Hd + (size_t)(row0 + ai * 128 + m * 16) * ldh + col0;
#pragma unroll
                for (int bj = 0; bj < 2; ++bj) {
                    const f32x4 g = acc[ai][bj][m][0], uu = acc[ai][bj][m][1];
                    float hv[4];
#pragma unroll
                    for (int j = 0; j < 4; ++j) hv[j] = g[j] * uu[j] * __builtin_amdgcn_rcpf(1.f + __builtin_amdgcn_exp2f(-1.4426950408889634f * g[j]));
                    uint2 w; w.x = g8::cvt_pk_bf16(hv[0], hv[1]); w.y = g8::cvt_pk_bf16(hv[2], hv[3]);
                    *(uint2*)(rowp + bj * 64) = w;
                }
            }
    }
};

struct EpiProj {
    bf16_t* O; bf16_t* VT; unsigned* KP;
    __device__ __forceinline__ void operator()(ACC_T, const Unit& u, int wr, int wc, int fr, int fq) const {
        const int pn = u.pn;
        const bool isV = (pn == 4 || pn == 5 || pn == 10 || pn == 11);
        const int row0 = u.pm * 256 + wr * 64 + fr;
        if (!isV) {
            const float sc = (pn < 2 || pn == 6 || pn == 7) ? at::QSCALE_ : 1.f;
            const int col0 = pn * 256 + wc * 32 + 8 * fq;
            const bool isFK = (pn == 2 || pn == 3);
            float kmx[2] = {0.f, 0.f};
#pragma unroll
            for (int ai = 0; ai < 2; ++ai)
#pragma unroll
                for (int m = 0; m < 4; ++m) {
                    bf16_t* rowp = O + (size_t)(row0 + ai * 128 + m * 16) * PC + col0;
#pragma unroll
                    for (int bj = 0; bj < 2; ++bj) {
                        const f32x4 v0 = acc[ai][bj][m][0] * sc, v1 = acc[ai][bj][m][1] * sc;
                        u32x4 w; w.x = g8::cvt_pk_bf16(v0[0], v0[1]); w.y = g8::cvt_pk_bf16(v0[2], v0[3]); w.z = g8::cvt_pk_bf16(v1[0], v1[1]); w.w = g8::cvt_pk_bf16(v1[2], v1[3]);
                        *(u32x4*)(rowp + bj * 128) = w;
                        if (isFK) {
                            float ss = bflo(w.x) * bflo(w.x) + bfhi(w.x) * bfhi(w.x) + bflo(w.y) * bflo(w.y) + bfhi(w.y) * bfhi(w.y)
                                     + bflo(w.z) * bflo(w.z) + bfhi(w.z) * bfhi(w.z) + bflo(w.w) * bflo(w.w) + bfhi(w.w) * bfhi(w.w);
                            ss += __shfl_xor(ss, 16); ss += __shfl_xor(ss, 32);
                            kmx[bj] = fmaxf(kmx[bj], ss);
                        }
                    }
                }
            if (isFK) {
#pragma unroll
                for (int bj = 0; bj < 2; ++bj) {
                    float v = kmx[bj];
                    v = fmaxf(v, __shfl_xor(v, 1)); v = fmaxf(v, __shfl_xor(v, 2)); v = fmaxf(v, __shfl_xor(v, 4)); v = fmaxf(v, __shfl_xor(v, 8));
                    if (fr == 0 && fq == 0) atomicMax(KP + (((u.pm * 256) >> 13) * 4 + 2 * (pn & 1) + bj) * 4 + wc, __float_as_uint(v));
                }
            }
        } else {
            const int type = pn >= 10 ? 1 : 0, hp = (pn & 1) * 2, d0 = wc * 32 + 8 * fq;
#pragma unroll
            for (int ai = 0; ai < 2; ++ai)
#pragma unroll
                for (int m = 0; m < 4; ++m) {
                    const int row = row0 + ai * 128 + m * 16; const int b = row >> 13, sq = row & (S - 1);
#pragma unroll
                    for (int bj = 0; bj < 2; ++bj) {
                        bf16_t* base = VT + ((size_t)((type * 16 + b * 4 + hp + bj) * 128 + d0)) * S + sq;
#pragma unroll
                        for (int n = 0; n < 2; ++n)
#pragma unroll
                            for (int j = 0; j < 4; ++j) base[(size_t)(4 * n + j) * S] = f2bf(acc[ai][bj][m][n][j]);
                    }
                }
        }
    }
};

__device__ __forceinline__ void phase_proj_main(const Ctx& c, int layer, LAS unsigned char* lds) {
    SchedStd S{(unsigned)WS_XN, (unsigned)(WS_WB + layer * WB_LAYER + WB_IN), D * 2, D, R / 256, PC / 256, (int)gridDim.x, (int)blockIdx.x};
    EpiProj E{c.PROJ(), (bf16_t*)(c.a->ws + WS_VT), (unsigned*)(c.a->ws + WS_KPART)};
    g8::gemm_stream<true, false>(lds, (const char*)c.a->ws, S, E);
}
__device__ __forceinline__ void phase_resid_main(const Ctx& c, const float* src, unsigned A, int lda_bytes, unsigned Bt, int K, LAS unsigned char* lds) {
    SchedStd S{A, Bt, lda_bytes, K, R / 256, D / 256, (int)gridDim.x, (int)blockIdx.x};
    EpiResid E{src, c.out()};
    g8::gemm_stream<false, false>(lds, (const char*)c.a->ws, S, E);
}
__device__ __forceinline__ void phase_ffn_up_main(const Ctx& c, LAS unsigned char* lds) {
    SchedStd S{(unsigned)WS_XN, (unsigned)WS_WGU, D * 2, D, R / 256, 2 * DFF / 256, (int)gridDim.x, (int)blockIdx.x};
    EpiSwiglu E{c.PROJ(), DFF};
    g8::gemm_stream<true, false>(lds, (const char*)c.a->ws, S, E);
}

struct SchedMerge {
    unsigned WB; int G, c;
    __device__ __forceinline__ bool next(int i, Unit& u) const {
        const int ti = i / 6, sub = i - ti * 6, j = sub >> 1;
        const int L = ti * G + c; if (L >= (R / 256) * (D / 256)) return false;
        int pm, pn; g8::tile_of(L, R / 256, D / 256, pm, pn);
        if ((sub & 1) == 0) { u.A = (unsigned)WS_XN + (unsigned)pm * 256u * (D * 2); u.lda = D * 2; u.K = D; u.B = WB + (unsigned)WB_G + ((unsigned)j * D + (unsigned)pn * 256u) * D * 2; }
        else {
            const int acol = j == 0 ? C_FQ : j == 1 ? C_SQ : C_LG;
            u.A = (unsigned)WS_PROJ + (unsigned)pm * 256u * (PC * 2) + acol * 2; u.lda = PC * 2; u.K = 512;
            u.B = WB + (unsigned)(j == 0 ? WB_FO : j == 1 ? WB_SO : WB_LO) + (unsigned)pn * 256u * 512 * 2;
        }
        u.gidx = nullptr; u.gcnt = 0; u.tag = sub; u.pm = pm; u.pn = pn;
        return true;
    }
};
struct EpiMerge {
    bf16_t* G; bf16_t* MRG; const float* bgate;
    __device__ __forceinline__ void operator()(ACC_T, const Unit& u, int wr, int wc, int fr, int fq) const {
        const int lr0 = wr * 64 + fr, lc0 = wc * 32 + 8 * fq;
        const int j = u.tag >> 1;
        if ((u.tag & 1) == 0) {
            f32x4 bb[2][2];
#pragma unroll
            for (int bj = 0; bj < 2; ++bj) { const float* bp = bgate + j * D + u.pn * 256 + lc0 + bj * 128; bb[bj][0] = *(const f32x4*)bp; bb[bj][1] = *(const f32x4*)(bp + 4); }
#pragma unroll
            for (int ai = 0; ai < 2; ++ai)
#pragma unroll
                for (int m = 0; m < 4; ++m)
#pragma unroll
                    for (int bj = 0; bj < 2; ++bj) {
                        const int lr = lr0 + ai * 128 + m * 16, lc = lc0 + bj * 128;
                        const f32x4 v0 = acc[ai][bj][m][0], v1 = acc[ai][bj][m][1];
                        const f32x4 b0 = bb[bj][0], b1 = bb[bj][1];
                        float s[8];
#pragma unroll
                        for (int q = 0; q < 4; ++q) { s[q] = __builtin_amdgcn_rcpf(1.f + __builtin_amdgcn_exp2f(-1.4426950408889634f * (v0[q] + b0[q]))); s[4 + q] = __builtin_amdgcn_rcpf(1.f + __builtin_amdgcn_exp2f(-1.4426950408889634f * (v1[q] + b1[q]))); }
                        u32x4 w; w.x = g8::cvt_pk_bf16(s[0], s[1]); w.y = g8::cvt_pk_bf16(s[2], s[3]); w.z = g8::cvt_pk_bf16(s[4], s[5]); w.w = g8::cvt_pk_bf16(s[6], s[7]);
                        *(u32x4*)(G + lr * 256 + lc) = w;
                    }
        } else {
            const char* Gc = (const char*)G; char* Mc = (char*)(MRG + (size_t)u.pm * 256 * PC + u.pn * 256);
            u32x4 gw[2][2], pw[2][2];
            {
                int lz = lr0 * 128 + lc0; asm volatile("" : "+v"(lz));
                const unsigned lr = (unsigned)(lz >> 7), lc = (unsigned)(lz & 127);
                const unsigned go = (lr * 256 + lc) * 2u, mo = (lr * PC + lc) * 2u;
#pragma unroll
                for (int bj = 0; bj < 2; ++bj) {
                    gw[0][bj] = *(const u32x4*)(Gc + (go + bj * 256));
                    pw[0][bj] = (u32x4){0u, 0u, 0u, 0u};
                    if (u.tag > 1) pw[0][bj] = *(const u32x4*)(Mc + (mo + bj * 256));
                }
            }
#pragma unroll
            for (int k = 0; k < 8; ++k) {
                const int ai = k >> 2, m = k & 3;
                int lz = lr0 * 128 + lc0; asm volatile("" : "+v"(lz));
                if (k < 7) {
                    const unsigned lrn = (unsigned)(lz >> 7) + ((k + 1) >> 2) * 128 + ((k + 1) & 3) * 16, lcn = (unsigned)(lz & 127);
                    const unsigned gon = (lrn * 256 + lcn) * 2u, mon = (lrn * PC + lcn) * 2u;
#pragma unroll
                    for (int bj = 0; bj < 2; ++bj) {
                        gw[(k + 1) & 1][bj] = *(const u32x4*)(Gc + (gon + bj * 256));
                        pw[(k + 1) & 1][bj] = (u32x4){0u, 0u, 0u, 0u};
                        if (u.tag > 1) pw[(k + 1) & 1][bj] = *(const u32x4*)(Mc + (mon + bj * 256));
                    }
                }
                const unsigned lr = (unsigned)(lz >> 7) + ai * 128 + m * 16, lc = (unsigned)(lz & 127);
                const unsigned mo = (lr * PC + lc) * 2u;
#pragma unroll
                for (int bj = 0; bj < 2; ++bj) {
                    const u32x4 g4 = gw[k & 1][bj], p4 = pw[k & 1][bj];
                    const f32x4 v0 = acc[ai][bj][m][0], v1 = acc[ai][bj][m][1];
                    float o[8];
                    o[0] = bflo(g4.x) * v0[0] + bflo(p4.x); o[1] = bfhi(g4.x) * v0[1] + bfhi(p4.x);
                    o[2] = bflo(g4.y) * v0[2] + bflo(p4.y); o[3] = bfhi(g4.y) * v0[3] + bfhi(p4.y);
                    o[4] = bflo(g4.z) * v1[0] + bflo(p4.z); o[5] = bfhi(g4.z) * v1[1] + bfhi(p4.z);
                    o[6] = bflo(g4.w) * v1[2] + bflo(p4.w); o[7] = bfhi(g4.w) * v1[3] + bfhi(p4.w);
                    u32x4 w; w.x = g8::cvt_pk_bf16(o[0], o[1]); w.y = g8::cvt_pk_bf16(o[2], o[3]); w.z = g8::cvt_pk_bf16(o[4], o[5]); w.w = g8::cvt_pk_bf16(o[6], o[7]);
                    *(u32x4*)(Mc + (mo + bj * 256)) = w;
                }
            }
        }
    }
};
__device__ __forceinline__ void phase_merge_main(const Ctx& c, int layer, LAS unsigned char* lds) {
    SchedMerge S{(unsigned)(WS_WB + layer * WB_LAYER), (int)gridDim.x, (int)blockIdx.x};
    EpiMerge E{(bf16_t*)(c.a->ws + WS_GSCR + (size_t)blockIdx.x * 131072), c.PROJ() + C_MRG, c.b_gate() + layer * 3 * D};
    g8::gemm_stream<true, false>(lds, (const char*)c.a->ws, S, E);
}

struct MoeMap { int ebase[9]; int cnt[8]; };
__device__ __forceinline__ void moe_map(const Ctx& c, MoeMap& m) {
    int acc = 0;
#pragma unroll
    for (int e = 0; e < 8; ++e) { m.cnt[e] = c.CNT()[e]; m.ebase[e] = acc; acc += (m.cnt[e] + 255) & ~255; }
    m.ebase[8] = acc;
}
constexpr int LDS_MOETAB = 131072 + 64;
struct SchedMoe {
    const LAS int* tab; unsigned Asrc, W; const int* LIST; int chunk, nrt, nct, G, c, up;
    __device__ __forceinline__ bool next(int i, Unit& u) const {
        const int L = i * G + c; if (L >= nrt * nct) return false;
        const int rt = L % nrt, ct = L / nrt;
        const int e = tab[rt * 4 + 0], pos0 = tab[rt * 4 + 1], gc = tab[rt * 4 + 2];
        if (up) {
            u.A = Asrc; u.lda = D * 2; u.K = D; u.gidx = LIST + (size_t)e * R + pos0; u.gcnt = gc;
            u.B = W + (unsigned)e * (2 * DFE) * D * 2 + (unsigned)ct * 256u * D * 2; u.pm = rt; u.pn = ct;
        } else {
            u.A = Asrc + (unsigned)rt * 256u * (DFE * 2); u.lda = DFE * 2; u.K = DFE; u.gidx = nullptr; u.gcnt = 0;
            u.B = W + (unsigned)e * D * DFE * 2 + (unsigned)ct * 256u * DFE * 2; u.pm = chunk * (MOE_CH / 256) + rt; u.pn = ct;
        }
        u.tag = 0;
        return true;
    }
};
__device__ __forceinline__ int moe_table(const Ctx& c, int chunk, LAS unsigned char* lds) {
    LAS int* tab = (LAS int*)(lds + LDS_MOETAB);
    MoeMap m; moe_map(c, m);
    int n = (m.ebase[8] - chunk * MOE_CH) / 256; n = n < 0 ? 0 : (n > MOE_CH / 256 ? MOE_CH / 256 : n);
    __syncthreads();
    if (c.tid < MOE_CH / 256) {
        const int slot0 = chunk * MOE_CH + c.tid * 256;
        int e = 0;
#pragma unroll
        for (int k = 1; k < 8; ++k) if (slot0 >= m.ebase[k]) e = k;
        int eb = 0, ec = 0;
#pragma unroll
        for (int k = 0; k < 8; ++k) if (k == e) { eb = m.ebase[k]; ec = m.cnt[k]; }
        tab[c.tid * 4 + 0] = e; tab[c.tid * 4 + 1] = slot0 - eb; tab[c.tid * 4 + 2] = ec - (slot0 - eb);
    }
    __syncthreads();
    return __builtin_amdgcn_readfirstlane(n);
}
__device__ __forceinline__ void phase_moe_up(const Ctx& c, int chunk, LAS unsigned char* lds) {
    const int nrt = moe_table(c, chunk, lds);
    SchedMoe S{(const LAS int*)(lds + LDS_MOETAB), (unsigned)WS_XN, (unsigned)WS_MOE_GU, c.LIST(), chunk, nrt, 2 * DFE / 256, (int)gridDim.x, (int)blockIdx.x, 1};
    EpiSwiglu E{c.HIDC(), DFE};
    g8::gemm_stream<true, true>(lds, (const char*)c.a->ws, S, E);
}
__device__ __forceinline__ void phase_moe_down(const Ctx& c, int chunk, LAS unsigned char* lds) {
    const int nrt = moe_table(c, chunk, lds);
    SchedMoe S{(const LAS int*)(lds + LDS_MOETAB), (unsigned)(WS_PROJ + WS_HIDC_OFF), (unsigned)WS_MOE_D, c.LIST(), chunk, nrt, D / 256, (int)gridDim.x, (int)blockIdx.x, 0};
    EpiBf16 E{c.Y(), D};
    g8::gemm_stream<true, false>(lds, (const char*)c.a->ws, S, E);
}


namespace fx {
typedef short bf16x8 __attribute__((ext_vector_type(8)));
typedef float f32x16 __attribute__((ext_vector_type(16)));
typedef float f32x4 __attribute__((ext_vector_type(4)));
constexpr int L_K = 0, L_V = 32768, L_CB = 65536, L_CBB = 65536 + 512, L_VOTE = 65536 + 1024, L_END = 65536 + 1024 + 64;
constexpr float LOG2E = 1.4426950408889634f;
constexpr float FOX_THR = 10.f;
__device__ __forceinline__ int swap23(int i) { return (i & ~12) | ((i & 4) << 1) | ((i & 8) >> 1); }

__device__ __forceinline__ void dma_k(const char* wsb, LAS unsigned char* lds, int kbuf, int b, int h, int jt, int tid) {
    const int wv = __builtin_amdgcn_readfirstlane(tid >> 6), lane = tid & 63;
    const unsigned kbase = (unsigned)WS_PROJ + ((unsigned)(b * S + 64 * jt) * PC + (unsigned)(C_FK + h * 128)) * 2u;
#pragma unroll
    for (int i = 0; i < 2; ++i) {
        const int id = (wv * 2 + i) * 64 + lane; const int rp = id >> 4, slot = id & 15;
        const unsigned ko = kbase + ((unsigned)swap23(rp) * PC + (unsigned)((slot ^ (rp & 15)) * 8)) * 2u;
        __builtin_amdgcn_global_load_lds((const unsigned*)(wsb + ko), (LAS unsigned*)(lds + L_K + kbuf * 16384 + (wv * 2 + i) * 1024), 16, 0, 0);
    }
}
__device__ __forceinline__ void dma_v(const char* wsb, LAS unsigned char* lds, int vbuf, int b, int h, int jt, int tid) {
    const int wv = __builtin_amdgcn_readfirstlane(tid >> 6), lane = tid & 63;
    const unsigned vbase = (unsigned)WS_VT + ((unsigned)((b * 4 + h) * 128) * S + 64u * jt) * 2u;
#pragma unroll
    for (int i = 0; i < 2; ++i) {
        const int id = (wv * 2 + i) * 64 + lane; const int d = id >> 3, vs = id & 7;
        const unsigned vo = vbase + ((unsigned)d * S + (unsigned)((vs ^ ((d >> 1) & 7)) * 8)) * 2u;
        __builtin_amdgcn_global_load_lds((const unsigned*)(wsb + vo), (LAS unsigned*)(lds + L_V + vbuf * 16384 + (wv * 2 + i) * 1024), 16, 0, 0);
    }
}
__device__ __forceinline__ float load_cb(const char* wsb, LAS unsigned char* lds, int b, int h, int jt, int tid) {
    float v = 0.f;
    if (tid < 64) v = -(*(const float*)(wsb + ((unsigned)WS_C + ((unsigned)(b * S + 64 * jt + tid) * 4 + h) * 4u)) + *(const LAS float*)(lds + L_CBB + jt * 4)) * LOG2E;
    return v;
}
__device__ __forceinline__ void meta_kv(const char* wsb, LAS unsigned char* lds, int h, int tid) {
    const unsigned kbase = (unsigned)WS_PROJ + ((unsigned)R * PC + (unsigned)(C_FK + h * 128)) * 2u, vbase = (unsigned)WS_PROJ + ((unsigned)R * PC + (unsigned)(C_FV + h * 128)) * 2u;
#pragma unroll
    for (int i = 0; i < 2; ++i) {
        const int id = tid + 512 * i;
        const int rp = id >> 4, slot = id & 15; const int key = swap23(rp);
        g8::u32x4 kv = {0u, 0u, 0u, 0u};
        if (key < NM) { const uint4 t = *(const uint4*)(wsb + (kbase + ((unsigned)key * PC + (unsigned)((slot ^ (rp & 15)) * 8)) * 2u)); kv = (g8::u32x4){t.x, t.y, t.z, t.w}; }
        *(LAS g8::u32x4*)(lds + L_K + id * 16) = kv;
        const int d = id >> 3, vs = id & 7; const int ch = vs ^ ((d >> 1) & 7);
        g8::u32x4 vv = {0u, 0u, 0u, 0u};
        if (ch < 2) {
            const unsigned vo = vbase + ((unsigned)(ch * 8) * PC + (unsigned)d) * 2u;
            unsigned e[8];
#pragma unroll
            for (int q = 0; q < 8; ++q) e[q] = *(const bf16_t*)(wsb + (vo + (unsigned)q * PC * 2u));
            vv = (g8::u32x4){e[0] | (e[1] << 16), e[2] | (e[3] << 16), e[4] | (e[5] << 16), e[6] | (e[7] << 16)};
        }
        *(LAS g8::u32x4*)(lds + L_V + id * 16) = vv;
    }
    if (tid < 64) {
        float cbv = 0.f;
        if (tid < NM) cbv = -*(const float*)(wsb + ((unsigned)WS_C + ((unsigned)(R + tid) * 4 + h) * 4u)) * LOG2E;
        *(LAS float*)(lds + L_CB + tid * 4) = cbv;
    }
}

struct WaveState { f32x16 O[4]; f32x16 s0, s1; unsigned pk0[8], pk1[8]; float m, l; };

__device__ __forceinline__ void qk(WaveState& w, const bf16x8 (&qf)[8], LAS unsigned char* lds, int kbuf, int lane) {
    const int ql = lane & 31, hi = lane >> 5, kx = ql & 15;
    const LAS unsigned char* Kb = lds + L_K + kbuf * 16384 + ql * 256;
#pragma unroll
    for (int r = 0; r < 16; ++r) { w.s0[r] = 0.f; w.s1[r] = 0.f; }
    bf16x8 fa[2], fb[2];
    { const LAS unsigned char* kp = Kb + (((0 + hi) ^ kx) << 4); fa[0] = *(const LAS bf16x8*)kp; fb[0] = *(const LAS bf16x8*)(kp + 32 * 256); }
#pragma unroll
    for (int ks = 0; ks < 8; ++ks) {
        if (ks + 1 < 8) { const LAS unsigned char* kp = Kb + (((2 * (ks + 1) + hi) ^ kx) << 4); fa[(ks + 1) & 1] = *(const LAS bf16x8*)kp; fb[(ks + 1) & 1] = *(const LAS bf16x8*)(kp + 32 * 256); }
        w.s0 = __builtin_amdgcn_mfma_f32_32x32x16_bf16(fa[ks & 1], qf[ks], w.s0, 0, 0, 0);
        w.s1 = __builtin_amdgcn_mfma_f32_32x32x16_bf16(fb[ks & 1], qf[ks], w.s1, 0, 0, 0);
        __builtin_amdgcn_sched_barrier(0);
    }
}
__device__ __forceinline__ void pv(WaveState& w, LAS unsigned char* lds, int vbuf, int lane) {
    const int ql = lane & 31, hi = lane >> 5, vx = (ql >> 1) & 7;
    const LAS unsigned char* Vb = lds + L_V + vbuf * 16384 + ql * 128;
    bf16x8 fv[2][4];
    { const LAS unsigned char* vp = Vb + (((0 + hi) ^ vx) << 4);
#pragma unroll
      for (int db = 0; db < 4; ++db) fv[0][db] = *(const LAS bf16x8*)(vp + db * 4096); }
#pragma unroll
    for (int g = 0; g < 4; ++g) {
        const int kb = g >> 1, sl = g & 1;
        if (g + 1 < 4) { const int kb2 = (g + 1) >> 1, sl2 = (g + 1) & 1; const LAS unsigned char* vp = Vb + (((4 * kb2 + 2 * sl2 + hi) ^ vx) << 4);
#pragma unroll
            for (int db = 0; db < 4; ++db) fv[(g + 1) & 1][db] = *(const LAS bf16x8*)(vp + db * 4096); }
        g8::u32x4 bv;
        if (kb == 0) bv = (g8::u32x4){w.pk0[4 * sl], w.pk0[4 * sl + 1], w.pk0[4 * sl + 2], w.pk0[4 * sl + 3]};
        else         bv = (g8::u32x4){w.pk1[4 * sl], w.pk1[4 * sl + 1], w.pk1[4 * sl + 2], w.pk1[4 * sl + 3]};
#pragma unroll
        for (int db = 0; db < 4; ++db) w.O[db] = __builtin_amdgcn_mfma_f32_32x32x16_bf16(fv[g & 1][db], __builtin_bit_cast(bf16x8, bv), w.O[db], 0, 0, 0);
        __builtin_amdgcn_sched_barrier(0);
    }
}
__device__ __forceinline__ void softmax(WaveState& w, LAS unsigned char* lds, int cbuf, int lim, int lane) {
    const int hi = lane >> 5;
    const LAS float* cb = (const LAS float*)(lds + L_CB + cbuf * 256) + 8 * hi;
#pragma unroll
    for (int g = 0; g < 4; ++g) {
        const f32x4 c0 = *(const LAS f32x4*)(cb + 16 * (g >> 1) + 4 * (g & 1)), c1 = *(const LAS f32x4*)(cb + 32 + 16 * (g >> 1) + 4 * (g & 1));
#pragma unroll
        for (int j = 0; j < 4; ++j) { w.s0[4 * g + j] += c0[j]; w.s1[4 * g + j] += c1[j]; }
    }
    if (lim < 64) {
        const float NEG = -__builtin_inff();
#pragma unroll
        for (int r = 0; r < 16; ++r) {
            const int kap = 16 * (r >> 3) + 8 * hi + (r & 7);
            if (kap > lim) w.s0[r] = NEG;
            if (kap + 32 > lim) w.s1[r] = NEG;
        }
    }
    float pmax = w.s0[0];
#pragma unroll
    for (int r = 1; r < 16; ++r) pmax = fmaxf(pmax, w.s0[r]);
#pragma unroll
    for (int r = 0; r < 16; ++r) pmax = fmaxf(pmax, w.s1[r]);
    pmax = fmaxf(pmax, __shfl_xor(pmax, 32));
    float mn = w.m;
    if (!__all(pmax - w.m <= FOX_THR)) {
        mn = fmaxf(w.m, pmax);
        const float alpha = __builtin_amdgcn_exp2f(w.m - mn);
        w.m = mn; w.l *= alpha;
#pragma unroll
        for (int db = 0; db < 4; ++db)
#pragma unroll
            for (int r = 0; r < 16; ++r) w.O[db][r] *= alpha;
    }
    float ls = 0.f;
#pragma unroll
    for (int r = 0; r < 16; ++r) { w.s0[r] = __builtin_amdgcn_exp2f(w.s0[r] - mn); w.s1[r] = __builtin_amdgcn_exp2f(w.s1[r] - mn); ls += w.s0[r] + w.s1[r]; }
    ls += __shfl_xor(ls, 32);
    w.l += ls;
#pragma unroll
    for (int i = 0; i < 8; ++i) { w.pk0[i] = g8::cvt_pk_bf16(w.s0[2 * i], w.s0[2 * i + 1]); w.pk1[i] = g8::cvt_pk_bf16(w.s1[2 * i], w.s1[2 * i + 1]); }
}

__device__ __forceinline__ bool block_and(LAS unsigned char* lds, bool pred, int wv, int lane) {
    const bool wall = __builtin_amdgcn_ballot_w64(pred) == 0xFFFFFFFFFFFFFFFFull;
    if (lane == 0) *(LAS int*)(lds + L_VOTE + wv * 4) = wall ? 1 : 0;
    __syncthreads();
    int r = 1;
#pragma unroll
    for (int q = 0; q < 8; ++q) r &= *(const LAS int*)(lds + L_VOTE + q * 4);
    return r != 0;
}
__device__ __forceinline__ void qblock(char* wsb, LAS unsigned char* lds, int b, int h, int qb, int tid_in) {
    int tid = tid_in; asm volatile("" : "+v"(tid));
    const int lane = tid & 63, wv = __builtin_amdgcn_readfirstlane(tid >> 6), ql = lane & 31, hi = lane >> 5;
    const int grp = wv >> 2;
    const int qcol = C_FQ + h * 128;
    const unsigned qoff = (unsigned)WS_PROJ + ((unsigned)(b * S + 256 * qb + 32 * wv + ql) * PC + qcol + hi * 8) * 2u;
    bf16x8 qf[8];
#pragma unroll
    for (int ks = 0; ks < 8; ++ks) qf[ks] = *(const bf16x8*)(wsb + (qoff + ks * 32));
    float qkb;
    {
        float ss = 0.f;
#pragma unroll
        for (int ks = 0; ks < 8; ++ks) {
            const g8::u32x4 qw = __builtin_bit_cast(g8::u32x4, qf[ks]);
            ss += bflo(qw.x) * bflo(qw.x) + bfhi(qw.x) * bfhi(qw.x) + bflo(qw.y) * bflo(qw.y) + bfhi(qw.y) * bfhi(qw.y)
                + bflo(qw.z) * bflo(qw.z) + bfhi(qw.z) * bfhi(qw.z) + bflo(qw.w) * bflo(qw.w) + bfhi(qw.w) * bfhi(qw.w);
        }
        ss += __shfl_xor(ss, 32);
        const unsigned* KP = (const unsigned*)(wsb + WS_KPART) + (b * 4 + h) * 4;
        const float k2 = __uint_as_float(KP[0]) + __uint_as_float(KP[1]) + __uint_as_float(KP[2]) + __uint_as_float(KP[3]);
        qkb = sqrtf(ss) * sqrtf(k2) * 1.002f + 0.05f;
    }
    WaveState w;
#pragma unroll
    for (int db = 0; db < 4; ++db)
#pragma unroll
        for (int r = 0; r < 16; ++r) w.O[db][r] = 0.f;
    w.m = -1e30f; w.l = 0.f;
    const int n = 4 * qb + 5;
    const int jd = 4 * qb + (wv >> 1);
    const int tf = 4 - (wv >> 1);
    const int dlim = 32 * (wv & 1) + ql;
#define FX_JT(t_) (4 * qb + 4 - (t_))
#define FX_ACT(t_) ((t_) == 0 || (t_) >= tf)
    __syncthreads();
    if (tid < 64) {
        const float* CTp = (const float*)(wsb + WS_CT) + ((b * 4 + h) * 128 + 2 * tid);
        const float t0 = CTp[0], t1 = CTp[1];
        float sc = t0 + t1;
#pragma unroll
        for (int o = 1; o < 64; o <<= 1) { const float t = __shfl_up(sc, o); if (tid >= o) sc += t; }
        const float meta_tot = *(const float*)(wsb + ((unsigned)WS_C + ((unsigned)(R + NM - 1) * 4 + h) * 4u));
        const float e0 = meta_tot + sc - (t0 + t1);
        *(LAS float*)(lds + L_CBB + (2 * tid) * 4) = e0; *(LAS float*)(lds + L_CBB + (2 * tid + 1) * 4) = e0 + t0;
    }
    __syncthreads();
    meta_kv(wsb, lds, h, tid);
    dma_k(wsb, lds, 1, b, h, FX_JT(1), tid);
    { const float c1 = load_cb(wsb, lds, b, h, FX_JT(1), tid); if (tid < 64) *(LAS float*)(lds + L_CB + 256 + tid * 4) = c1; }
    asm volatile("s_waitcnt vmcnt(0)" ::: "memory");
    __syncthreads();
    float cbreg = 0.f;
#define FX_EVEN(m_) do { const int m__ = (m_); if (m__ >= 1) { int tq = tid; asm volatile("" : "+v"(tq)); \
        if (m__ + 1 < n) { dma_k(wsb, lds, (m__ + 1) & 1, b, h, FX_JT(m__ + 1), tq); cbreg = load_cb(wsb, lds, b, h, FX_JT(m__ + 1), tq); } \
        if (m__ < n) dma_v(wsb, lds, m__ & 1, b, h, FX_JT(m__), tq); } } while (0)
#define FX_ODD(m_) do { const int m__ = (m_); asm volatile("s_waitcnt vmcnt(0)" ::: "memory"); \
        if (m__ >= 1 && m__ + 1 < n && tid < 64) *(LAS float*)(lds + L_CB + ((m__ + 1) & 1) * 256 + tid * 4) = cbreg; } while (0)
#define FX_SM(t_) do { const int t__ = (t_); if (FX_ACT(t__)) softmax(w, lds, t__ & 1, t__ == 0 ? NM - 1 : (FX_JT(t__) < jd ? 64 : dlim), lane); } while (0)
#define FX_VOTE(t_) (((t_) >= 1 && (t_) < n - 1) ? (qkb - *(const LAS float*)(lds + L_CBB + FX_JT(t_) * 4) * LOG2E < w.m - 127.f) : false)
    if (grp == 0) {
        qk(w, qf, lds, 0, lane);
        __syncthreads();
        for (int t = 0; ; ++t) {
            FX_SM(t); FX_ODD(t);
            const bool last = block_and(lds, FX_VOTE(t), wv, lane) || t == n - 1;
            if (!last) FX_EVEN(t + 1);
            if (FX_ACT(t)) pv(w, lds, t & 1, lane);
            if (!last && FX_ACT(t + 1)) qk(w, qf, lds, (t + 1) & 1, lane);
            __syncthreads();
            if (last) break;
        }
        asm volatile("s_waitcnt vmcnt(0)" ::: "memory");
        (void)block_and(lds, false, wv, lane);
    } else {
        __syncthreads();
        qk(w, qf, lds, 0, lane); FX_ODD(0);
        bool last = block_and(lds, false, wv, lane);
        for (int t = 0; ; ++t) {
            if (!last) FX_EVEN(t + 1);
            FX_SM(t);
            __syncthreads();
            if (FX_ACT(t)) pv(w, lds, t & 1, lane);
            if (!last && FX_ACT(t + 1)) qk(w, qf, lds, (t + 1) & 1, lane);
            FX_ODD(t + 1);
            const bool stop_next = block_and(lds, FX_VOTE(t + 1), wv, lane);
            if (last) break;
            last = stop_next || (t + 1 == n - 1);
        }
    }
#undef FX_EVEN
#undef FX_ODD
#undef FX_SM
#undef FX_VOTE
#undef FX_JT
#undef FX_ACT
    const float inv = 1.f / w.l;
    int tz = tid; asm volatile("" : "+v"(tz));
    const unsigned ooff = (unsigned)WS_PROJ + ((unsigned)(b * S + 256 * qb + 32 * wv + (tz & 31)) * PC + qcol + ((tz >> 5) & 1) * 4) * 2u;
#pragma unroll
    for (int db = 0; db < 4; ++db)
#pragma unroll
        for (int g = 0; g < 4; ++g) {
            uint2 o; o.x = g8::cvt_pk_bf16(w.O[db][4 * g] * inv, w.O[db][4 * g + 1] * inv); o.y = g8::cvt_pk_bf16(w.O[db][4 * g + 2] * inv, w.O[db][4 * g + 3] * inv);
            *(uint2*)(wsb + (ooff + (32 * db + 8 * g) * 2)) = o;
        }
}
}

namespace sx {
using fx::bf16x8; using fx::f32x16; using fx::WaveState; using fx::swap23; using fx::L_K; using fx::L_V;
__device__ __forceinline__ void dma_k(const char* wsb, LAS unsigned char* lds, int kbuf, int b, int h, int jt, int tid) {
    const int wv = __builtin_amdgcn_readfirstlane(tid >> 6), lane = tid & 63;
    const unsigned kbase = (unsigned)WS_PROJ + ((unsigned)(b * S + 64 * jt) * PC + (unsigned)(C_SK + h * 128)) * 2u;
#pragma unroll
    for (int i = 0; i < 2; ++i) {
        const int id = (wv * 2 + i) * 64 + lane; const int rp = id >> 4, slot = id & 15;
        const unsigned ko = kbase + ((unsigned)swap23(rp) * PC + (unsigned)((slot ^ (rp & 15)) * 8)) * 2u;
        __builtin_amdgcn_global_load_lds((const unsigned*)(wsb + ko), (LAS unsigned*)(lds + L_K + kbuf * 16384 + (wv * 2 + i) * 1024), 16, 0, 0);
    }
}
__device__ __forceinline__ void dma_v(const char* wsb, LAS unsigned char* lds, int vbuf, int b, int h, int jt, int tid) {
    const int wv = __builtin_amdgcn_readfirstlane(tid >> 6), lane = tid & 63;
    const unsigned vbase = (unsigned)WS_VT + ((unsigned)((16 + b * 4 + h) * 128) * S + 64u * jt) * 2u;
#pragma unroll
    for (int i = 0; i < 2; ++i) {
        const int id = (wv * 2 + i) * 64 + lane; const int d = id >> 3, vs = id & 7;
        const unsigned vo = vbase + ((unsigned)d * S + (unsigned)((vs ^ ((d >> 1) & 7)) * 8)) * 2u;
        __builtin_amdgcn_global_load_lds((const unsigned*)(wsb + vo), (LAS unsigned*)(lds + L_V + vbuf * 16384 + (wv * 2 + i) * 1024), 16, 0, 0);
    }
}
__device__ __forceinline__ void meta_k(const char* wsb, LAS unsigned char* lds, int kbuf, int h, int tid) {
    const unsigned kbase = (unsigned)WS_PROJ + ((unsigned)R * PC + (unsigned)(C_SK + h * 128)) * 2u;
#pragma unroll
    for (int i = 0; i < 2; ++i) {
        const int id = tid + 512 * i;
        const int rp = id >> 4, slot = id & 15; const int key = swap23(rp);
        g8::u32x4 kv = {0u, 0u, 0u, 0u};
        if (key < NM) { const uint4 t = *(const uint4*)(wsb + (kbase + ((unsigned)key * PC + (unsigned)((slot ^ (rp & 15)) * 8)) * 2u)); kv = (g8::u32x4){t.x, t.y, t.z, t.w}; }
        *(LAS g8::u32x4*)(lds + L_K + kbuf * 16384 + id * 16) = kv;
    }
}
__device__ __forceinline__ void meta_v(const char* wsb, LAS unsigned char* lds, int vbuf, int h, int tid) {
    const unsigned vbase = (unsigned)WS_PROJ + ((unsigned)R * PC + (unsigned)(C_SV + h * 128)) * 2u;
#pragma unroll
    for (int i = 0; i < 2; ++i) {
        const int id = tid + 512 * i;
        const int d = id >> 3, vs = id & 7; const int ch = vs ^ ((d >> 1) & 7);
        g8::u32x4 vv = {0u, 0u, 0u, 0u};
        if (ch < 2) {
            const unsigned vo = vbase + ((unsigned)(ch * 8) * PC + (unsigned)d) * 2u;
            unsigned e[8];
#pragma unroll
            for (int q = 0; q < 8; ++q) e[q] = *(const bf16_t*)(wsb + (vo + (unsigned)q * PC * 2u));
            vv = (g8::u32x4){e[0] | (e[1] << 16), e[2] | (e[3] << 16), e[4] | (e[5] << 16), e[6] | (e[7] << 16)};
        }
        *(LAS g8::u32x4*)(lds + L_V + vbuf * 16384 + id * 16) = vv;
    }
}
__device__ __forceinline__ void sbweights(WaveState& w, float& rr, int lim, int lane) {
    const int hi = lane >> 5;
    float T[4];
#pragma unroll
    for (int rho = 0; rho < 4; ++rho) {
        float mv[8], dv[8];
#pragma unroll
        for (int e = 0; e < 8; ++e) {
            const int r = 8 * (rho & 1) + e;
            const float z = rho < 2 ? w.s0[r] : w.s1[r];
            const float ex = __builtin_amdgcn_exp2f(-fabsf(z));
            const float sp = fmaxf(z, 0.f) + __builtin_amdgcn_logf(1.f + ex);
            const bool valid = (32 * (rho >> 1) + 16 * (rho & 1) + e) < lim - 8 * hi;
            mv[e] = valid ? -sp : 0.f;
            dv[e] = valid ? z - sp : -__builtin_inff();
        }
        float suf = 0.f;
#pragma unroll
        for (int e = 7; e >= 0; --e) { dv[e] += suf; suf += mv[e]; }
        T[rho] = suf;
#pragma unroll
        for (int e = 0; e < 8; ++e) { const int r = 8 * (rho & 1) + e; if (rho < 2) w.s0[r] = dv[e]; else w.s1[r] = dv[e]; }
    }
    float run = rr;
#pragma unroll
    for (int rho = 3; rho >= 0; --rho) {
        const float Tp = __shfl_xor(T[rho], 32);
        const float base = run + (hi == 0 ? Tp : 0.f);
#pragma unroll
        for (int e = 0; e < 8; ++e) {
            const int r = 8 * (rho & 1) + e;
            if (rho < 2) w.s0[r] = __builtin_amdgcn_exp2f(w.s0[r] + base); else w.s1[r] = __builtin_amdgcn_exp2f(w.s1[r] + base);
        }
        run += T[rho] + Tp;
    }
    rr = run;
#pragma unroll
    for (int i = 0; i < 8; ++i) { w.pk0[i] = g8::cvt_pk_bf16(w.s0[2 * i], w.s0[2 * i + 1]); w.pk1[i] = g8::cvt_pk_bf16(w.s1[2 * i], w.s1[2 * i + 1]); }
}

__device__ __forceinline__ void qblock(char* wsb, LAS unsigned char* lds, int b, int h, int qb, int tid_in) {
    int tid = tid_in; asm volatile("" : "+v"(tid));
    const int lane = tid & 63, wv = __builtin_amdgcn_readfirstlane(tid >> 6), ql = lane & 31, hi = lane >> 5;
    const int grp = wv >> 2;
    const int qcol = C_SQ + h * 128;
    const unsigned qoff = (unsigned)WS_PROJ + ((unsigned)(b * S + 256 * qb + 32 * wv + ql) * PC + qcol + hi * 8) * 2u;
    bf16x8 qf[8];
#pragma unroll
    for (int ks = 0; ks < 8; ++ks) qf[ks] = *(const bf16x8*)(wsb + (qoff + ks * 32));
    WaveState w;
#pragma unroll
    for (int db = 0; db < 4; ++db)
#pragma unroll
        for (int r = 0; r < 16; ++r) w.O[db][r] = 0.f;
    w.m = 0.f; w.l = 0.f;
    float rr = 0.f;
    const int n = 4 * qb + 5;
    const int tf = 3 - (wv >> 1);
    const int dlim = 32 * (wv & 1) + ql;
#define SX_JT(t_) (4 * qb + 3 - (t_))
#define SX_LIM(t_) ((t_) == n - 1 ? NM : ((t_) == tf ? dlim : 64))
    __syncthreads();
    dma_k(wsb, lds, 0, b, h, SX_JT(0), tid); dma_v(wsb, lds, 0, b, h, SX_JT(0), tid); dma_k(wsb, lds, 1, b, h, SX_JT(1), tid);
    asm volatile("s_waitcnt vmcnt(0)" ::: "memory");
    __syncthreads();
#define SX_EVEN(m_) do { const int m__ = (m_); if (m__ >= 1) { int tq = tid; asm volatile("" : "+v"(tq)); \
        if (m__ + 1 < n) { if (m__ + 1 == n - 1) meta_k(wsb, lds, (m__ + 1) & 1, h, tq); else dma_k(wsb, lds, (m__ + 1) & 1, b, h, SX_JT(m__ + 1), tq); } \
        if (m__ < n) { if (m__ == n - 1) meta_v(wsb, lds, m__ & 1, h, tq); else dma_v(wsb, lds, m__ & 1, b, h, SX_JT(m__), tq); } } } while (0)
#define SX_ODD() asm volatile("s_waitcnt vmcnt(0)" ::: "memory")
#define SX_SM(t_) do { const int t__ = (t_); if (t__ >= tf) sbweights(w, rr, SX_LIM(t__), lane); } while (0)
#define SX_VOTE(t_) ((t_) < n - 1 ? (rr < -127.f) : false)
    if (grp == 0) {
        if (0 >= tf) fx::qk(w, qf, lds, 0, lane);
        __syncthreads();
        for (int t = 0; ; ++t) {
            SX_SM(t); SX_ODD();
            const bool last = fx::block_and(lds, SX_VOTE(t), wv, lane) || t == n - 1;
            if (!last) SX_EVEN(t + 1);
            if (t >= tf) fx::pv(w, lds, t & 1, lane);
            if (!last && t + 1 >= tf) fx::qk(w, qf, lds, (t + 1) & 1, lane);
            __syncthreads();
            if (last) break;
        }
        SX_ODD();
        (void)fx::block_and(lds, false, wv, lane);
    } else {
        __syncthreads();
        if (0 >= tf) fx::qk(w, qf, lds, 0, lane);
        SX_ODD();
        bool last = fx::block_and(lds, SX_VOTE(0), wv, lane);
        for (int t = 0; ; ++t) {
            if (!last) SX_EVEN(t + 1);
            SX_SM(t);
            __syncthreads();
            if (t >= tf) fx::pv(w, lds, t & 1, lane);
            if (!last && t + 1 >= tf) fx::qk(w, qf, lds, (t + 1) & 1, lane);
            SX_ODD();
            const bool stop_next = fx::block_and(lds, SX_VOTE(t + 1), wv, lane);
            if (last) break;
            last = stop_next || (t + 1 == n - 1);
        }
    }
#undef SX_EVEN
#undef SX_ODD
#undef SX_SM
#undef SX_VOTE
#undef SX_JT
#undef SX_LIM
    int tz = tid; asm volatile("" : "+v"(tz));
    const unsigned ooff = (unsigned)WS_PROJ + ((unsigned)(b * S + 256 * qb + 32 * wv + (tz & 31)) * PC + qcol + ((tz >> 5) & 1) * 4) * 2u;
#pragma unroll
    for (int db = 0; db < 4; ++db)
#pragma unroll
        for (int g = 0; g < 4; ++g) {
            uint2 o; o.x = g8::cvt_pk_bf16(w.O[db][4 * g], w.O[db][4 * g + 1]); o.y = g8::cvt_pk_bf16(w.O[db][4 * g + 2], w.O[db][4 * g + 3]);
            *(uint2*)(wsb + (ooff + (32 * db + 8 * g) * 2)) = o;
        }
}
}

__device__ __forceinline__ void phase_attn_main(const Ctx& c, int layer, LAS unsigned char* lds) {
    char* wsb = (char*)c.a->ws;
    {
        unsigned* ctr = (unsigned*)(c.a->ws + WS_FOXQ) + layer * 16;
        LAS int* slot = (LAS int*)(lds + 65536 + 1024 + 32);
        for (;;) {
            __syncthreads();
            if (c.tid == 0) *slot = (int)__hip_atomic_fetch_add(ctr, 1u, __ATOMIC_RELAXED, __HIP_MEMORY_SCOPE_AGENT);
            __syncthreads();
            const int it = *slot;
            if (it >= 512) break;
            const int bh = it & 15, qb = 31 - (it >> 4);
            fx::qblock(wsb, lds, bh >> 2, bh & 3, qb, c.tid);
        }
    }
    for (int it = blockIdx.x; it < 512; it += gridDim.x) {
        const int bh = it >> 5, qb = it & 31;
        sx::qblock(wsb, lds, bh >> 2, bh & 3, qb, c.tid);
    }
    __syncthreads();
}

namespace mg {
typedef short bf16x8 __attribute__((ext_vector_type(8)));
typedef float f32x4 __attribute__((ext_vector_type(4)));
__device__ __forceinline__ void mma16(f32x4& acc, const bf16_t* ap, const bf16_t* bp, int k0, int klen) {
#pragma unroll 4
    for (int k = k0; k < k0 + klen; k += 32) {
        const bf16x8 a = *(const bf16x8*)(ap + k), b = *(const bf16x8*)(bp + k);
        acc = __builtin_amdgcn_mfma_f32_16x16x32_bf16(a, b, acc, 0, 0, 0);
    }
}
template <int SLOTS>
__device__ __forceinline__ void put_partial(float* red, int slot, const f32x4& acc, int tid) {
    const int wv = tid >> 6, lane = tid & 63, fr = lane & 15, fq = lane >> 4;
#pragma unroll
    for (int j = 0; j < 4; ++j) red[((slot * 8 + wv) * 16 + 4 * fq + j) * 16 + fr] = acc[j];
}
__device__ __forceinline__ float get_sum(const float* red, int slot, int tid) {
    float v = 0.f;
#pragma unroll
    for (int w = 0; w < 8; ++w) v += red[(slot * 8 + w) * 256 + tid];
    return v;
}
__device__ __forceinline__ int item0() { return (int)gridDim.x - 1 - (int)blockIdx.x; }
}

__device__ __forceinline__ void meta_proj(const Ctx& c, int layer) {
    const int tid = c.tid, wv = tid >> 6, lane = tid & 63, fr = lane & 15, fq = lane >> 4;
    const bf16_t* A = c.XN() + (size_t)(R + fr) * D + fq * 8;
    const bf16_t* W = (const bf16_t*)(c.a->ws + WS_WB + layer * WB_LAYER + WB_IN);
    float* red = c.smem;
    for (int g = mg::item0(); g < PC / 16; g += gridDim.x) {
        mg::f32x4 acc = {0.f, 0.f, 0.f, 0.f};
        mg::mma16(acc, A, W + (size_t)(g * 16 + fr) * D + fq * 8, wv * (D / 8), D / 8);
        __syncthreads();
        mg::put_partial<1>(red, 0, acc, tid);
        __syncthreads();
        if (tid < 256) c.PROJ()[(size_t)(R + (tid >> 4)) * PC + g * 16 + (tid & 15)] = f2bf(mg::get_sum(red, 0, tid));
    }
}
__device__ __forceinline__ void meta_merge(const Ctx& c, int layer) {
    const int tid = c.tid, wv = tid >> 6, lane = tid & 63, fr = lane & 15, fq = lane >> 4;
    const unsigned char* wb = c.a->ws + WS_WB + layer * WB_LAYER;
    float* red = c.smem;
    for (int g = mg::item0(); g < D / 16; g += gridDim.x) {
        const int n = g * 16 + fr;
        mg::f32x4 ga[3], ya[3];
#pragma unroll
        for (int j3 = 0; j3 < 3; ++j3) {
            ga[j3] = (mg::f32x4){0.f, 0.f, 0.f, 0.f}; ya[j3] = (mg::f32x4){0.f, 0.f, 0.f, 0.f};
            mg::mma16(ga[j3], c.XN() + (size_t)(R + fr) * D + fq * 8, (const bf16_t*)(wb + WB_G) + (size_t)(j3 * D + n) * D + fq * 8, wv * (D / 8), D / 8);
            const int acol = j3 == 0 ? C_FQ : j3 == 1 ? C_SQ : C_LG;
            const bf16_t* Wo = (const bf16_t*)(wb + (j3 == 0 ? WB_FO : j3 == 1 ? WB_SO : WB_LO));
            mg::mma16(ya[j3], c.PROJ() + (size_t)(R + fr) * PC + acol + fq * 8, Wo + (size_t)n * 512 + fq * 8, wv * 64, 64);
        }
        __syncthreads();
#pragma unroll
        for (int j3 = 0; j3 < 3; ++j3) { mg::put_partial<6>(red, 2 * j3, ga[j3], tid); mg::put_partial<6>(red, 2 * j3 + 1, ya[j3], tid); }
        __syncthreads();
        if (tid < 256) {
            const int col = g * 16 + (tid & 15);
            float m = 0.f;
#pragma unroll
            for (int j3 = 0; j3 < 3; ++j3) {
                const float gv = mg::get_sum(red, 2 * j3, tid) + c.b_gate()[layer * 3 * D + j3 * D + col];
                m += mg::get_sum(red, 2 * j3 + 1, tid) * __builtin_amdgcn_rcpf(1.f + __builtin_amdgcn_exp2f(-1.4426950408889634f * gv));
            }
            c.PROJ()[(size_t)(R + (tid >> 4)) * PC + C_MRG + col] = f2bf(m);
        }
    }
}
__device__ __forceinline__ void meta_resid(const Ctx& c, const float* src, const bf16_t* A, int lda, const bf16_t* Wt, int K) {
    const int tid = c.tid, wv = tid >> 6, lane = tid & 63, fr = lane & 15, fq = lane >> 4;
    float* red = c.smem;
    const int kl = K / 8;
    for (int g = mg::item0(); g < D / 16; g += gridDim.x) {
        const int n = g * 16 + fr;
        mg::f32x4 acc = {0.f, 0.f, 0.f, 0.f};
        mg::mma16(acc, A + (size_t)(R + fr) * lda + fq * 8, Wt + (size_t)n * K + fq * 8, wv * kl, kl);
        __syncthreads();
        mg::put_partial<1>(red, 0, acc, tid);
        __syncthreads();
        if (tid < 256) { const size_t o = (size_t)(tid >> 4) * D + g * 16 + (tid & 15); c.hmeta()[o] = src[o] + mg::get_sum(red, 0, tid); }
    }
}
__device__ __forceinline__ void meta_ffn_up(const Ctx& c) {
    const int tid = c.tid, wv = tid >> 6, lane = tid & 63, fr = lane & 15, fq = lane >> 4;
    const bf16_t* W = (const bf16_t*)(c.a->ws + WS_WGU);
    const bf16_t* A = c.XN() + (size_t)(R + fr) * D + fq * 8;
    float* red = c.smem;
    for (int g = mg::item0(); g < DFF / 16; g += gridDim.x) {
        const int h = g * 16 + fr; const int rg = 8 * (h >> 2) + (h & 3);
        mg::f32x4 ga = {0.f, 0.f, 0.f, 0.f}, ua = {0.f, 0.f, 0.f, 0.f};
        mg::mma16(ga, A, W + (size_t)rg * D + fq * 8, wv * (D / 8), D / 8);
        mg::mma16(ua, A, W + (size_t)(rg + 4) * D + fq * 8, wv * (D / 8), D / 8);
        __syncthreads();
        mg::put_partial<2>(red, 0, ga, tid); mg::put_partial<2>(red, 1, ua, tid);
        __syncthreads();
        if (tid < 256) {
            const float gs = mg::get_sum(red, 0, tid), us = mg::get_sum(red, 1, tid);
            c.PROJ()[(size_t)(R + (tid >> 4)) * DFF + g * 16 + (tid & 15)] = f2bf(gs * us * __builtin_amdgcn_rcpf(1.f + __builtin_amdgcn_exp2f(-1.4426950408889634f * gs)));
        }
    }
}

struct CvtJob { const float* src; bf16_t* dst; int ldw, K, N, mode; };
__device__ __forceinline__ void cvt_load(const CvtJob& j, int t, int nk, int g, int ko, float4 (&v)[8]) {
    const int kt = t % nk, ntile = t / nk;
    const float* sp = j.src + (size_t)(kt * 128 + ko * 8) * j.ldw + ntile * 128 + g * 4;
#pragma unroll
    for (int i = 0; i < 8; ++i) v[i] = *(const float4*)(sp + (size_t)i * j.ldw);
}
__device__ __forceinline__ void cvt_store(const CvtJob& j, int t, int nk, int g, int ko, const float4 (&v)[8], uint4* img, int tid) {
    const int kt = t % nk, ntile = t / nk;
    lds_barrier();
#pragma unroll
    for (int q = 0; q < 4; ++q) {
        float e[8];
#pragma unroll
        for (int i = 0; i < 8; ++i) e[i] = q == 0 ? v[i].x : q == 1 ? v[i].y : q == 2 ? v[i].z : v[i].w;
        uint4 o; o.x = pack2(e[0], e[1]); o.y = pack2(e[2], e[3]); o.z = pack2(e[4], e[5]); o.w = pack2(e[6], e[7]);
        img[(4 * g + q) * 16 + (ko ^ (g & 15))] = o;
    }
    lds_barrier();
    const int c16 = tid & 15, r0 = tid >> 4;
#pragma unroll
    for (int i = 0; i < 4; ++i) {
        const int r = r0 + 32 * i;
        const uint4 o = img[r * 16 + (c16 ^ ((r >> 2) & 15))];
        const int ng = ntile * 128 + r;
        const int row = j.mode == 0 ? ng : (8 * (ng >> 2) + (ng & 3) + (j.mode == 2 ? 4 : 0));
        *(uint4*)(j.dst + (size_t)row * j.K + kt * 128 + c16 * 8) = o;
    }
}
__device__ __forceinline__ void cvt_tiles(const CvtJob& j, int& base, float* lds, int tid) {
    const int nk = j.K / 128, nn = j.N / 128, nt = nk * nn;
    const int G = gridDim.x;
    const int g = tid & 31, ko = tid >> 5;
    uint4* img = (uint4*)lds;
    const int first = ((int)blockIdx.x - base % G + G) % G;
    float4 va[8], vb[8];
    if (first < nt) cvt_load(j, first, nk, g, ko, va);
    for (int t = first; t < nt; t += 2 * G) {
        if (t + G < nt) cvt_load(j, t + G, nk, g, ko, vb);
        cvt_store(j, t, nk, g, ko, va, img, tid);
        if (t + G < nt) {
            if (t + 2 * G < nt) cvt_load(j, t + 2 * G, nk, g, ko, va);
            cvt_store(j, t + G, nk, g, ko, vb, img, tid);
        }
    }
    base += nt;
}
__device__ __forceinline__ void phase_cvt_dense(const Ctx& c) {
    int base = 0; float* tile = c.smem; unsigned char* ws = c.a->ws;
#pragma unroll 1
    for (int l = 0; l < 2; ++l) {
        const float* win = c.w_in() + (size_t)l * D * INC; unsigned char* wb = ws + WS_WB + l * WB_LAYER;
        cvt_tiles(CvtJob{win, (bf16_t*)(wb + WB_IN), INC, D, 1536, 0}, base, tile, c.tid);
        cvt_tiles(CvtJob{win + 1540, (bf16_t*)(wb + WB_IN) + (size_t)1536 * D, INC, D, 2560, 0}, base, tile, c.tid);
        cvt_tiles(CvtJob{win + WI_GATES, (bf16_t*)(wb + WB_G), INC, D, 3 * D, 0}, base, tile, c.tid);
        cvt_tiles(CvtJob{c.w_fox_o() + (size_t)l * 512 * D, (bf16_t*)(wb + WB_FO), D, 512, D, 0}, base, tile, c.tid);
        cvt_tiles(CvtJob{c.w_sb_o() + (size_t)l * 512 * D, (bf16_t*)(wb + WB_SO), D, 512, D, 0}, base, tile, c.tid);
        cvt_tiles(CvtJob{c.w_lru_o() + (size_t)l * 512 * D, (bf16_t*)(wb + WB_LO), D, 512, D, 0}, base, tile, c.tid);
        cvt_tiles(CvtJob{c.w_out() + (size_t)l * D * D, (bf16_t*)(wb + WB_OUT), D, D, D, 0}, base, tile, c.tid);
    }
    cvt_tiles(CvtJob{c.ffn_wg(), (bf16_t*)(ws + WS_WGU), DFF, D, DFF, 1}, base, tile, c.tid);
    cvt_tiles(CvtJob{c.ffn_wu(), (bf16_t*)(ws + WS_WGU), DFF, D, DFF, 2}, base, tile, c.tid);
    cvt_tiles(CvtJob{c.ffn_wd(), (bf16_t*)(ws + WS_WD), D, DFF, D, 0}, base, tile, c.tid);
}
__device__ __forceinline__ void phase_cvt_moe(const Ctx& c) {
    int base = 0; float* tile = c.smem; unsigned char* ws = c.a->ws;
#pragma unroll 1
    for (int e = 0; e < NE; ++e) {
        cvt_tiles(CvtJob{c.moe_wg() + (size_t)e * D * DFE, (bf16_t*)(ws + WS_MOE_GU) + (size_t)e * 2 * DFE * D, DFE, D, DFE, 1}, base, tile, c.tid);
        cvt_tiles(CvtJob{c.moe_wu() + (size_t)e * D * DFE, (bf16_t*)(ws + WS_MOE_GU) + (size_t)e * 2 * DFE * D, DFE, D, DFE, 2}, base, tile, c.tid);
        cvt_tiles(CvtJob{c.moe_wd() + (size_t)e * DFE * D, (bf16_t*)(ws + WS_MOE_D) + (size_t)e * D * DFE, D, DFE, D, 0}, base, tile, c.tid);
    }
}

__device__ __forceinline__ void final_row(const Ctx& c, const float4 (&gv)[4], int rr, const bf16_t* y0, const bf16_t* y1, float w0, float w1, int lane) {
    float* hrow = c.out() + (size_t)rr * D;
    float v[16];
    float ss = 0.f;
#pragma unroll
    for (int i = 0; i < 4; ++i) {
        const float4 t = *(const float4*)(hrow + i * 256 + lane * 4);
        const uint2 a = *(const uint2*)(y0 + i * 256 + lane * 4), bq = *(const uint2*)(y1 + i * 256 + lane * 4);
        v[4 * i] = t.x + w0 * bflo(a.x) + w1 * bflo(bq.x); v[4 * i + 1] = t.y + w0 * bfhi(a.x) + w1 * bfhi(bq.x);
        v[4 * i + 2] = t.z + w0 * bflo(a.y) + w1 * bflo(bq.y); v[4 * i + 3] = t.w + w0 * bfhi(a.y) + w1 * bfhi(bq.y);
    }
#pragma unroll
    for (int k = 0; k < 16; ++k) ss += v[k] * v[k];
    ss = wave_sum(ss);
    const float rstd = rsqrtf(ss * (1.f / D) + RMS_EPS);
#pragma unroll
    for (int i = 0; i < 4; ++i) {
        const float4 g = gv[i];
        float4 o; o.x = v[4 * i] * rstd * g.x; o.y = v[4 * i + 1] * rstd * g.y; o.z = v[4 * i + 2] * rstd * g.z; o.w = v[4 * i + 3] * rstd * g.w;
        *(float4*)(hrow + i * 256 + lane * 4) = o;
    }
}
__device__ __forceinline__ void phase_final(const Ctx& c, int part) {
    MoeMap m; moe_map(c, m);
    const int lane = c.lane;
    float4 gv[4]; gain_load(c.g_final(), gv, lane);
    constexpr int SLOT_LIM = (MOE_NCH - 1) * MOE_CH;
    int nlast = (m.ebase[8] - SLOT_LIM) / 256; nlast = nlast < 0 ? 0 : (nlast > MOE_CH / 256 ? MOE_CH / 256 : nlast);
    int nbusy = nlast * (D / 256);
    if (nbusy > (int)gridDim.x - 64) nbusy = (int)gridDim.x - 64;
    int wgi = blockIdx.x, nwg = gridDim.x;
    if (part == 0) { wgi = (int)blockIdx.x - nbusy; nwg = (int)gridDim.x - nbusy; if (wgi < 0) return; }
    const int rfirst = wgi * 8 + c.wave, rstep = nwg * 8;
    int mp0 = 0, mp1 = 0;
    { const int rl = rfirst + lane * rstep; if (rl < R) { mp0 = c.PAIR()[(size_t)rl * 2]; mp1 = c.PAIR()[(size_t)rl * 2 + 1]; } }
    int ri = 0;
    for (int rr = rfirst; rr < R; rr += rstep, ++ri) {
        const int p0 = __shfl(mp0, ri), p1 = __shfl(mp1, ri);
        int b0 = 0, b1 = 0;
#pragma unroll
        for (int k = 0; k < 8; ++k) { if (k == (p0 >> 20)) b0 = m.ebase[k]; if (k == (p1 >> 20)) b1 = m.ebase[k]; }
        const int s0 = b0 + (p0 & 0xFFFFF), s1 = b1 + (p1 & 0xFFFFF);
        const bool early = s0 < SLOT_LIM && s1 < SLOT_LIM;
        if (early != (part == 0)) continue;
        const float w0 = c.TOPW()[(size_t)rr * 2], w1 = c.TOPW()[(size_t)rr * 2 + 1];
        final_row(c, gv, rr, c.Y() + (size_t)s0 * D, c.Y() + (size_t)s1 * D, w0, w1, lane);
    }
}

constexpr int LDS_BYTES = 147456;
__global__ void __launch_bounds__(NTHR, 2) fwd(Args args) {
    extern __shared__ __attribute__((aligned(16))) unsigned char lds[];
    if (threadIdx.x < 4) ((unsigned*)(lds + 131072))[threadIdx.x] = 0u;
    __syncthreads();
    XcdBarrier bar = xcd_barrier_post((unsigned*)(args.ws + WS_BAR), (volatile LAS unsigned*)(lds + 131072));
#if defined(PROBE_G1)
    unsigned long long pr_t = __builtin_amdgcn_s_memrealtime(), pr_a1 = 0, pr_a2 = 0; int pr_k = 0;
#define SEAM_N(nk) do { xcd_barrier(bar); if (blockIdx.x == 0) { const unsigned long long t_ = __builtin_amdgcn_s_memrealtime(); \
        if ((PROBE_G1 >> pr_k) & 1u) pr_a1 += t_ - pr_t; if ((PROBE_G2 >> pr_k) & 1u) pr_a2 += t_ - pr_t; pr_t = t_; } pr_k = (nk); } while (0)
#define SEAM() SEAM_N(pr_k + 1)
#define MIDSEAM(k2) SEAM_N(k2)
#else
#define MIDSEAM(k2)
#define SEAM() xcd_barrier(bar)
#define SEAM_N(nk) xcd_barrier(bar)
#endif
#ifndef PHMASK
#define PHMASK 0xFFFFFFFFu
#endif
#define PH(k) (((PHMASK & args.phmask) >> (k)) & 1u)
#define MKCTX() Ctx c; c.a = &args; c.smem = (float*)lds; { int t_ = threadIdx.x; asm volatile("" : "+v"(t_)); c.tid = t_; c.lane = t_ & 63; c.wave = __builtin_amdgcn_readfirstlane(t_ >> 6); }
    LAS unsigned char* L = (LAS unsigned char*)lds;
    if (PH(0)) { MKCTX(); phase_cvt_dense(c); }
    if (PH(0)) { MKCTX(); phase_norm(c, 0, 0); }
    SEAM();
    if (PH(1)) { MKCTX(); side_cumsum(c); }
    if (PH(1)) { MKCTX(); meta_proj(c, 0); }
    if (PH(1)) { MKCTX(); phase_proj_main(c, 0, L); }
    SEAM();
    if (PH(2)) { MKCTX(); phase_attn_main(c, 0, L); }
    if (PH(2)) { MKCTX(); phase_attn(c, 0); }
    SEAM();
    if (PH(3)) { MKCTX(); phase_lru_carry(c); }
    SEAM();
    if (PH(4)) { MKCTX(); phase_lru(c, 0, 1); }
    SEAM();
    if (PH(5)) { MKCTX(); meta_merge(c, 0); }
    if (PH(5)) { MKCTX(); phase_merge_main(c, 0, L); }
    SEAM();
    if (PH(6)) { MKCTX(); meta_resid(c, c.meta(), c.PROJ() + C_MRG, PC, (const bf16_t*)(args.ws + WS_WB + WB_OUT), D); }
    if (PH(6)) { MKCTX(); phase_resid_main(c, c.x(), (unsigned)(WS_PROJ + C_MRG * 2), PC * 2, (unsigned)(WS_WB + WB_OUT), D, L); }
    SEAM();
    if (PH(7)) { MKCTX(); phase_norm(c, 0, 1); }
    SEAM();
    if (PH(8)) { MKCTX(); meta_ffn_up(c); }
    if (PH(8)) { MKCTX(); phase_ffn_up_main(c, L); }
    SEAM();
    if (PH(9)) { MKCTX(); meta_resid(c, c.hmeta(), c.PROJ(), DFF, (const bf16_t*)(args.ws + WS_WD), DFF); }
    if (PH(9)) { MKCTX(); phase_resid_main(c, c.out(), (unsigned)WS_PROJ, DFF * 2, (unsigned)WS_WD, DFF, L); }
    SEAM();
    if (PH(10)) { MKCTX(); phase_norm(c, 1, 0); }
    SEAM();
    if (PH(11)) { MKCTX(); side_cumsum(c); }
    if (PH(11)) { MKCTX(); meta_proj(c, 1); }
    if (PH(11)) { MKCTX(); phase_proj_main(c, 1, L); }
    SEAM();
    if (PH(12)) { MKCTX(); phase_attn_main(c, 1, L); }
    if (PH(12)) { MKCTX(); phase_attn(c, 1); }
    SEAM();
    if (PH(13)) { MKCTX(); phase_lru_carry(c); }
    SEAM();
    if (PH(14)) { MKCTX(); phase_lru(c, 1, 1); }
    SEAM();
    if (PH(15)) { MKCTX(); phase_merge_main(c, 1, L); }
    SEAM();
    if (PH(16)) { MKCTX(); phase_resid_main(c, c.out(), (unsigned)(WS_PROJ + C_MRG * 2), PC * 2, (unsigned)(WS_WB + WB_LAYER + WB_OUT), D, L); }
    SEAM();
    if (PH(17)) { MKCTX(); phase_cvt_moe(c); }
    if (PH(17)) { MKCTX(); phase_norm(c, 1, 1); }
    SEAM();
#pragma unroll 1
    for (int ch = 0; ch < MOE_NCH; ++ch) {
        if (PH(18)) { MKCTX(); phase_moe_up(c, ch, L); }
        SEAM_N(19);
        if (PH(19)) { MKCTX(); phase_moe_down(c, ch, L); }
        if (ch < MOE_NCH - 1) SEAM_N(18);
    }
    if (PH(20)) { MKCTX(); phase_final(c, 0); }
    SEAM_N(20);
    if (PH(20)) { MKCTX(); phase_final(c, 1); }
#if defined(PROBE_G1)
    if (blockIdx.x == 0) {
        __syncthreads();
        if (threadIdx.x == 0) {
            const unsigned long long t_ = __builtin_amdgcn_s_memrealtime();
            if ((PROBE_G1 >> 20) & 1u) pr_a1 += t_ - pr_t; if ((PROBE_G2 >> 20) & 1u) pr_a2 += t_ - pr_t;
            const unsigned long long wait = 16ull * pr_a1 + 0ull * pr_a2;
            while (__builtin_amdgcn_s_memrealtime() - t_ < wait) __builtin_amdgcn_s_sleep(32);
        }
    }
#endif
}

extern "C" void kernel_launch(void* const* d_in, const int* in_sizes, int n_in, void* d_out, int out_size, void* d_ws, size_t ws_size, hipStream_t stream) {
    static int grid = 0;
    if (grid == 0) {
        if (n_in != 26 || out_size != R * D || ws_size < WS_END) { fprintf(stderr, "kernel_launch: unexpected problem (n_in %d out %d ws %zu)\n", n_in, out_size, ws_size); grid = -1; return; }
        int dev = 0, cus = 0, per_cu = 0;
        if (hipGetDevice(&dev) != hipSuccess || hipDeviceGetAttribute(&cus, hipDeviceAttributeMultiprocessorCount, dev) != hipSuccess) { grid = -1; return; }
        if (hipFuncSetAttribute((const void*)fwd, hipFuncAttributeMaxDynamicSharedMemorySize, LDS_BYTES) != hipSuccess) { grid = -1; return; }
        if (hipOccupancyMaxActiveBlocksPerMultiprocessor(&per_cu, (const void*)fwd, NTHR, LDS_BYTES) != hipSuccess || per_cu < 1) { fprintf(stderr, "occupancy query: %d\n", per_cu); }
        (void)hipGetLastError();
        grid = cus;
    }
    if (grid < 0) return;
    (void)hipMemsetAsync(d_ws, 0, WS_ZERO_BYTES, stream);
    Args a{};
    for (int i = 0; i < 26; ++i) a.in[i] = (const float*)d_in[i];
    a.out = (float*)d_out; a.ws = (unsigned char*)d_ws; a.phmask = 0xFFFFFFFFu; a.pad = 0u;
    hipLaunchKernelGGL(fwd, dim3(grid), dim3(NTHR), LDS_BYTES, stream, a);
}
```

```cpp
#include <hip/hip_runtime.h>
#include <cstdio>
#include <cstdint>


typedef unsigned short bf16_t;
#define LAS __attribute__((address_space(3)))

constexpr int D = 1024, NB = 4, S = 8192, NM = 16, R = NB * S, RT = R + NM;
constexpr int INC = 7172;
constexpr int PC = 4096;
constexpr int C_FQ = 0, C_FK = 512, C_FV = 1024, C_SQ = 1536, C_SK = 2048, C_SV = 2560, C_LX = 3072, C_LG = 3584, C_MRG = 512;
constexpr int WI_GATES = 4100;
constexpr int DFF = 2816, DFE = 3584, NE = 8;
constexpr int LCH = 128, NLC = S / LCH;
constexpr int MOE_CH = 16384;
constexpr int MOE_NCH = 5;
constexpr int NTHR = 512;
constexpr float RMS_EPS = 1e-6f;

constexpr size_t MiB = 1ull << 20;
constexpr size_t WS_BAR = 0;
constexpr size_t WS_CNT = 16384;
constexpr size_t WS_KPART = 16384 + 1024;
constexpr size_t WS_FOXQ = 16384 + 2048;
constexpr size_t WS_ZERO_BYTES = 16384 + 4096;
constexpr size_t WS_HMETA = 32768;
constexpr size_t WS_LF = 1 * MiB;
constexpr size_t WS_C = 2 * MiB;
constexpr size_t WS_SUMP = 3 * MiB;
constexpr size_t WS_SUME = 4 * MiB + 65536;
constexpr size_t WS_CARRY = 5 * MiB + 131072;
constexpr size_t WS_LIST = 6 * MiB + 262144;
constexpr size_t WS_PAIR = 7 * MiB + 524288;
constexpr size_t WS_TOPW = 7 * MiB + 786432;
constexpr size_t WS_XN = 8 * MiB;
constexpr size_t WS_PROJ = 73 * MiB;
constexpr size_t WS_HIDC_OFF = 0;
constexpr size_t WS_Y_OFF = 112 * MiB;
constexpr size_t WS_WB = 331 * MiB;
constexpr size_t WB_LAYER = 19 * MiB, WB_IN = 0, WB_G = 8 * MiB, WB_FO = 14 * MiB, WB_SO = 15 * MiB, WB_LO = 16 * MiB, WB_OUT = 17 * MiB;
constexpr size_t WS_WGU = 369 * MiB;
constexpr size_t WS_WD = 380 * MiB;
constexpr size_t WS_GSCR = 400 * MiB;
constexpr size_t WS_VT = 432 * MiB;
constexpr size_t WS_MOE_GU = 331 * MiB;
constexpr size_t WS_MOE_D = 443 * MiB;
constexpr size_t WS_END = 499 * MiB;

__device__ __forceinline__ float bf2f(bf16_t v) { return __uint_as_float(((unsigned)v) << 16); }
__device__ __forceinline__ float bflo(unsigned v) { return __uint_as_float(v << 16); }
__device__ __forceinline__ float bfhi(unsigned v) { return __uint_as_float(v & 0xFFFF0000u); }
__device__ __forceinline__ bf16_t f2bf(float f) { unsigned u = __float_as_uint(f); u += 0x7FFFu + ((u >> 16) & 1u); return (bf16_t)(u >> 16); }
__device__ __forceinline__ unsigned pack2(float a, float b) { return (unsigned)f2bf(a) | ((unsigned)f2bf(b) << 16); }
__device__ __forceinline__ void lds_barrier() { asm volatile("s_waitcnt lgkmcnt(0)" ::: "memory"); __builtin_amdgcn_s_barrier(); asm volatile("" ::: "memory"); }
__device__ __forceinline__ float wave_sum(float v) {
#pragma unroll
    for (int o = 32; o; o >>= 1) v += __shfl_xor(v, o);
    return v;
}
__device__ __forceinline__ float wave_max(float v) {
#pragma unroll
    for (int o = 32; o; o >>= 1) v = fmaxf(v, __shfl_xor(v, o));
    return v;
}
__device__ __forceinline__ float sigmoidf_(float x) { return 1.f / (1.f + expf(-x)); }
__device__ __forceinline__ float softplusf_(float x) { return fmaxf(x, 0.f) + log1pf(expf(-fabsf(x))); }
__device__ __forceinline__ float logsigf_(float x) { return fminf(x, 0.f) - log1pf(expf(-fabsf(x))); }
__device__ __forceinline__ float gelu_tanh(float x) { return 0.5f * x * (1.f + tanhf(0.7978845608028654f * (x + 0.044715f * x * x * x))); }

#define XB_TMO      128
#define XB_XCNT(j)  (256  + 64 * (j))
#define XB_XSUB(j)  (1280 + 64 * (j))
#define XB_XGEN(j)  (2304 + 64 * (j))
#define XB_TOP      3328
#define XB_TOPGEN   3392
#define XCD_BAR_WORDS 3456
#define XB_SPIN_CAP (1u << 24)
__device__ __forceinline__ unsigned xb_ld(unsigned* p)              { return __hip_atomic_load(p, __ATOMIC_RELAXED, __HIP_MEMORY_SCOPE_AGENT); }
__device__ __forceinline__ unsigned xb_add(unsigned* p, unsigned v) { return __hip_atomic_fetch_add(p, v, __ATOMIC_RELAXED, __HIP_MEMORY_SCOPE_AGENT); }
__device__ __forceinline__ unsigned xb_xcc_id() { return (unsigned)__builtin_amdgcn_s_getreg((3 << 11) | 20) & 0xFu; }
#define XB_SPIN(cond, bar) do { unsigned _sp = 0; while (cond) { __builtin_amdgcn_s_sleep(1); \
    if ((++_sp & 255u) == 0u) { if (xb_ld(&(bar)[XB_TMO])) break; if (_sp > XB_SPIN_CAP) { atomicAdd(&(bar)[XB_TMO], 1u); break; } } } } while (0)
struct XcdBarrier { unsigned* bar; unsigned x; volatile LAS unsigned* st; };
__device__ __forceinline__ XcdBarrier xcd_barrier_post(unsigned* bar, volatile LAS unsigned* st) {
    XcdBarrier b; b.bar = bar; b.x = xb_xcc_id(); b.st = st;
    if (threadIdx.x == 0) (void)xb_add(&bar[XB_XCNT(b.x)], 1u);
    return b;
}
__device__ __forceinline__ void xcd_barrier_complete(unsigned* bar, unsigned x, unsigned& nloc, unsigned& nx) {
    const unsigned G = gridDim.x * gridDim.y * gridDim.z;
    unsigned sum, cnt, mine, sp = 0u;
    for (;;) {
        sum = 0u; cnt = 0u; mine = 0u;
#pragma unroll
        for (unsigned j = 0; j < 16; ++j) { const unsigned c = xb_ld(&bar[XB_XCNT(j)]); sum += c; cnt += (c > 0u) ? 1u : 0u; mine = (j == x) ? c : mine; }
        if (sum == G) break;
        __builtin_amdgcn_s_sleep(1);
        if ((++sp & 255u) == 0u) { if (xb_ld(&bar[XB_TMO])) break; if (sp > XB_SPIN_CAP) { atomicAdd(&bar[XB_TMO], 1u); break; } }
    }
    nloc = mine > 0u ? mine : 1u; nx = cnt > 0u ? cnt : 1u;
}
__device__ __forceinline__ void xcd_barrier(const XcdBarrier& b) {
    asm volatile("s_waitcnt vmcnt(0)" ::: "memory");
    __syncthreads();
    if (threadIdx.x == 0) {
        unsigned* bar = b.bar;
        __builtin_amdgcn_s_waitcnt(0);
        unsigned nloc = b.st[0], nx = b.st[1];
        if (nloc == 0u) { xcd_barrier_complete(bar, b.x, nloc, nx); b.st[0] = nloc; b.st[1] = nx; }
        const unsigned old = xb_add(&bar[XB_XSUB(b.x)], 1u);
        const unsigned gen = old / nloc;
        if (old + 1u == (gen + 1u) * nloc) {
            __builtin_amdgcn_fence(__ATOMIC_RELEASE, "agent");
            asm volatile("s_waitcnt vmcnt(0)" ::: "memory");
            const unsigned og = xb_add(&bar[XB_TOP], 1u);
            const unsigned tg = og / nx;
            if (og + 1u == (tg + 1u) * nx) xb_add(&bar[XB_TOPGEN], 1u);
            else XB_SPIN(xb_ld(&bar[XB_TOPGEN]) == tg, bar);
            __builtin_amdgcn_fence(__ATOMIC_ACQUIRE, "agent");
            xb_add(&bar[XB_XGEN(b.x)], 1u);
            asm volatile("s_waitcnt vmcnt(0)" ::: "memory");
        } else {
            XB_SPIN(xb_ld(&bar[XB_XGEN(b.x)]) == gen, bar);
            __builtin_amdgcn_fence(__ATOMIC_ACQUIRE, "agent");
            asm volatile("s_waitcnt vmcnt(0)" ::: "memory");
        }
    }
    __syncthreads();
}

struct Args { const float* in[26]; float* out; unsigned char* ws; unsigned phmask; unsigned pad; };

struct Ctx {
    const Args* a; float* smem; int tid, lane, wave;
    __device__ __forceinline__ const float* x() const { return a->in[0]; }
    __device__ __forceinline__ const float* meta() const { return a->in[1]; }
    __device__ __forceinline__ const float* g_mix() const { return a->in[2]; }
    __device__ __forceinline__ const float* w_in() const { return a->in[3]; }
    __device__ __forceinline__ const float* b_forget() const { return a->in[4]; }
    __device__ __forceinline__ const float* b_gate() const { return a->in[5]; }
    __device__ __forceinline__ const float* conv_w() const { return a->in[6]; }
    __device__ __forceinline__ const float* conv_b() const { return a->in[7]; }
    __device__ __forceinline__ const float* wa() const { return a->in[8]; }
    __device__ __forceinline__ const float* ba() const { return a->in[9]; }
    __device__ __forceinline__ const float* wx() const { return a->in[10]; }
    __device__ __forceinline__ const float* bx() const { return a->in[11]; }
    __device__ __forceinline__ const float* lam() const { return a->in[12]; }
    __device__ __forceinline__ const float* w_fox_o() const { return a->in[13]; }
    __device__ __forceinline__ const float* w_sb_o() const { return a->in[14]; }
    __device__ __forceinline__ const float* w_lru_o() const { return a->in[15]; }
    __device__ __forceinline__ const float* w_out() const { return a->in[16]; }
    __device__ __forceinline__ const float* g_ffn() const { return a->in[17]; }
    __device__ __forceinline__ const float* ffn_wg() const { return a->in[18]; }
    __device__ __forceinline__ const float* ffn_wu() const { return a->in[19]; }
    __device__ __forceinline__ const float* ffn_wd() const { return a->in[20]; }
    __device__ __forceinline__ const float* router_w() const { return a->in[21]; }
    __device__ __forceinline__ const float* moe_wg() const { return a->in[22]; }
    __device__ __forceinline__ const float* moe_wu() const { return a->in[23]; }
    __device__ __forceinline__ const float* moe_wd() const { return a->in[24]; }
    __device__ __forceinline__ const float* g_final() const { return a->in[25]; }
    __device__ __forceinline__ float* out() const { return a->out; }
    __device__ __forceinline__ float* hmeta() const { return (float*)(a->ws + WS_HMETA); }
    __device__ __forceinline__ float* LF() const { return (float*)(a->ws + WS_LF); }
    __device__ __forceinline__ float* C() const { return (float*)(a->ws + WS_C); }
    __device__ __forceinline__ float* SUMP() const { return (float*)(a->ws + WS_SUMP); }
    __device__ __forceinline__ float* SUME() const { return (float*)(a->ws + WS_SUME); }
    __device__ __forceinline__ float* CARRY() const { return (float*)(a->ws + WS_CARRY); }
    __device__ __forceinline__ int* LIST() const { return (int*)(a->ws + WS_LIST); }
    __device__ __forceinline__ int* PAIR() const { return (int*)(a->ws + WS_PAIR); }
    __device__ __forceinline__ float* TOPW() const { return (float*)(a->ws + WS_TOPW); }
    __device__ __forceinline__ int* CNT() const { return (int*)(a->ws + WS_CNT); }
    __device__ __forceinline__ bf16_t* XN() const { return (bf16_t*)(a->ws + WS_XN); }
    __device__ __forceinline__ bf16_t* PROJ() const { return (bf16_t*)(a->ws + WS_PROJ); }
    __device__ __forceinline__ bf16_t* HIDC() const { return (bf16_t*)(a->ws + WS_PROJ + WS_HIDC_OFF); }
    __device__ __forceinline__ bf16_t* Y() const { return (bf16_t*)(a->ws + WS_PROJ + WS_Y_OFF); }
};

__device__ __forceinline__ const float* hsrc_row(const Ctx& c, int layer, int rr) {
    if (layer == 0) return rr < R ? c.x() + (size_t)rr * D : c.meta() + (size_t)(rr - R) * D;
    return rr < R ? c.out() + (size_t)rr * D : c.hmeta() + (size_t)(rr - R) * D;
}
__device__ __forceinline__ float* hdst_row(const Ctx& c, int rr) {
    return rr < R ? c.out() + (size_t)rr * D : c.hmeta() + (size_t)(rr - R) * D;
}

__device__ __forceinline__ void norm_load(const float* src, float4 (&nx)[4], int lane) {
#pragma unroll
    for (int i = 0; i < 4; ++i) nx[i] = *(const float4*)(src + i * 256 + lane * 4);
}
__device__ __forceinline__ void norm_take(const float4 (&nx)[4], float (&v)[16]) {
#pragma unroll
    for (int i = 0; i < 4; ++i) { v[4 * i] = nx[i].x; v[4 * i + 1] = nx[i].y; v[4 * i + 2] = nx[i].z; v[4 * i + 3] = nx[i].w; }
}
__device__ __forceinline__ void gain_load(const float* gain, float4 (&gv)[4], int lane) {
#pragma unroll
    for (int i = 0; i < 4; ++i) gv[i] = *(const float4*)(gain + i * 256 + lane * 4);
}
__device__ __forceinline__ void norm_row(const float4 (&gv)[4], bf16_t* dst, float (&v)[16], int lane) {
    float ss = 0.f;
#pragma unroll
    for (int k = 0; k < 16; ++k) ss += v[k] * v[k];
    ss = wave_sum(ss);
    const float rstd = rsqrtf(ss * (1.f / D) + RMS_EPS);
#pragma unroll
    for (int i = 0; i < 4; ++i) {
        const float4 g = gv[i];
        v[4 * i] *= rstd * g.x; v[4 * i + 1] *= rstd * g.y; v[4 * i + 2] *= rstd * g.z; v[4 * i + 3] *= rstd * g.w;
        uint2 o; o.x = pack2(v[4 * i], v[4 * i + 1]); o.y = pack2(v[4 * i + 2], v[4 * i + 3]);
        *(uint2*)(dst + i * 256 + lane * 4) = o;
    }
}
__device__ __forceinline__ void phase_norm(const Ctx& c, int layer, int mode) {
    const int lane = c.lane;
    const float* gain = (mode == 0 ? c.g_mix() : c.g_ffn()) + layer * D;
    float4 gv[4]; gain_load(gain, gv, lane);
    if (mode == 1 && layer == 1) {
        int* lcnt = (int*)c.smem;
        int* ent = lcnt + 16;
        float* entw = (float*)(ent + 512);
        float4* rw = (float4*)(c.smem + 1024);
        __syncthreads();
        for (int idx = c.tid; idx < 2 * D; idx += NTHR) {
            const int col = idx >> 1, h = idx & 1;
            rw[(((col >> 8) * 4 + (col & 3)) * 2 + h) * 64 + ((col >> 2) & 63)] = *(const float4*)(c.router_w() + (size_t)col * 8 + h * 4);
        }
        for (int chunk = blockIdx.x; chunk < R / 128; chunk += gridDim.x) {
            __syncthreads();
            if (c.tid < 16) lcnt[c.tid] = 0;
            __syncthreads();
            float4 nx[4];
            norm_load(c.out() + (size_t)(chunk * 128 + c.wave * 16) * D, nx, lane);
            for (int i = 0; i < 16; ++i) {
                const int lr = c.wave * 16 + i, rr = chunk * 128 + lr;
                float v[16];
                norm_take(nx, v);
                if (i < 15) norm_load(c.out() + (size_t)(rr + 1) * D, nx, lane);
                norm_row(gv, c.XN() + (size_t)rr * D, v, lane);
                float lg[8];
#pragma unroll
                for (int e = 0; e < 8; ++e) lg[e] = 0.f;
#pragma unroll
                for (int q = 0; q < 4; ++q)
#pragma unroll
                    for (int j = 0; j < 4; ++j) {
                        const float4 w0 = rw[((q * 4 + j) * 2) * 64 + lane];
                        const float4 w1 = rw[((q * 4 + j) * 2 + 1) * 64 + lane];
                        const float y = v[4 * q + j];
                        lg[0] += y * w0.x; lg[1] += y * w0.y; lg[2] += y * w0.z; lg[3] += y * w0.w;
                        lg[4] += y * w1.x; lg[5] += y * w1.y; lg[6] += y * w1.z; lg[7] += y * w1.w;
                    }
#pragma unroll
                for (int e = 0; e < 8; ++e) lg[e] = wave_sum(lg[e]);
                int i1 = 0; float v1 = lg[0];
#pragma unroll
                for (int e = 1; e < 8; ++e) if (lg[e] > v1) { v1 = lg[e]; i1 = e; }
                int i2 = -1; float v2 = -3.0e38f;
#pragma unroll
                for (int e = 0; e < 8; ++e) if (e != i1 && lg[e] > v2) { v2 = lg[e]; i2 = e; }
                const float w1 = 1.f / (1.f + expf(v2 - v1)), w2 = 1.f - w1;
                if (lane == 0) {
                    const int r1 = atomicAdd(&lcnt[i1], 1), r2 = atomicAdd(&lcnt[i2], 1);
                    ent[(lr * 2) * 2] = (rr << 3) | i1; ent[(lr * 2) * 2 + 1] = r1; entw[lr * 2] = w1;
                    ent[(lr * 2 + 1) * 2] = (rr << 3) | i2; ent[(lr * 2 + 1) * 2 + 1] = r2; entw[lr * 2 + 1] = w2;
                }
            }
            __syncthreads();
            if (c.tid < 8) lcnt[8 + c.tid] = atomicAdd(&c.CNT()[c.tid], lcnt[c.tid]);
            __syncthreads();
            if (c.tid < 256) {
                const int k = c.tid;
                const int re = ent[k * 2], e = re & 7, rr = re >> 3;
                const int pos = lcnt[8 + e] + ent[k * 2 + 1];
                c.LIST()[(size_t)e * R + pos] = rr;
                c.PAIR()[(size_t)rr * 2 + (k & 1)] = (e << 20) | pos;
                c.TOPW()[(size_t)rr * 2 + (k & 1)] = entw[k];
            }
        }
        return;
    }
    const int nrows = RT;
    float4* wfs = (float4*)c.smem;
    if (mode == 0) {
        const float* wf = c.w_in() + (size_t)layer * D * INC + 1536;
        __syncthreads();
        for (int k = c.tid; k < D; k += NTHR) wfs[((k >> 8) * 4 + (k & 3)) * 64 + ((k >> 2) & 63)] = *(const float4*)(wf + (size_t)k * INC);
        __syncthreads();
    }
    float4 nx[4];
    const float bfg = mode == 0 ? c.b_forget()[layer * 4 + (lane & 3)] : 0.f;
    const int rstep = gridDim.x * 8;
    { const int r0 = blockIdx.x * 8 + c.wave; if (r0 < nrows) norm_load((mode == 0) ? hsrc_row(c, layer, r0) : hdst_row(c, r0), nx, lane); }
    for (int rr = blockIdx.x * 8 + c.wave; rr < nrows; rr += rstep) {
        float v[16];
        norm_take(nx, v);
        if (rr + rstep < nrows) norm_load((mode == 0) ? hsrc_row(c, layer, rr + rstep) : hdst_row(c, rr + rstep), nx, lane);
        norm_row(gv, c.XN() + (size_t)rr * D, v, lane);
        if (mode == 0) {
            float d0 = 0.f, d1 = 0.f, d2 = 0.f, d3 = 0.f;
#pragma unroll
            for (int i = 0; i < 4; ++i)
#pragma unroll
                for (int j = 0; j < 4; ++j) {
                    const float4 w = wfs[(i * 4 + j) * 64 + lane];
                    const float y = v[4 * i + j];
                    d0 += y * w.x; d1 += y * w.y; d2 += y * w.z; d3 += y * w.w;
                }
            d0 = wave_sum(d0); d1 = wave_sum(d1); d2 = wave_sum(d2); d3 = wave_sum(d3);
            if (lane < 4) {
                const float dsel = lane == 0 ? d0 : lane == 1 ? d1 : lane == 2 ? d2 : d3;
                c.LF()[(size_t)rr * 4 + lane] = logsigf_(dsel + bfg);
            }
        }
    }
}

constexpr size_t WS_CT = 131072;
__device__ __forceinline__ void side_cumsum(const Ctx& c) {
    const int lane = c.lane;
    float* CT = (float*)(c.a->ws + WS_CT);
    for (int idx = blockIdx.x * 8 + c.wave; idx < 16 * (S / 64); idx += gridDim.x * 8) {
        const int seq = idx >> 7, chunk = idx & 127, b = seq >> 2, h = seq & 3;
        const size_t rr = (size_t)b * S + 64 * chunk + lane;
        float sc = c.LF()[rr * 4 + h];
#pragma unroll
        for (int o = 1; o < 64; o <<= 1) { const float t = __shfl_up(sc, o); if (lane >= o) sc += t; }
        c.C()[rr * 4 + h] = sc;
        if (lane == 63) CT[seq * 128 + chunk] = sc;
        if (b == 0 && chunk == 0) {
            float v = lane < NM ? c.LF()[(size_t)(R + lane) * 4 + h] : 0.f;
#pragma unroll
            for (int o = 1; o < 16; o <<= 1) { const float t = __shfl_up(v, o); if (lane >= o) v += t; }
            if (lane < NM) c.C()[(size_t)(R + lane) * 4 + h] = v;
        }
    }
}

__device__ __forceinline__ int key_row(int b, int g) { return g < NM ? R + g : b * S + g - NM; }

__device__ __forceinline__ float qk_dot(const float* qs, const bf16_t* kp) {
    float dot = 0.f;
#pragma unroll 4
    for (int dd = 0; dd < 16; ++dd) {
        const uint4 kk = *(const uint4*)(kp + dd * 8);
        const float4 qa = *(const float4*)(qs + dd * 8), qb = *(const float4*)(qs + dd * 8 + 4);
        dot += qa.x * bflo(kk.x) + qa.y * bfhi(kk.x) + qa.z * bflo(kk.y) + qa.w * bfhi(kk.y)
             + qb.x * bflo(kk.z) + qb.y * bfhi(kk.z) + qb.z * bflo(kk.w) + qb.w * bfhi(kk.w);
    }
    return dot;
}

__device__ __forceinline__ void attn_query(const Ctx& c, int type, int rr, int h) {
    const int lane = c.lane;
    int b, pg;
    if (rr < R) { b = rr >> 13; pg = NM + (rr & (S - 1)); } else { b = 0; pg = rr - R; }
    const int cq = type == 0 ? C_FQ : C_SQ, ck = type == 0 ? C_FK : C_SK, cv = type == 0 ? C_FV : C_SV;
    bf16_t* qrow = c.PROJ() + (size_t)rr * PC + cq + h * 128;
    float* q = c.smem + c.wave * 128;
    const float scale = 0.08838834764831845f;
    q[lane] = bf2f(qrow[lane]) * scale; q[lane + 64] = bf2f(qrow[lane + 64]) * scale;
    float a0 = 0.f, a1 = 0.f;
    if (type == 0) {
        float m = -1e30f, l = 0.f;
        const float cqv = c.C()[(size_t)rr * 4 + h];
        const int nk = pg + 1;
        for (int g0 = 0; g0 < nk; g0 += 64) {
            const int g = g0 + lane; const bool valid = g < nk;
            const int krow = key_row(b, valid ? g : 0);
            const float dot = qk_dot(q, c.PROJ() + (size_t)krow * PC + ck + h * 128);
            const float sc = valid ? dot + cqv - c.C()[(size_t)krow * 4 + h] : -__builtin_inff();
            const float mn = fmaxf(m, wave_max(sc));
            const float p = valid ? expf(sc - mn) : 0.f;
            const float alpha = expf(m - mn);
            l = l * alpha + wave_sum(p); a0 *= alpha; a1 *= alpha; m = mn;
            const int cnt = min(64, nk - g0);
            for (int j = 0; j < cnt; ++j) {
                const float pj = __shfl(p, j);
                const int vrow = key_row(b, g0 + j);
                const unsigned vv = *(const unsigned*)(c.PROJ() + (size_t)vrow * PC + cv + h * 128 + lane * 2);
                a0 += pj * bflo(vv); a1 += pj * bfhi(vv);
            }
        }
        const float inv = 1.f / l; a0 *= inv; a1 *= inv;
    } else {
        float Rrun = 0.f;
        for (int gtop = pg - 1; gtop >= 0; gtop -= 64) {
            const int g = gtop - lane; const bool valid = g >= 0;
            const int krow = key_row(b, valid ? g : 0);
            const float z = qk_dot(q, c.PROJ() + (size_t)krow * PC + ck + h * 128);
            const float sp = softplusf_(z);
            const float mval = valid ? -sp : 0.f;
            float sc = mval;
#pragma unroll
            for (int o = 1; o < 64; o <<= 1) { const float t = __shfl_up(sc, o); if (lane >= o) sc += t; }
            const float excl = sc - mval;
            const float p = valid ? expf(z - sp + Rrun + excl) : 0.f;
            const int cnt = min(64, gtop + 1);
            for (int j = 0; j < cnt; ++j) {
                const float pj = __shfl(p, j);
                const int vrow = key_row(b, gtop - j);
                const unsigned vv = *(const unsigned*)(c.PROJ() + (size_t)vrow * PC + cv + h * 128 + lane * 2);
                a0 += pj * bflo(vv); a1 += pj * bfhi(vv);
            }
            Rrun += __shfl(sc, 63);
            if (Rrun < -110.f) break;
        }
    }
    *(unsigned*)(qrow + lane * 2) = pack2(a0, a1);
}

typedef short lru_bf16x8 __attribute__((ext_vector_type(8)));
typedef float lru_f32x16 __attribute__((ext_vector_type(16)));
typedef unsigned lru_u32x4 __attribute__((ext_vector_type(4)));
constexpr int USS = 68;
typedef float cvt_f32x2 __attribute__((ext_vector_type(2)));
typedef __bf16 cvt_bf16x2 __attribute__((ext_vector_type(2)));
__device__ __forceinline__ unsigned lru_cvt_pk(float lo, float hi) { const cvt_f32x2 f = {lo, hi}; return __builtin_bit_cast(unsigned, __builtin_convertvector(f, cvt_bf16x2)); }
__device__ __forceinline__ void split8(const float (&x)[8], lru_bf16x8& hi, lru_bf16x8& lo) {
    unsigned h[4], l[4];
#pragma unroll
    for (int e = 0; e < 4; ++e) {
        h[e] = lru_cvt_pk(x[2 * e], x[2 * e + 1]);
        l[e] = lru_cvt_pk(x[2 * e] - __uint_as_float(h[e] << 16), x[2 * e + 1] - __uint_as_float(h[e] & 0xFFFF0000u));
    }
    const lru_u32x4 hv = {h[0], h[1], h[2], h[3]};
    const lru_u32x4 lv = {l[0], l[1], l[2], l[3]};
    hi = __builtin_bit_cast(lru_bf16x8, hv); lo = __builtin_bit_cast(lru_bf16x8, lv);
}
constexpr int TPT = LCH / 8;
struct LruIn { float x[TPT + 3]; float g[TPT]; float carry; };
struct LruIn2 { float ci[TPT]; };
struct LruCh { float w0, w1, w2, w3, cb, bav, bxv, spl; };
template <bool META>
__device__ __forceinline__ void lru_load(const Ctx& c, int seq, int chunk, int n, int pass, int tid, LruIn& in) {
    const int len = META ? NM : LCH;
    const int gbase = seq == 4 ? 0 : NM + chunk * LCH;
    const int b = seq == 4 ? 0 : seq;
    const int ch = tid & 63, sg = tid >> 6;
    const bf16_t* PROJ = c.PROJ();
#pragma unroll
    for (int k = 0; k < TPT + 3; ++k) {
        const int t = sg * TPT + k - 3; const int g = gbase + t;
        const bool ok = META ? (t < len && g >= 0) : true;
        const float v = bf2f(PROJ[(size_t)key_row(b, ok ? g : 0) * PC + C_LX + n * 64 + ch]);
        in.x[k] = ok ? v : 0.f;
    }
    in.carry = 0.f;
    if (pass == 1) {
#pragma unroll
        for (int tt = 0; tt < TPT; ++tt) { const int t = sg * TPT + tt; const float gv = bf2f(PROJ[(size_t)key_row(b, gbase + (t < len ? t : 0)) * PC + C_LG + n * 64 + ch]); in.g[tt] = t < len ? gv : 0.f; }
        if (seq != 4) in.carry = c.CARRY()[(size_t)(seq * NLC + chunk) * 512 + n * 64 + ch];
    }
}
template <bool META>
__device__ __forceinline__ void lru_item(const Ctx& c, int seq, int chunk, int n, int pass, const LruIn& in, const LruCh& kc, const lru_bf16x8 (&wbh)[4], const lru_bf16x8 (&wbl)[4]) {
    float* us = c.smem;
    float* as_ = us + LCH * USS;
    float* is_ = as_ + LCH * 64;
    float* sgP = is_ + LCH * 64;
    float* sgE = sgP + 8 * 64;
    int tid = threadIdx.x; asm volatile("" : "+v"(tid));
    const int len = META ? NM : LCH;
    const int gbase = seq == 4 ? 0 : NM + chunk * LCH;
    const int b = seq == 4 ? 0 : seq;
    const int ch = tid & 63, sg = tid >> 6;
    const int cidx = n * 64 + ch;
    bf16_t* PROJ = c.PROJ();
    lds_barrier();
    __builtin_amdgcn_sched_barrier(0);
#pragma unroll
    for (int tt = 0; tt < TPT; ++tt) {
        const int t = sg * TPT + tt;
        us[t * USS + ch] = (!META || t < len) ? kc.cb + kc.w0 * in.x[tt] + kc.w1 * in.x[tt + 1] + kc.w2 * in.x[tt + 2] + kc.w3 * in.x[tt + 3] : 0.f;
    }
    lds_barrier();
    __builtin_amdgcn_sched_barrier(0);
    {
        const int wv = tid >> 6, lane = tid & 63, tj = wv & 1, ql = lane & 31, kg = lane >> 5;
        float* dst = (wv >> 2) ? is_ : as_;
#pragma unroll
        for (int tb = 0; tb < LCH / 64; ++tb) {
            const int tq = ((wv >> 1) & 1) + 2 * tb;
            lru_f32x16 acc;
#pragma unroll
            for (int r = 0; r < 16; ++r) acc[r] = 0.f;
            const float* urow = us + (32 * tq + ql) * USS + 8 * kg;
#pragma unroll
            for (int ks = 0; ks < 4; ++ks) {
                const float4 u0 = *(const float4*)(urow + 16 * ks), u1 = *(const float4*)(urow + 16 * ks + 4);
                const float x[8] = {u0.x, u0.y, u0.z, u0.w, u1.x, u1.y, u1.z, u1.w};
                lru_bf16x8 ah, al; split8(x, ah, al);
                acc = __builtin_amdgcn_mfma_f32_32x32x16_bf16(ah, wbh[ks], acc, 0, 0, 0);
                acc = __builtin_amdgcn_mfma_f32_32x32x16_bf16(al, wbh[ks], acc, 0, 0, 0);
                acc = __builtin_amdgcn_mfma_f32_32x32x16_bf16(ah, wbl[ks], acc, 0, 0, 0);
            }
#pragma unroll
            for (int r = 0; r < 16; ++r) dst[(32 * tq + (r & 3) + 8 * (r >> 2) + 4 * kg) * 64 + 32 * tj + ql] = acc[r];
        }
    }
    lds_barrier();
    __builtin_amdgcn_sched_barrier(0);
    float P = 1.f, E = 0.f;
    bf16_t* cp0 = PROJ + (size_t)(b * S + chunk * LCH + sg * TPT) * PC + cidx;
#pragma unroll
    for (int tt = 0; tt < TPT; ++tt) {
        const int t = sg * TPT + tt;
        const float r = __builtin_amdgcn_rcpf(1.f + __builtin_amdgcn_exp2f(-1.4426950408889634f * (as_[t * 64 + ch] + kc.bav)));
        const float gi = __builtin_amdgcn_rcpf(1.f + __builtin_amdgcn_exp2f(-1.4426950408889634f * (is_[t * 64 + ch] + kc.bxv)));
        const float la = -8.f * r * kc.spl;
        const float av = __builtin_amdgcn_exp2f(1.4426950408889634f * la);
        const float a = (!META || t < len) ? av : 1.f;
        const float inp = (!META || t < len) ? __builtin_amdgcn_sqrtf(fmaxf(1.f - av * av, 0.f)) * gi * us[t * USS + ch] : 0.f;
        if (META || pass != 0) { as_[t * 64 + ch] = a; is_[t * 64 + ch] = inp; }
        E = a * E + inp; P *= a;
        if (!META && pass == 0) {
            cp0[(size_t)tt * PC + C_FV] = f2bf(1.f - av); cp0[(size_t)tt * PC + C_SV] = f2bf(inp);
        }
    }
    sgP[sg * 64 + ch] = P; sgE[sg * 64 + ch] = E;
    lds_barrier();
    __builtin_amdgcn_sched_barrier(0);
    const size_t sidx = (size_t)(seq == 4 ? 4 * NLC : seq * NLC + chunk) * 512 + cidx;
    if (pass == 0) {
        if (sg == 0) {
            float Pt = 1.f, Et = 0.f;
#pragma unroll
            for (int q = 0; q < 8; ++q) { const float pq = sgP[q * 64 + ch]; Et = pq * Et + sgE[q * 64 + ch]; Pt *= pq; }
            c.SUMP()[sidx] = Pt; c.SUME()[sidx] = Et;
        }
    } else {
        float hst = in.carry;
#pragma unroll
        for (int q = 0; q < 7; ++q) if (q < sg) hst = sgP[q * 64 + ch] * hst + sgE[q * 64 + ch];
#pragma unroll
        for (int tt = 0; tt < TPT; ++tt) {
            const int t = sg * TPT + tt;
            hst = as_[t * 64 + ch] * hst + is_[t * 64 + ch];
            if (t < len) {
                const float x = in.g[tt];
                const float uarg = 0.7978845608028654f * (x + 0.044715f * x * x * x);
                PROJ[(size_t)key_row(b, gbase + t) * PC + C_LG + cidx] = f2bf(hst * x * __builtin_amdgcn_rcpf(1.f + __builtin_amdgcn_exp2f(-2.885390081777927f * uarg)));
            }
        }
    }
}

__device__ __forceinline__ void lru_loadB(const Ctx& c, int b, int chunk, int n, int tid, LruIn& in, LruIn2& in2) {
    const int ch = tid & 63, sg = tid >> 6;
    const bf16_t* P0 = c.PROJ() + (size_t)(b * S + chunk * LCH + sg * TPT) * PC + n * 64 + ch;
#pragma unroll
    for (int tt = 0; tt < TPT; ++tt) {
        in.x[tt] = bf2f(P0[(size_t)tt * PC + C_FV]);
        in2.ci[tt] = bf2f(P0[(size_t)tt * PC + C_SV]);
        in.g[tt] = bf2f(P0[(size_t)tt * PC + C_LG]);
    }
    in.carry = c.CARRY()[(size_t)(b * NLC + chunk) * 512 + n * 64 + ch];
}
__device__ __forceinline__ void lru_itemB(const Ctx& c, int b, int chunk, int n, const LruIn& in, const LruIn2& in2) {
    float* sgP = c.smem; float* sgE = sgP + 8 * 64;
    int tid = threadIdx.x; asm volatile("" : "+v"(tid));
    const int ch = tid & 63, sg = tid >> 6;
    float P = 1.f, E = 0.f;
#pragma unroll
    for (int tt = 0; tt < TPT; ++tt) { const float a = 1.f - in.x[tt]; E = a * E + in2.ci[tt]; P *= a; }
    lds_barrier();
    sgP[sg * 64 + ch] = P; sgE[sg * 64 + ch] = E;
    lds_barrier();
    float hst = in.carry;
#pragma unroll
    for (int q = 0; q < 7; ++q) if (q < sg) hst = sgP[q * 64 + ch] * hst + sgE[q * 64 + ch];
    bf16_t* O0 = c.PROJ() + (size_t)(b * S + chunk * LCH + sg * TPT) * PC + C_LG + n * 64 + ch;
#pragma unroll
    for (int tt = 0; tt < TPT; ++tt) {
        hst = (1.f - in.x[tt]) * hst + in2.ci[tt];
        const float x = in.g[tt];
        const float uarg = 0.7978845608028654f * (x + 0.044715f * x * x * x);
        O0[(size_t)tt * PC] = f2bf(hst * x * __builtin_amdgcn_rcpf(1.f + __builtin_amdgcn_exp2f(-2.885390081777927f * uarg)));
    }
}

__device__ __forceinline__ void phase_lru(const Ctx& c, int layer, int pass) {
    const int n = blockIdx.x & 7, G8 = gridDim.x >> 3;
    lru_bf16x8 wbh[4], wbl[4];
    LruCh kc;
    {
        const int wv = c.tid >> 6, lane = c.tid & 63, j = 32 * (wv & 1) + (lane & 31), kg = lane >> 5;
        const float* w = ((wv >> 2) ? c.wx() : c.wa()) + ((size_t)layer * 8 + n) * 4096 + j;
#pragma unroll
        for (int ks = 0; ks < 4; ++ks) {
            float x[8];
#pragma unroll
            for (int e = 0; e < 8; ++e) x[e] = w[(16 * ks + 8 * kg + e) * 64];
            split8(x, wbh[ks], wbl[ks]);
        }
        const int cidx = n * 64 + (c.tid & 63);
        const float* cw = c.conv_w() + (size_t)layer * 4 * 512 + cidx;
        kc.w0 = cw[0]; kc.w1 = cw[512]; kc.w2 = cw[1024]; kc.w3 = cw[1536]; kc.cb = c.conv_b()[layer * 512 + cidx];
        kc.bav = c.ba()[layer * 512 + cidx]; kc.bxv = c.bx()[layer * 512 + cidx]; kc.spl = softplusf_(-c.lam()[layer * 512 + cidx]);
    }
    if ((blockIdx.x >> 3) == 0) { LruIn mi; lru_load<true>(c, 4, 0, n, pass, c.tid, mi); lru_item<true>(c, 4, 0, n, pass, mi, kc, wbh, wbl); }
    int j = blockIdx.x >> 3;
    if (pass == 1) {
        LruIn cur, nx1; LruIn2 cur2, nx12;
        if (j < NB * NLC) lru_loadB(c, j / NLC, j % NLC, n, c.tid, cur, cur2);
        { const int j1 = j + G8 < NB * NLC ? j + G8 : j; if (j < NB * NLC) lru_loadB(c, j1 / NLC, j1 % NLC, n, c.tid, nx1, nx12); }
        for (; j < NB * NLC; j += G8) {
            LruIn nx2; LruIn2 nx22;
            const int jn = j + 2 * G8 < NB * NLC ? j + 2 * G8 : j;
            lru_loadB(c, jn / NLC, jn % NLC, n, c.tid, nx2, nx22);
            lru_itemB(c, j / NLC, j % NLC, n, cur, cur2);
            cur = nx1; cur2 = nx12; nx1 = nx2; nx12 = nx22;
        }
    } else {
        LruIn cur;
        if (j < NB * NLC) lru_load<false>(c, j / NLC, j % NLC, n, pass, c.tid, cur);
        for (; j < NB * NLC; j += G8) {
            LruIn nxt;
            const int jn = j + G8 < NB * NLC ? j + G8 : j;
            lru_load<false>(c, jn / NLC, jn % NLC, n, pass, c.tid, nxt);
            lru_item<false>(c, j / NLC, j % NLC, n, pass, cur, kc, wbh, wbl);
            cur = nxt;
        }
    }
    __syncthreads();
}
__device__ __forceinline__ void phase_lru_carry(const Ctx& c) {
    if (blockIdx.x >= 32 || threadIdx.x >= 64) return;
    const int b = blockIdx.x >> 3, ch = (blockIdx.x & 7) * 64 + threadIdx.x;
    const float* Pp = c.SUMP() + (size_t)b * NLC * 512 + ch; const float* Ep = c.SUME() + (size_t)b * NLC * 512 + ch;
    float* Cp = c.CARRY() + (size_t)b * NLC * 512 + ch;
    float hst = c.SUME()[(size_t)(4 * NLC) * 512 + ch];
    for (int c0 = 0; c0 < NLC; c0 += 8) {
        float pv[8], ev[8];
#pragma unroll
        for (int q = 0; q < 8; ++q) { pv[q] = Pp[(size_t)(c0 + q) * 512]; ev[q] = Ep[(size_t)(c0 + q) * 512]; }
#pragma unroll
        for (int q = 0; q < 8; ++q) { Cp[(size_t)(c0 + q) * 512] = hst; hst = pv[q] * hst + ev[q]; }
    }
}

__device__ __forceinline__ void phase_attn(const Ctx& c, int layer) {
    phase_lru(c, layer, 0);
    const int nitems = layer == 1 ? 0 : NM * 8;
    for (int it = blockIdx.x * 8 + c.wave; it < nitems; it += gridDim.x * 8) {
        const int rr = R + it % NM, hh = it / NM;
        attn_query(c, hh >> 2, rr, hh & 3);
    }
}

namespace g8 {
constexpr int BM = 256, BK = 64, HALF = 128, HTB = HALF * BK * 2, STAGE_BYTES = 8 * HTB, NXCD = 8, WGM = 8;
typedef short bf16x8 __attribute__((ext_vector_type(8)));
typedef float f32x4 __attribute__((ext_vector_type(4)));
typedef unsigned u32x4 __attribute__((ext_vector_type(4)));
__device__ __forceinline__ int lds_byte(int r, int c) { const int st = (r >> 4) * 2 + (c >> 5), rr = r & 15, cc = c & 31, ob = rr * 64 + cc * 2; return st * 1024 + (ob ^ (((ob >> 9) & 1) << 5)); }
__device__ __forceinline__ void stage_rc(int b, int& R_, int& C_) { const int st = b / 1024, sb = b % 1024, swz = sb ^ (((sb >> 9) & 1) << 5); R_ = (st >> 1) * 16 + swz / 64; C_ = (st & 1) * 32 + (swz % 64) / 2; }
__device__ __forceinline__ int perm32(int rho) { const int n = rho >> 4, i = rho & 15; return 8 * (i >> 2) + 4 * n + (i & 3); }
__device__ __forceinline__ unsigned cvt_pk_bf16(float lo, float hi) { const cvt_f32x2 f = {lo, hi}; return __builtin_bit_cast(unsigned, __builtin_convertvector(f, cvt_bf16x2)); }

struct Unit {
    unsigned A;
    unsigned B;
    const int* gidx;
    int gcnt;
    int lda;
    int K;
    int tag;
    int pm, pn;
};

__device__ __forceinline__ void tile_of(int L, int nM, int nN, int& pm, int& pn) {
    const int nwg = nM * nN; int wgid = L;
    { const int q = nwg / NXCD, r = nwg % NXCD, xcd = wgid % NXCD, off = wgid / NXCD; wgid = (xcd < r ? xcd * (q + 1) : r * (q + 1) + (xcd - r) * q) + off; }
    const int nig = WGM * nN, gid = wgid / nig, fm = gid * WGM, gsz = (nM - fm) < WGM ? (nM - fm) : WGM;
    pm = fm + ((wgid % nig) % gsz); pn = (wgid % nig) / gsz;
}

template <bool PERM, bool GATHER>
__device__ __forceinline__ void mk_off(const Unit& u, int tid, unsigned (&vA)[2][2], unsigned (&vB)[2]) {
    int sR[2], sC[2];
#pragma unroll
    for (int i = 0; i < 2; ++i) stage_rc(tid * 16 + i * 8192, sR[i], sC[i]);
#pragma unroll
    for (int i = 0; i < 2; ++i) {
        if (GATHER) {
#pragma unroll
            for (int h = 0; h < 2; ++h) { const int r = h * HALF + sR[i]; const int idx = u.gidx[r < u.gcnt ? r : 0]; vA[h][i] = (unsigned)idx * (unsigned)u.lda + (unsigned)sC[i] * 2u; }
        } else {
            vA[0][i] = (unsigned)sR[i] * (unsigned)u.lda + (unsigned)sC[i] * 2u; vA[1][i] = 0u;
        }
        const int Rb = PERM ? ((sR[i] & ~31) + perm32(sR[i] & 31)) : sR[i];
        vB[i] = ((unsigned)Rb * (unsigned)u.K + (unsigned)sC[i]) * 2u;
    }
}

#define G8_SA(b, h) (((b) * 2 + (h)) * HTB)
#define G8_SB(b, h) ((4 + (b) * 2 + (h)) * HTB)
#define G8_GLL(gp, lp) __builtin_amdgcn_global_load_lds((const unsigned*)(gp), (LAS unsigned*)(lp), 16, 0, 0)
#define G8_STAGE(bufoff, gbase, v0, v1) do { G8_GLL(wsb + (unsigned)((gbase) + (v0)), lds + (bufoff) + ldsw); G8_GLL(wsb + (unsigned)((gbase) + (v1)), lds + (bufoff) + ldsw + 8192); } while (0)
#define G8_LDA(dst, b, h) do { _Pragma("unroll") for (int m = 0; m < 4; ++m) _Pragma("unroll") for (int k = 0; k < 2; ++k) dst[m][k] = *(const LAS bf16x8*)(lds + G8_SA(b, h) + aoff + m * 2048 + k * 1024); } while (0)
#define G8_LDB(dst, b, h) do { _Pragma("unroll") for (int n = 0; n < 2; ++n) _Pragma("unroll") for (int k = 0; k < 2; ++k) dst[n][k] = *(const LAS bf16x8*)(lds + G8_SB(b, h) + boff + n * 2048 + k * 1024); } while (0)
#define G8_MMA(ai, bj, At, Bt) do { __builtin_amdgcn_s_setprio(1); _Pragma("unroll") for (int m = 0; m < 4; ++m) _Pragma("unroll") for (int n = 0; n < 2; ++n) _Pragma("unroll") for (int k = 0; k < 2; ++k) \
        acc[ai][bj][m][n] = __builtin_amdgcn_mfma_f32_16x16x32_bf16(Bt[n][k], At[m][k], acc[ai][bj][m][n], 0, 0, 0); __builtin_amdgcn_s_setprio(0); } while (0)
#define G8_WAIT_V(n) asm volatile("s_waitcnt vmcnt(" #n ")" ::: "memory")
#define G8_WAIT_L(n) asm volatile("s_waitcnt lgkmcnt(" #n ")" ::: "memory")
#define G8_BAR __builtin_amdgcn_s_barrier()
#define G8_SCHED __builtin_amdgcn_sched_barrier(0)

template <bool PERM, bool GATHER, class Sched, class Epi>
__device__ __forceinline__ void gemm_stream(LAS unsigned char* lds, const char* wsb, const Sched& S, const Epi& E) {
    int tid = threadIdx.x; asm volatile("" : "+v"(tid));
    const int wid = __builtin_amdgcn_readfirstlane(tid >> 6), lane = tid & 63, wr = wid >> 2, wc = wid & 3, fr = lane & 15, fq = lane >> 4;
    const unsigned ldsw = (unsigned)wid * 1024u;
    const int aoff = lds_byte(wr * 64 + fr, fq * 8), boff = lds_byte(wc * 32 + fr, fq * 8);
    Unit cur, nxt; int ui = 0;
    if (!S.next(0, cur)) return;
    f32x4 acc[2][2][4][2];
#pragma unroll
    for (int a = 0; a < 2; ++a)
#pragma unroll
        for (int b = 0; b < 2; ++b)
#pragma unroll
            for (int m = 0; m < 4; ++m)
#pragma unroll
                for (int n = 0; n < 2; ++n) acc[a][b][m][n] = (f32x4){0.f, 0.f, 0.f, 0.f};
    bf16x8 At[4][2], B0[2][2], B1[2][2];
    unsigned cvA[2][2], cvB[2], nvA[2][2], nvB[2];
    mk_off<PERM, GATHER>(cur, tid, cvA, cvB);
    constexpr int H1 = GATHER ? 1 : 0;
    unsigned cA = cur.A, cB = cur.B; unsigned chB = (unsigned)HALF * cur.K * 2; unsigned chA = GATHER ? 0u : (unsigned)HALF * cur.lda;
    const unsigned kstep = (unsigned)(BK * 2);
    G8_STAGE(G8_SB(0, 0), cB, cvB[0], cvB[1]); G8_STAGE(G8_SA(0, 0), cA, cvA[0][0], cvA[0][1]); G8_STAGE(G8_SB(0, 1), cB + chB, cvB[0], cvB[1]); G8_STAGE(G8_SA(0, 1), cA + chA, cvA[H1][0], cvA[H1][1]);
    if (wr == 1) G8_BAR;
    G8_WAIT_V(4); G8_BAR;
    G8_STAGE(G8_SB(1, 0), cB + kstep, cvB[0], cvB[1]); G8_STAGE(G8_SA(1, 0), cA + kstep, cvA[0][0], cvA[0][1]); G8_STAGE(G8_SB(1, 1), cB + chB + kstep, cvB[0], cvB[1]);
    G8_WAIT_V(6); G8_BAR;
    for (;;) {
        const bool has_next = S.next(ui + 1, nxt);
        if (!has_next) nxt = cur;
        mk_off<PERM, GATHER>(nxt, tid, nvA, nvB);
        const unsigned nA = nxt.A, nB = nxt.B; const unsigned nhB = (unsigned)HALF * nxt.K * 2; const unsigned nhA = GATHER ? 0u : (unsigned)HALF * nxt.lda;
        const int nt = cur.K / BK;
        for (int t = 0; t < nt; t += 2) {
            const bool last = (t == nt - 2);
            const unsigned a1 = cA + (unsigned)(t + 1) * kstep;
            const unsigned a2 = last ? nA : cA + (unsigned)(t + 2) * kstep, b2 = last ? nB : cB + (unsigned)(t + 2) * kstep;
            const unsigned a3 = a2 + kstep, b3 = b2 + kstep;
            const unsigned hB2 = last ? nhB : chB, hA2 = last ? nhA : chA;
            G8_LDB(B0, 0, 0); G8_SCHED; G8_LDA(At, 0, 0); G8_STAGE(G8_SA(1, 1), a1 + chA, cvA[H1][0], cvA[H1][1]);
            if (last) {
#pragma unroll
                for (int i = 0; i < 2; ++i) { cvA[0][i] = nvA[0][i]; cvA[1][i] = nvA[1][i]; cvB[i] = nvB[i]; }
            }
            G8_WAIT_L(8); G8_BAR; G8_WAIT_L(0); G8_MMA(0, 0, At, B0); G8_BAR; G8_SCHED;
            G8_LDB(B1, 0, 1); G8_STAGE(G8_SB(0, 0), b2, cvB[0], cvB[1]);
            G8_BAR; G8_WAIT_L(0); G8_MMA(0, 1, At, B1); G8_BAR;
            G8_LDA(At, 0, 1); G8_STAGE(G8_SA(0, 0), a2, cvA[0][0], cvA[0][1]);
            G8_BAR; G8_WAIT_L(0); G8_MMA(1, 0, At, B0); G8_BAR; G8_SCHED;
            G8_STAGE(G8_SB(0, 1), b2 + hB2, cvB[0], cvB[1]);
            G8_WAIT_V(6); G8_BAR; G8_MMA(1, 1, At, B1); G8_BAR;
            G8_LDB(B0, 1, 0); G8_SCHED; G8_LDA(At, 1, 0); G8_STAGE(G8_SA(0, 1), a2 + hA2, cvA[H1][0], cvA[H1][1]);
            G8_WAIT_L(8); G8_BAR; G8_WAIT_L(0); G8_MMA(0, 0, At, B0); G8_BAR; G8_SCHED;
            G8_LDB(B1, 1, 1); G8_STAGE(G8_SB(1, 0), b3, cvB[0], cvB[1]);
            G8_BAR; G8_WAIT_L(0); G8_MMA(0, 1, At, B1); G8_BAR;
            G8_LDA(At, 1, 1); G8_STAGE(G8_SA(1, 0), a3, cvA[0][0], cvA[0][1]);
            G8_BAR; G8_WAIT_L(0); G8_MMA(1, 0, At, B0); G8_BAR; G8_SCHED;
            G8_STAGE(G8_SB(1, 1), b3 + hB2, cvB[0], cvB[1]);
            G8_WAIT_V(6); G8_BAR; G8_MMA(1, 1, At, B1); G8_BAR;
        }
        E(acc, cur, wr, wc, fr, fq);
        if (!has_next) break;
#pragma unroll
        for (int a = 0; a < 2; ++a)
#pragma unroll
            for (int b = 0; b < 2; ++b)
#pragma unroll
                for (int m = 0; m < 4; ++m)
#pragma unroll
                    for (int n = 0; n < 2; ++n) acc[a][b][m][n] = (f32x4){0.f, 0.f, 0.f, 0.f};
        cur = nxt; cA = nA; cB = nB; chB = nhB; chA = nhA; ++ui;
    }
    G8_WAIT_V(0);
    if (wr == 0) G8_BAR;
    G8_BAR;
}
}

using g8::f32x4; using g8::u32x4; using g8::Unit;
namespace at { constexpr float QSCALE_ = 0.08838834764831845f * 1.4426950408889634f; }
#define ACC_T const f32x4 (&acc)[2][2][4][2]

struct SchedStd {
    unsigned A, B; int lda, K, nM, nN, G, c;
    __device__ __forceinline__ bool next(int i, Unit& u) const {
        const int L = i * G + c; if (L >= nM * nN) return false;
        int pm, pn; g8::tile_of(L, nM, nN, pm, pn);
        u.A = A + (unsigned)pm * 256u * (unsigned)lda; u.B = B + (unsigned)pn * 256u * (unsigned)K * 2u; u.gidx = nullptr; u.gcnt = 0; u.lda = lda; u.K = K; u.tag = 0; u.pm = pm; u.pn = pn;
        return true;
    }
};
struct EpiBf16 {
    bf16_t* O; int ldc;
    __device__ __forceinline__ void operator()(ACC_T, const Unit& u, int wr, int wc, int fr, int fq) const {
        const int row0 = u.pm * 256 + wr * 64 + fr, col0 = u.pn * 256 + wc * 32 + 8 * fq;
#pragma unroll
        for (int ai = 0; ai < 2; ++ai)
#pragma unroll
            for (int m = 0; m < 4; ++m) {
                bf16_t* rowp = O + (size_t)(row0 + ai * 128 + m * 16) * ldc + col0;
#pragma unroll
                for (int bj = 0; bj < 2; ++bj) {
                    const f32x4 v0 = acc[ai][bj][m][0], v1 = acc[ai][bj][m][1];
                    u32x4 w; w.x = g8::cvt_pk_bf16(v0[0], v0[1]); w.y = g8::cvt_pk_bf16(v0[2], v0[3]); w.z = g8::cvt_pk_bf16(v1[0], v1[1]); w.w = g8::cvt_pk_bf16(v1[2], v1[3]);
                    *(u32x4*)(rowp + bj * 128) = w;
                }
            }
    }
};
struct EpiResid {
    const float* src; float* dst;
    __device__ __forceinline__ void operator()(ACC_T, const Unit& u, int wr, int wc, int fr, int fq) const {
        const int row0 = u.pm * 256 + wr * 64 + fr, col0 = u.pn * 256 + wc * 32 + 4 * fq;
        f32x4 sv[2][4];
#pragma unroll
        for (int q = 0; q < 4; ++q) sv[0][q] = *(const f32x4*)(src + (size_t)row0 * D + col0 + (q >> 1) * 128 + (q & 1) * 16);
#pragma unroll
        for (int k = 0; k < 8; ++k) {
            const int ai = k >> 2, m = k & 3;
            if (k < 7) {
                const size_t rn = (size_t)(row0 + ((k + 1) >> 2) * 128 + ((k + 1) & 3) * 16) * D + col0;
#pragma unroll
                for (int q = 0; q < 4; ++q) sv[(k + 1) & 1][q] = *(const f32x4*)(src + rn + (q >> 1) * 128 + (q & 1) * 16);
            }
            const size_t ro = (size_t)(row0 + ai * 128 + m * 16) * D + col0;
#pragma unroll
            for (int q = 0; q < 4; ++q) *(f32x4*)(dst + ro + (q >> 1) * 128 + (q & 1) * 16) = sv[k & 1][q] + acc[ai][q >> 1][m][q & 1];
        }
    }
};
struct EpiSwiglu {
    bf16_t* Hd; int ldh;
    __device__ __forceinline__ void operator()(ACC_T, const Unit& u, int wr, int wc, int fr, int fq) const {
        const int row0 = u.pm * 256 + wr * 64 + fr, col0 = u.pn * 128 + wc * 16 + 4 * fq;
#pragma unroll
        for (int ai = 0; ai < 2; ++ai)
#pragma unroll
            for (int m = 0; m < 4; ++m) {
                bf16_t* rowp = Hd + (size_t)(row0 + ai * 128 + m * 16) * ldh + col0;
#pragma unroll
                for (int bj = 0; bj < 2; ++bj) {
                    const f32x4 g = acc[ai][bj][m][0], uu = acc[ai][bj][m][1];
                    float hv[4];
#pragma unroll
                    for (int j = 0; j < 4; ++j) hv[j] = g[j] * uu[j] * __builtin_amdgcn_rcpf(1.f + __builtin_amdgcn_exp2f(-1.4426950408889634f * g[j]));
                    uint2 w; w.x = g8::cvt_pk_bf16(hv[0], hv[1]); w.y = g8::cvt_pk_bf16(hv[2], hv[3]);
                    *(uint2*)(rowp + bj * 64) = w;
                }
            }
    }
};

struct EpiProj {
    bf16_t* O; bf16_t* VT; unsigned* KP;
    __device__ __forceinline__ void operator()(ACC_T, const Unit& u, int wr, int wc, int fr, int fq) const {
        const int pn = u.pn;
        const bool isV = (pn == 4 || pn == 5 || pn == 10 || pn == 11);
        const int row0 = u.pm * 256 + wr * 64 + fr;
        if (!isV) {
            const float sc = (pn < 2 || pn == 6 || pn == 7) ? at::QSCALE_ : 1.f;
            const int col0 = pn * 256 + wc * 32 + 8 * fq;
            const bool isFK = (pn == 2 || pn == 3);
            float kmx[2] = {0.f, 0.f};
#pragma unroll
            for (int ai = 0; ai < 2; ++ai)
#pragma unroll
                for (int m = 0; m < 4; ++m) {
                    bf16_t* rowp = O + (size_t)(row0 + ai * 128 + m * 16) * PC + col0;
#pragma unroll
                    for (int bj = 0; bj < 2; ++bj) {
                        const f32x4 v0 = acc[ai][bj][m][0] * sc, v1 = acc[ai][bj][m][1] * sc;
                        u32x4 w; w.x = g8::cvt_pk_bf16(v0[0], v0[1]); w.y = g8::cvt_pk_bf16(v0[2], v0[3]); w.z = g8::cvt_pk_bf16(v1[0], v1[1]); w.w = g8::cvt_pk_bf16(v1[2], v1[3]);
                        *(u32x4*)(rowp + bj * 128) = w;
                        if (isFK) {
                            float ss = bflo(w.x) * bflo(w.x) + bfhi(w.x) * bfhi(w.x) + bflo(w.y) * bflo(w.y) + bfhi(w.y) * bfhi(w.y)
                                     + bflo(w.z) * bflo(w.z) + bfhi(w.z) * bfhi(w.z) + bflo(w.w) * bflo(w.w) + bfhi(w.w) * bfhi(w.w);
                            ss += __shfl_xor(ss, 16); ss += __shfl_xor(ss, 32);
                            kmx[bj] = fmaxf(kmx[bj], ss);
                        }
                    }
                }
            if (isFK) {
#pragma unroll
                for (int bj = 0; bj < 2; ++bj) {
                    float v = kmx[bj];
                    v = fmaxf(v, __shfl_xor(v, 1)); v = fmaxf(v, __shfl_xor(v, 2)); v = fmaxf(v, __shfl_xor(v, 4)); v = fmaxf(v, __shfl_xor(v, 8));
                    if (fr == 0 && fq == 0) atomicMax(KP + (((u.pm * 256) >> 13) * 4 + 2 * (pn & 1) + bj) * 4 + wc, __float_as_uint(v));
                }
            }
        } else {
            const int type = pn >= 10 ? 1 : 0, hp = (pn & 1) * 2, d0 = wc * 32 + 8 * fq;
#pragma unroll
            for (int ai = 0; ai < 2; ++ai)
#pragma unroll
                for (int m = 0; m < 4; ++m) {
                    const int row = row0 + ai * 128 + m * 16; const int b = row >> 13, sq = row & (S - 1);
#pragma unroll
                    for (int bj = 0; bj < 2; ++bj) {
                        bf16_t* base = VT + ((size_t)((type * 16 + b * 4 + hp + bj) * 128 + d0)) * S + sq;
#pragma unroll
                        for (int n = 0; n < 2; ++n)
#pragma unroll
                            for (int j = 0; j < 4; ++j) base[(size_t)(4 * n + j) * S] = f2bf(acc[ai][bj][m][n][j]);
                    }
                }
        }
    }
};

__device__ __forceinline__ void phase_proj_main(const Ctx& c, int layer, LAS unsigned char* lds) {
    SchedStd S{(unsigned)WS_XN, (unsigned)(WS_WB + layer * WB_LAYER + WB_IN), D * 2, D, R / 256, PC / 256, (int)gridDim.x, (int)blockIdx.x};
    EpiProj E{c.PROJ(), (bf16_t*)(c.a->ws + WS_VT), (unsigned*)(c.a->ws + WS_KPART)};
    g8::gemm_stream<true, false>(lds, (const char*)c.a->ws, S, E);
}
__device__ __forceinline__ void phase_resid_main(const Ctx& c, const float* src, unsigned A, int lda_bytes, unsigned Bt, int K, LAS unsigned char* lds) {
    SchedStd S{A, Bt, lda_bytes, K, R / 256, D / 256, (int)gridDim.x, (int)blockIdx.x};
    EpiResid E{src, c.out()};
    g8::gemm_stream<false, false>(lds, (const char*)c.a->ws, S, E);
}
__device__ __forceinline__ void phase_ffn_up_main(const Ctx& c, LAS unsigned char* lds) {
    SchedStd S{(unsigned)WS_XN, (unsigned)WS_WGU, D * 2, D, R / 256, 2 * DFF / 256, (int)gridDim.x, (int)blockIdx.x};
    EpiSwiglu E{c.PROJ(), DFF};
    g8::gemm_stream<true, false>(lds, (const char*)c.a->ws, S, E);
}

struct SchedMerge {
    unsigned WB; int G, c;
    __device__ __forceinline__ bool next(int i, Unit& u) const {
        const int ti = i / 6, sub = i - ti * 6, j = sub >> 1;
        const int L = ti * G + c; if (L >= (R / 256) * (D / 256)) return false;
        int pm, pn; g8::tile_of(L, R / 256, D / 256, pm, pn);
        if ((sub & 1) == 0) { u.A = (unsigned)WS_XN + (unsigned)pm * 256u * (D * 2); u.lda = D * 2; u.K = D; u.B = WB + (unsigned)WB_G + ((unsigned)j * D + (unsigned)pn * 256u) * D * 2; }
        else {
            const int acol = j == 0 ? C_FQ : j == 1 ? C_SQ : C_LG;
            u.A = (unsigned)WS_PROJ + (unsigned)pm * 256u * (PC * 2) + acol * 2; u.lda = PC * 2; u.K = 512;
            u.B = WB + (unsigned)(j == 0 ? WB_FO : j == 1 ? WB_SO : WB_LO) + (unsigned)pn * 256u * 512 * 2;
        }
        u.gidx = nullptr; u.gcnt = 0; u.tag = sub; u.pm = pm; u.pn = pn;
        return true;
    }
};
struct EpiMerge {
    bf16_t* G; bf16_t* MRG; const float* bgate;
    __device__ __forceinline__ void operator()(ACC_T, const Unit& u, int wr, int wc, int fr, int fq) const {
        const int lr0 = wr * 64 + fr, lc0 = wc * 32 + 8 * fq;
        const int j = u.tag >> 1;
        if ((u.tag & 1) == 0) {
            f32x4 bb[2][2];
#pragma unroll
            for (int bj = 0; bj < 2; ++bj) { const float* bp = bgate + j * D + u.pn * 256 + lc0 + bj * 128; bb[bj][0] = *(const f32x4*)bp; bb[bj][1] = *(const f32x4*)(bp + 4); }
#pragma unroll
            for (int ai = 0; ai < 2; ++ai)
#pragma unroll
                for (int m = 0; m < 4; ++m)
#pragma unroll
                    for (int bj = 0; bj < 2; ++bj) {
                        const int lr = lr0 + ai * 128 + m * 16, lc = lc0 + bj * 128;
                        const f32x4 v0 = acc[ai][bj][m][0], v1 = acc[ai][bj][m][1];
                        const f32x4 b0 = bb[bj][0], b1 = bb[bj][1];
                        float s[8];
#pragma unroll
                        for (int q = 0; q < 4; ++q) { s[q] = __builtin_amdgcn_rcpf(1.f + __builtin_amdgcn_exp2f(-1.4426950408889634f * (v0[q] + b0[q]))); s[4 + q] = __builtin_amdgcn_rcpf(1.f + __builtin_amdgcn_exp2f(-1.4426950408889634f * (v1[q] + b1[q]))); }
                        u32x4 w; w.x = g8::cvt_pk_bf16(s[0], s[1]); w.y = g8::cvt_pk_bf16(s[2], s[3]); w.z = g8::cvt_pk_bf16(s[4], s[5]); w.w = g8::cvt_pk_bf16(s[6], s[7]);
                        *(u32x4*)(G + lr * 256 + lc) = w;
                    }
        } else {
            const char* Gc = (const char*)G; char* Mc = (char*)(MRG + (size_t)u.pm * 256 * PC + u.pn * 256);
            u32x4 gw[2][2], pw[2][2];
            {
                int lz = lr0 * 128 + lc0; asm volatile("" : "+v"(lz));
                const unsigned lr = (unsigned)(lz >> 7), lc = (unsigned)(lz & 127);
                const unsigned go = (lr * 256 + lc) * 2u, mo = (lr * PC + lc) * 2u;
#pragma unroll
                for (int bj = 0; bj < 2; ++bj) {
                    gw[0][bj] = *(const u32x4*)(Gc + (go + bj * 256));
                    pw[0][bj] = (u32x4){0u, 0u, 0u, 0u};
                    if (u.tag > 1) pw[0][bj] = *(const u32x4*)(Mc + (mo + bj * 256));
                }
            }
#pragma unroll
            for (int k = 0; k < 8; ++k) {
                const int ai = k >> 2, m = k & 3;
                int lz = lr0 * 128 + lc0; asm volatile("" : "+v"(lz));
                if (k < 7) {
                    const unsigned lrn = (unsigned)(lz >> 7) + ((k + 1) >> 2) * 128 + ((k + 1) & 3) * 16, lcn = (unsigned)(lz & 127);
                    const unsigned gon = (lrn * 256 + lcn) * 2u, mon = (lrn * PC + lcn) * 2u;
#pragma unroll
                    for (int bj = 0; bj < 2; ++bj) {
                        gw[(k + 1) & 1][bj] = *(const u32x4*)(Gc + (gon + bj * 256));
                        pw[(k + 1) & 1][bj] = (u32x4){0u, 0u, 0u, 0u};
                        if (u.tag > 1) pw[(k + 1) & 1][bj] = *(const u32x4*)(Mc + (mon + bj * 256));
                    }
                }
                const unsigned lr = (unsigned)(lz >> 7) + ai * 128 + m * 16, lc = (unsigned)(lz & 127);
                const unsigned mo = (lr * PC + lc) * 2u;
#pragma unroll
                for (int bj = 0; bj < 2; ++bj) {
                    const u32x4 g4 = gw[k & 1][bj], p4 = pw[k & 1][bj];
                    const f32x4 v0 = acc[ai][bj][m][0], v1 = acc[ai][bj][m][1];
                    float o[8];
                    o[0] = bflo(g4.x) * v0[0] + bflo(p4.x); o[1] = bfhi(g4.x) * v0[1] + bfhi(p4.x);
                    o[2] = bflo(g4.y) * v0[2] + bflo(p4.y); o[3] = bfhi(g4.y) * v0[3] + bfhi(p4.y);
                    o[4] = bflo(g4.z) * v1[0] + bflo(p4.z); o[5] = bfhi(g4.z) * v1[1] + bfhi(p4.z);
                    o[6] = bflo(g4.w) * v1[2] + bflo(p4.w); o[7] = bfhi(g4.w) * v1[3] + bfhi(p4.w);
                    u32x4 w; w.x = g8::cvt_pk_bf16(o[0], o[1]); w.y = g8::cvt_pk_bf16(o[2], o[3]); w.z = g8::cvt_pk_bf16(o[4], o[5]); w.w = g8::cvt_pk_bf16(o[6], o[7]);
                    *(u32x4*)(Mc + (mo + bj * 256)) = w;
                }
            }
        }
    }
};
__device__ __forceinline__ void phase_merge_main(const Ctx& c, int layer, LAS unsigned char* lds) {
    SchedMerge S{(unsigned)(WS_WB + layer * WB_LAYER), (int)gridDim.x, (int)blockIdx.x};
    EpiMerge E{(bf16_t*)(c.a->ws + WS_GSCR + (size_t)blockIdx.x * 131072), c.PROJ() + C_MRG, c.b_gate() + layer * 3 * D};
    g8::gemm_stream<true, false>(lds, (const char*)c.a->ws, S, E);
}

struct MoeMap { int ebase[9]; int cnt[8]; };
__device__ __forceinline__ void moe_map(const Ctx& c, MoeMap& m) {
    int acc = 0;
#pragma unroll
    for (int e = 0; e < 8; ++e) { m.cnt[e] = c.CNT()[e]; m.ebase[e] = acc; acc += (m.cnt[e] + 255) & ~255; }
    m.ebase[8] = acc;
}
constexpr int LDS_MOETAB = 131072 + 64;
struct SchedMoe {
    const LAS int* tab; unsigned Asrc, W; const int* LIST; int chunk, nrt, nct, G, c, up;
    __device__ __forceinline__ bool next(int i, Unit& u) const {
        const int L = i * G + c; if (L >= nrt * nct) return false;
        const int rt = L % nrt, ct = L / nrt;
        const int e = tab[rt * 4 + 0], pos0 = tab[rt * 4 + 1], gc = tab[rt * 4 + 2];
        if (up) {
            u.A = Asrc; u.lda = D * 2; u.K = D; u.gidx = LIST + (size_t)e * R + pos0; u.gcnt = gc;
            u.B = W + (unsigned)e * (2 * DFE) * D * 2 + (unsigned)ct * 256u * D * 2; u.pm = rt; u.pn = ct;
        } else {
            u.A = Asrc + (unsigned)rt * 256u * (DFE * 2); u.lda = DFE * 2; u.K = DFE; u.gidx = nullptr; u.gcnt = 0;
            u.B = W + (unsigned)e * D * DFE * 2 + (unsigned)ct * 256u * DFE * 2; u.pm = chunk * (MOE_CH / 256) + rt; u.pn = ct;
        }
        u.tag = 0;
        return true;
    }
};
__device__ __forceinline__ int moe_table(const Ctx& c, int chunk, LAS unsigned char* lds) {
    LAS int* tab = (LAS int*)(lds + LDS_MOETAB);
    MoeMap m; moe_map(c, m);
    int n = (m.ebase[8] - chunk * MOE_CH) / 256; n = n < 0 ? 0 : (n > MOE_CH / 256 ? MOE_CH / 256 : n);
    __syncthreads();
    if (c.tid < MOE_CH / 256) {
        const int slot0 = chunk * MOE_CH + c.tid * 256;
        int e = 0;
#pragma unroll
        for (int k = 1; k < 8; ++k) if (slot0 >= m.ebase[k]) e = k;
        int eb = 0, ec = 0;
#pragma unroll
        for (int k = 0; k < 8; ++k) if (k == e) { eb = m.ebase[k]; ec = m.cnt[k]; }
        tab[c.tid * 4 + 0] = e; tab[c.tid * 4 + 1] = slot0 - eb; tab[c.tid * 4 + 2] = ec - (slot0 - eb);
    }
    __syncthreads();
    return __builtin_amdgcn_readfirstlane(n);
}
__device__ __forceinline__ void phase_moe_up(const Ctx& c, int chunk, LAS unsigned char* lds) {
    const int nrt = moe_table(c, chunk, lds);
    SchedMoe S{(const LAS int*)(lds + LDS_MOETAB), (unsigned)WS_XN, (unsigned)WS_MOE_GU, c.LIST(), chunk, nrt, 2 * DFE / 256, (int)gridDim.x, (int)blockIdx.x, 1};
    EpiSwiglu E{c.HIDC(), DFE};
    g8::gemm_stream<true, true>(lds, (const char*)c.a->ws, S, E);
}
__device__ __forceinline__ void phase_moe_down(const Ctx& c, int chunk, LAS unsigned char* lds) {
    const int nrt = moe_table(c, chunk, lds);
    SchedMoe S{(const LAS int*)(lds + LDS_MOETAB), (unsigned)(WS_PROJ + WS_HIDC_OFF), (unsigned)WS_MOE_D, c.LIST(), chunk, nrt, D / 256, (int)gridDim.x, (int)blockIdx.x, 0};
    EpiBf16 E{c.Y(), D};
    g8::gemm_stream<true, false>(lds, (const char*)c.a->ws, S, E);
}


namespace fx {
typedef short bf16x8 __attribute__((ext_vector_type(8)));
typedef float f32x16 __attribute__((ext_vector_type(16)));
typedef float f32x4 __attribute__((ext_vector_type(4)));
constexpr int L_K = 0, L_V = 32768, L_CB = 65536, L_CBB = 65536 + 512, L_VOTE = 65536 + 1024, L_END = 65536 + 1024 + 64;
constexpr float LOG2E = 1.4426950408889634f;
constexpr float FOX_THR = 10.f;
__device__ __forceinline__ int swap23(int i) { return (i & ~12) | ((i & 4) << 1) | ((i & 8) >> 1); }

__device__ __forceinline__ void dma_k(const char* wsb, LAS unsigned char* lds, int kbuf, int b, int h, int jt, int tid) {
    const int wv = __builtin_amdgcn_readfirstlane(tid >> 6), lane = tid & 63;
    const unsigned kbase = (unsigned)WS_PROJ + ((unsigned)(b * S + 64 * jt) * PC + (unsigned)(C_FK + h * 128)) * 2u;
#pragma unroll
    for (int i = 0; i < 2; ++i) {
        const int id = (wv * 2 + i) * 64 + lane; const int rp = id >> 4, slot = id & 15;
        const unsigned ko = kbase + ((unsigned)swap23(rp) * PC + (unsigned)((slot ^ (rp & 15)) * 8)) * 2u;
        __builtin_amdgcn_global_load_lds((const unsigned*)(wsb + ko), (LAS unsigned*)(lds + L_K + kbuf * 16384 + (wv * 2 + i) * 1024), 16, 0, 0);
    }
}
__device__ __forceinline__ void dma_v(const char* wsb, LAS unsigned char* lds, int vbuf, int b, int h, int jt, int tid) {
    const int wv = __builtin_amdgcn_readfirstlane(tid >> 6), lane = tid & 63;
    const unsigned vbase = (unsigned)WS_VT + ((unsigned)((b * 4 + h) * 128) * S + 64u * jt) * 2u;
#pragma unroll
    for (int i = 0; i < 2; ++i) {
        const int id = (wv * 2 + i) * 64 + lane; const int d = id >> 3, vs = id & 7;
        const unsigned vo = vbase + ((unsigned)d * S + (unsigned)((vs ^ ((d >> 1) & 7)) * 8)) * 2u;
        __builtin_amdgcn_global_load_lds((const unsigned*)(wsb + vo), (LAS unsigned*)(lds + L_V + vbuf * 16384 + (wv * 2 + i) * 1024), 16, 0, 0);
    }
}
__device__ __forceinline__ float load_cb(const char* wsb, LAS unsigned char* lds, int b, int h, int jt, int tid) {
    float v = 0.f;
    if (tid < 64) v = -(*(const float*)(wsb + ((unsigned)WS_C + ((unsigned)(b * S + 64 * jt + tid) * 4 + h) * 4u)) + *(const LAS float*)(lds + L_CBB + jt * 4)) * LOG2E;
    return v;
}
__device__ __forceinline__ void meta_kv(const char* wsb, LAS unsigned char* lds, int h, int tid) {
    const unsigned kbase = (unsigned)WS_PROJ + ((unsigned)R * PC + (unsigned)(C_FK + h * 128)) * 2u, vbase = (unsigned)WS_PROJ + ((unsigned)R * PC + (unsigned)(C_FV + h * 128)) * 2u;
#pragma unroll
    for (int i = 0; i < 2; ++i) {
        const int id = tid + 512 * i;
        const int rp = id >> 4, slot = id & 15; const int key = swap23(rp);
        g8::u32x4 kv = {0u, 0u, 0u, 0u};
        if (key < NM) { const uint4 t = *(const uint4*)(wsb + (kbase + ((unsigned)key * PC + (unsigned)((slot ^ (rp & 15)) * 8)) * 2u)); kv = (g8::u32x4){t.x, t.y, t.z, t.w}; }
        *(LAS g8::u32x4*)(lds + L_K + id * 16) = kv;
        const int d = id >> 3, vs = id & 7; const int ch = vs ^ ((d >> 1) & 7);
        g8::u32x4 vv = {0u, 0u, 0u, 0u};
        if (ch < 2) {
            const unsigned vo = vbase + ((unsigned)(ch * 8) * PC + (unsigned)d) * 2u;
            unsigned e[8];
#pragma unroll
            for (int q = 0; q < 8; ++q) e[q] = *(const bf16_t*)(wsb + (vo + (unsigned)q * PC * 2u));
            vv = (g8::u32x4){e[0] | (e[1] << 16), e[2] | (e[3] << 16), e[4] | (e[5] << 16), e[6] | (e[7] << 16)};
        }
        *(LAS g8::u32x4*)(lds + L_V + id * 16) = vv;
    }
    if (tid < 64) {
        float cbv = 0.f;
        if (tid < NM) cbv = -*(const float*)(wsb + ((unsigned)WS_C + ((unsigned)(R + tid) * 4 + h) * 4u)) * LOG2E;
        *(LAS float*)(lds + L_CB + tid * 4) = cbv;
    }
}

struct WaveState { f32x16 O[4]; f32x16 s0, s1; unsigned pk0[8], pk1[8]; float m, l; };

__device__ __forceinline__ void qk(WaveState& w, const bf16x8 (&qf)[8], LAS unsigned char* lds, int kbuf, int lane) {
    const int ql = lane & 31, hi = lane >> 5, kx = ql & 15;
    const LAS unsigned char* Kb = lds + L_K + kbuf * 16384 + ql * 256;
#pragma unroll
    for (int r = 0; r < 16; ++r) { w.s0[r] = 0.f; w.s1[r] = 0.f; }
    bf16x8 fa[2], fb[2];
    { const LAS unsigned char* kp = Kb + (((0 + hi) ^ kx) << 4); fa[0] = *(const LAS bf16x8*)kp; fb[0] = *(const LAS bf16x8*)(kp + 32 * 256); }
#pragma unroll
    for (int ks = 0; ks < 8; ++ks) {
        if (ks + 1 < 8) { const LAS unsigned char* kp = Kb + (((2 * (ks + 1) + hi) ^ kx) << 4); fa[(ks + 1) & 1] = *(const LAS bf16x8*)kp; fb[(ks + 1) & 1] = *(const LAS bf16x8*)(kp + 32 * 256); }
        w.s0 = __builtin_amdgcn_mfma_f32_32x32x16_bf16(fa[ks & 1], qf[ks], w.s0, 0, 0, 0);
        w.s1 = __builtin_amdgcn_mfma_f32_32x32x16_bf16(fb[ks & 1], qf[ks], w.s1, 0, 0, 0);
        __builtin_amdgcn_sched_barrier(0);
    }
}
__device__ __forceinline__ void pv(WaveState& w, LAS unsigned char* lds, int vbuf, int lane) {
    const int ql = lane & 31, hi = lane >> 5, vx = (ql >> 1) & 7;
    const LAS unsigned char* Vb = lds + L_V + vbuf * 16384 + ql * 128;
    bf16x8 fv[2][4];
    { const LAS unsigned char* vp = Vb + (((0 + hi) ^ vx) << 4);
#pragma unroll
      for (int db = 0; db < 4; ++db) fv[0][db] = *(const LAS bf16x8*)(vp + db * 4096); }
#pragma unroll
    for (int g = 0; g < 4; ++g) {
        const int kb = g >> 1, sl = g & 1;
        if (g + 1 < 4) { const int kb2 = (g + 1) >> 1, sl2 = (g + 1) & 1; const LAS unsigned char* vp = Vb + (((4 * kb2 + 2 * sl2 + hi) ^ vx) << 4);
#pragma unroll
            for (int db = 0; db < 4; ++db) fv[(g + 1) & 1][db] = *(const LAS bf16x8*)(vp + db * 4096); }
        g8::u32x4 bv;
        if (kb == 0) bv = (g8::u32x4){w.pk0[4 * sl], w.pk0[4 * sl + 1], w.pk0[4 * sl + 2], w.pk0[4 * sl + 3]};
        else         bv = (g8::u32x4){w.pk1[4 * sl], w.pk1[4 * sl + 1], w.pk1[4 * sl + 2], w.pk1[4 * sl + 3]};
#pragma unroll
        for (int db = 0; db < 4; ++db) w.O[db] = __builtin_amdgcn_mfma_f32_32x32x16_bf16(fv[g & 1][db], __builtin_bit_cast(bf16x8, bv), w.O[db], 0, 0, 0);
        __builtin_amdgcn_sched_barrier(0);
    }
}
__device__ __forceinline__ void softmax(WaveState& w, LAS unsigned char* lds, int cbuf, int lim, int lane) {
    const int hi = lane >> 5;
    const LAS float* cb = (const LAS float*)(lds + L_CB + cbuf * 256) + 8 * hi;
#pragma unroll
    for (int g = 0; g < 4; ++g) {
        const f32x4 c0 = *(const LAS f32x4*)(cb + 16 * (g >> 1) + 4 * (g & 1)), c1 = *(const LAS f32x4*)(cb + 32 + 16 * (g >> 1) + 4 * (g & 1));
#pragma unroll
        for (int j = 0; j < 4; ++j) { w.s0[4 * g + j] += c0[j]; w.s1[4 * g + j] += c1[j]; }
    }
    if (lim < 64) {
        const float NEG = -__builtin_inff();
#pragma unroll
        for (int r = 0; r < 16; ++r) {
            const int kap = 16 * (r >> 3) + 8 * hi + (r & 7);
            if (kap > lim) w.s0[r] = NEG;
            if (kap + 32 > lim) w.s1[r] = NEG;
        }
    }
    float pmax = w.s0[0];
#pragma unroll
    for (int r = 1; r < 16; ++r) pmax = fmaxf(pmax, w.s0[r]);
#pragma unroll
    for (int r = 0; r < 16; ++r) pmax = fmaxf(pmax, w.s1[r]);
    pmax = fmaxf(pmax, __shfl_xor(pmax, 32));
    float mn = w.m;
    if (!__all(pmax - w.m <= FOX_THR)) {
        mn = fmaxf(w.m, pmax);
        const float alpha = __builtin_amdgcn_exp2f(w.m - mn);
        w.m = mn; w.l *= alpha;
#pragma unroll
        for (int db = 0; db < 4; ++db)
#pragma unroll
            for (int r = 0; r < 16; ++r) w.O[db][r] *= alpha;
    }
    float ls = 0.f;
#pragma unroll
    for (int r = 0; r < 16; ++r) { w.s0[r] = __builtin_amdgcn_exp2f(w.s0[r] - mn); w.s1[r] = __builtin_amdgcn_exp2f(w.s1[r] - mn); ls += w.s0[r] + w.s1[r]; }
    ls += __shfl_xor(ls, 32);
    w.l += ls;
#pragma unroll
    for (int i = 0; i < 8; ++i) { w.pk0[i] = g8::cvt_pk_bf16(w.s0[2 * i], w.s0[2 * i + 1]); w.pk1[i] = g8::cvt_pk_bf16(w.s1[2 * i], w.s1[2 * i + 1]); }
}

__device__ __forceinline__ bool block_and(LAS unsigned char* lds, bool pred, int wv, int lane) {
    const bool wall = __builtin_amdgcn_ballot_w64(pred) == 0xFFFFFFFFFFFFFFFFull;
    if (lane == 0) *(LAS int*)(lds + L_VOTE + wv * 4) = wall ? 1 : 0;
    __syncthreads();
    int r = 1;
#pragma unroll
    for (int q = 0; q < 8; ++q) r &= *(const LAS int*)(lds + L_VOTE + q * 4);
    return r != 0;
}
__device__ __forceinline__ void qblock(char* wsb, LAS unsigned char* lds, int b, int h, int qb, int tid_in) {
    int tid = tid_in; asm volatile("" : "+v"(tid));
    const int lane = tid & 63, wv = __builtin_amdgcn_readfirstlane(tid >> 6), ql = lane & 31, hi = lane >> 5;
    const int grp = wv >> 2;
    const int qcol = C_FQ + h * 128;
    const unsigned qoff = (unsigned)WS_PROJ + ((unsigned)(b * S + 256 * qb + 32 * wv + ql) * PC + qcol + hi * 8) * 2u;
    bf16x8 qf[8];
#pragma unroll
    for (int ks = 0; ks < 8; ++ks) qf[ks] = *(const bf16x8*)(wsb + (qoff + ks * 32));
    float qkb;
    {
        float ss = 0.f;
#pragma unroll
        for (int ks = 0; ks < 8; ++ks) {
            const g8::u32x4 qw = __builtin_bit_cast(g8::u32x4, qf[ks]);
            ss += bflo(qw.x) * bflo(qw.x) + bfhi(qw.x) * bfhi(qw.x) + bflo(qw.y) * bflo(qw.y) + bfhi(qw.y) * bfhi(qw.y)
                + bflo(qw.z) * bflo(qw.z) + bfhi(qw.z) * bfhi(qw.z) + bflo(qw.w) * bflo(qw.w) + bfhi(qw.w) * bfhi(qw.w);
        }
        ss += __shfl_xor(ss, 32);
        const unsigned* KP = (const unsigned*)(wsb + WS_KPART) + (b * 4 + h) * 4;
        const float k2 = __uint_as_float(KP[0]) + __uint_as_float(KP[1]) + __uint_as_float(KP[2]) + __uint_as_float(KP[3]);
        qkb = sqrtf(ss) * sqrtf(k2) * 1.002f + 0.05f;
    }
    WaveState w;
#pragma unroll
    for (int db = 0; db < 4; ++db)
#pragma unroll
        for (int r = 0; r < 16; ++r) w.O[db][r] = 0.f;
    w.m = -1e30f; w.l = 0.f;
    const int n = 4 * qb + 5;
    const int jd = 4 * qb + (wv >> 1);
    const int tf = 4 - (wv >> 1);
    const int dlim = 32 * (wv & 1) + ql;
#define FX_JT(t_) (4 * qb + 4 - (t_))
#define FX_ACT(t_) ((t_) == 0 || (t_) >= tf)
    __syncthreads();
    if (tid < 64) {
        const float* CTp = (const float*)(wsb + WS_CT) + ((b * 4 + h) * 128 + 2 * tid);
        const float t0 = CTp[0], t1 = CTp[1];
        float sc = t0 + t1;
#pragma unroll
        for (int o = 1; o < 64; o <<= 1) { const float t = __shfl_up(sc, o); if (tid >= o) sc += t; }
        const float meta_tot = *(const float*)(wsb + ((unsigned)WS_C + ((unsigned)(R + NM - 1) * 4 + h) * 4u));
        const float e0 = meta_tot + sc - (t0 + t1);
        *(LAS float*)(lds + L_CBB + (2 * tid) * 4) = e0; *(LAS float*)(lds + L_CBB + (2 * tid + 1) * 4) = e0 + t0;
    }
    __syncthreads();
    meta_kv(wsb, lds, h, tid);
    dma_k(wsb, lds, 1, b, h, FX_JT(1), tid);
    { const float c1 = load_cb(wsb, lds, b, h, FX_JT(1), tid); if (tid < 64) *(LAS float*)(lds + L_CB + 256 + tid * 4) = c1; }
    asm volatile("s_waitcnt vmcnt(0)" ::: "memory");
    __syncthreads();
    float cbreg = 0.f;
#define FX_EVEN(m_) do { const int m__ = (m_); if (m__ >= 1) { int tq = tid; asm volatile("" : "+v"(tq)); \
        if (m__ + 1 < n) { dma_k(wsb, lds, (m__ + 1) & 1, b, h, FX_JT(m__ + 1), tq); cbreg = load_cb(wsb, lds, b, h, FX_JT(m__ + 1), tq); } \
        if (m__ < n) dma_v(wsb, lds, m__ & 1, b, h, FX_JT(m__), tq); } } while (0)
#define FX_ODD(m_) do { const int m__ = (m_); asm volatile("s_waitcnt vmcnt(0)" ::: "memory"); \
        if (m__ >= 1 && m__ + 1 < n && tid < 64) *(LAS float*)(lds + L_CB + ((m__ + 1) & 1) * 256 + tid * 4) = cbreg; } while (0)
#define FX_SM(t_) do { const int t__ = (t_); if (FX_ACT(t__)) softmax(w, lds, t__ & 1, t__ == 0 ? NM - 1 : (FX_JT(t__) < jd ? 64 : dlim), lane); } while (0)
#define FX_VOTE(t_) (((t_) >= 1 && (t_) < n - 1) ? (qkb - *(const LAS float*)(lds + L_CBB + FX_JT(t_) * 4) * LOG2E < w.m - 127.f) : false)
    if (grp == 0) {
        qk(w, qf, lds, 0, lane);
        __syncthreads();
        for (int t = 0; ; ++t) {
            FX_SM(t); FX_ODD(t);
            const bool last = block_and(lds, FX_VOTE(t), wv, lane) || t == n - 1;
            if (!last) FX_EVEN(t + 1);
            if (FX_ACT(t)) pv(w, lds, t & 1, lane);
            if (!last && FX_ACT(t + 1)) qk(w, qf, lds, (t + 1) & 1, lane);
            __syncthreads();
            if (last) break;
        }
        asm volatile("s_waitcnt vmcnt(0)" ::: "memory");
        (void)block_and(lds, false, wv, lane);
    } else {
        __syncthreads();
        qk(w, qf, lds, 0, lane); FX_ODD(0);
        bool last = block_and(lds, false, wv, lane);
        for (int t = 0; ; ++t) {
            if (!last) FX_EVEN(t + 1);
            FX_SM(t);
            __syncthreads();
            if (FX_ACT(t)) pv(w, lds, t & 1, lane);
            if (!last && FX_ACT(t + 1)) qk(w, qf, lds, (t + 1) & 1, lane);
            FX_ODD(t + 1);
            const bool stop_next = block_and(lds, FX_VOTE(t + 1), wv, lane);
            if (last) break;
            last = stop_next || (t + 1 == n - 1);
        }
    }
#undef FX_EVEN
#undef FX_ODD
#undef FX_SM
#undef FX_VOTE
#undef FX_JT
#undef FX_ACT
    const float inv = 1.f / w.l;
    int tz = tid; asm volatile("" : "+v"(tz));
    const unsigned ooff = (unsigned)WS_PROJ + ((unsigned)(b * S + 256 * qb + 32 * wv + (tz & 31)) * PC + qcol + ((tz >> 5) & 1) * 4) * 2u;
#pragma unroll
    for (int db = 0; db < 4; ++db)
#pragma unroll
        for (int g = 0; g < 4; ++g) {
            uint2 o; o.x = g8::cvt_pk_bf16(w.O[db][4 * g] * inv, w.O[db][4 * g + 1] * inv); o.y = g8::cvt_pk_bf16(w.O[db][4 * g + 2] * inv, w.O[db][4 * g + 3] * inv);
            *(uint2*)(wsb + (ooff + (32 * db + 8 * g) * 2)) = o;
        }
}
}

namespace sx {
using fx::bf16x8; using fx::f32x16; using fx::WaveState; using fx::swap23; using fx::L_K; using fx::L_V;
__device__ __forceinline__ void dma_k(const char* wsb, LAS unsigned char* lds, int kbuf, int b, int h, int jt, int tid) {
    const int wv = __builtin_amdgcn_readfirstlane(tid >> 6), lane = tid & 63;
    const unsigned kbase = (unsigned)WS_PROJ + ((unsigned)(b * S + 64 * jt) * PC + (unsigned)(C_SK + h * 128)) * 2u;
#pragma unroll
    for (int i = 0; i < 2; ++i) {
        const int id = (wv * 2 + i) * 64 + lane; const int rp = id >> 4, slot = id & 15;
        const unsigned ko = kbase + ((unsigned)swap23(rp) * PC + (unsigned)((slot ^ (rp & 15)) * 8)) * 2u;
        __builtin_amdgcn_global_load_lds((const unsigned*)(wsb + ko), (LAS unsigned*)(lds + L_K + kbuf * 16384 + (wv * 2 + i) * 1024), 16, 0, 0);
    }
}
__device__ __forceinline__ void dma_v(const char* wsb, LAS unsigned char* lds, int vbuf, int b, int h, int jt, int tid) {
    const int wv = __builtin_amdgcn_readfirstlane(tid >> 6), lane = tid & 63;
    const unsigned vbase = (unsigned)WS_VT + ((unsigned)((16 + b * 4 + h) * 128) * S + 64u * jt) * 2u;
#pragma unroll
    for (int i = 0; i < 2; ++i) {
        const int id = (wv * 2 + i) * 64 + lane; const int d = id >> 3, vs = id & 7;
        const unsigned vo = vbase + ((unsigned)d * S + (unsigned)((vs ^ ((d >> 1) & 7)) * 8)) * 2u;
        __builtin_amdgcn_global_load_lds((const unsigned*)(wsb + vo), (LAS unsigned*)(lds + L_V + vbuf * 16384 + (wv * 2 + i) * 1024), 16, 0, 0);
    }
}
__device__ __forceinline__ void meta_k(const char* wsb, LAS unsigned char* lds, int kbuf, int h, int tid) {
    const unsigned kbase = (unsigned)WS_PROJ + ((unsigned)R * PC + (unsigned)(C_SK + h * 128)) * 2u;
#pragma unroll
    for (int i = 0; i < 2; ++i) {
        const int id = tid + 512 * i;
        const int rp = id >> 4, slot = id & 15; const int key = swap23(rp);
        g8::u32x4 kv = {0u, 0u, 0u, 0u};
        if (key < NM) { const uint4 t = *(const uint4*)(wsb + (kbase + ((unsigned)key * PC + (unsigned)((slot ^ (rp & 15)) * 8)) * 2u)); kv = (g8::u32x4){t.x, t.y, t.z, t.w}; }
        *(LAS g8::u32x4*)(lds + L_K + kbuf * 16384 + id * 16) = kv;
    }
}
__device__ __forceinline__ void meta_v(const char* wsb, LAS unsigned char* lds, int vbuf, int h, int tid) {
    const unsigned vbase = (unsigned)WS_PROJ + ((unsigned)R * PC + (unsigned)(C_SV + h * 128)) * 2u;
#pragma unroll
    for (int i = 0; i < 2; ++i) {
        const int id = tid + 512 * i;
        const int d = id >> 3, vs = id & 7; const int ch = vs ^ ((d >> 1) & 7);
        g8::u32x4 vv = {0u, 0u, 0u, 0u};
        if (ch < 2) {
            const unsigned vo = vbase + ((unsigned)(ch * 8) * PC + (unsigned)d) * 2u;
            unsigned e[8];
#pragma unroll
            for (int q = 0; q < 8; ++q) e[q] = *(const bf16_t*)(wsb + (vo + (unsigned)q * PC * 2u));
            vv = (g8::u32x4){e[0] | (e[1] << 16), e[2] | (e[3] << 16), e[4] | (e[5] << 16), e[6] | (e[7] << 16)};
        }
        *(LAS g8::u32x4*)(lds + L_V + vbuf * 16384 + id * 16) = vv;
    }
}
__device__ __forceinline__ void sbweights(WaveState& w, float& rr, int lim, int lane) {
    const int hi = lane >> 5;
    float T[4];
#pragma unroll
    for (int rho = 0; rho < 4; ++rho) {
        float pv[8], qv[8];
#pragma unroll
        for (int e = 0; e < 8; ++e) {
            const int r = 8 * (rho & 1) + e;
            const float z = rho < 2 ? w.s0[r] : w.s1[r];
            const float t = __builtin_amdgcn_exp2f(-fabsf(z));
            const float big = __builtin_amdgcn_rcpf(1.f + t), sml = t * big;
            const bool pos = z >= 0.f;
            pv[e] = pos ? big : sml; qv[e] = pos ? sml : big;
        }
        if (lim < 64) {
#pragma unroll
            for (int e = 0; e < 8; ++e) {
                const bool valid = (32 * (rho >> 1) + 16 * (rho & 1) + e) < lim - 8 * hi;
                pv[e] = valid ? pv[e] : 0.f; qv[e] = valid ? qv[e] : 1.f;
            }
        }
        float suf = 1.f;
#pragma unroll
        for (int e = 7; e >= 0; --e) { pv[e] *= suf; suf *= qv[e]; }
        T[rho] = suf;
#pragma unroll
        for (int e = 0; e < 8; ++e) { const int r = 8 * (rho & 1) + e; if (rho < 2) w.s0[r] = pv[e]; else w.s1[r] = pv[e]; }
    }
    float run = __builtin_amdgcn_exp2f(rr);
    float lg = 0.f;
#pragma unroll
    for (int rho = 3; rho >= 0; --rho) {
        const float Tp = __shfl_xor(T[rho], 32);
        const float base = run * (hi == 0 ? Tp : 1.f);
#pragma unroll
        for (int e = 0; e < 8; ++e) {
            const int r = 8 * (rho & 1) + e;
            if (rho < 2) w.s0[r] *= base; else w.s1[r] *= base;
        }
        run *= T[rho] * Tp;
        lg += __builtin_amdgcn_logf(T[rho]);
    }
    rr += lg + __shfl_xor(lg, 32);
#pragma unroll
    for (int i = 0; i < 8; ++i) { w.pk0[i] = g8::cvt_pk_bf16(w.s0[2 * i], w.s0[2 * i + 1]); w.pk1[i] = g8::cvt_pk_bf16(w.s1[2 * i], w.s1[2 * i + 1]); }
}

__device__ __forceinline__ void qblock(char* wsb, LAS unsigned char* lds, int b, int h, int qb, int tid_in) {
    int tid = tid_in; asm volatile("" : "+v"(tid));
    const int lane = tid & 63, wv = __builtin_amdgcn_readfirstlane(tid >> 6), ql = lane & 31, hi = lane >> 5;
    const int grp = wv >> 2;
    const int qcol = C_SQ + h * 128;
    const unsigned qoff = (unsigned)WS_PROJ + ((unsigned)(b * S + 256 * qb + 32 * wv + ql) * PC + qcol + hi * 8) * 2u;
    bf16x8 qf[8];
#pragma unroll
    for (int ks = 0; ks < 8; ++ks) qf[ks] = *(const bf16x8*)(wsb + (qoff + ks * 32));
    WaveState w;
#pragma unroll
    for (int db = 0; db < 4; ++db)
#pragma unroll
        for (int r = 0; r < 16; ++r) w.O[db][r] = 0.f;
    w.m = 0.f; w.l = 0.f;
    float rr = 0.f;
    const int n = 4 * qb + 5;
    const int tf = 3 - (wv >> 1);
    const int dlim = 32 * (wv & 1) + ql;
#define SX_JT(t_) (4 * qb + 3 - (t_))
#define SX_LIM(t_) ((t_) == n - 1 ? NM : ((t_) == tf ? dlim : 64))
    __syncthreads();
    dma_k(wsb, lds, 0, b, h, SX_JT(0), tid); dma_v(wsb, lds, 0, b, h, SX_JT(0), tid); dma_k(wsb, lds, 1, b, h, SX_JT(1), tid);
    asm volatile("s_waitcnt vmcnt(0)" ::: "memory");
    __syncthreads();
#define SX_EVEN(m_) do { const int m__ = (m_); if (m__ >= 1) { int tq = tid; asm volatile("" : "+v"(tq)); \
        if (m__ + 1 < n) { if (m__ + 1 == n - 1) meta_k(wsb, lds, (m__ + 1) & 1, h, tq); else dma_k(wsb, lds, (m__ + 1) & 1, b, h, SX_JT(m__ + 1), tq); } \
        if (m__ < n) { if (m__ == n - 1) meta_v(wsb, lds, m__ & 1, h, tq); else dma_v(wsb, lds, m__ & 1, b, h, SX_JT(m__), tq); } } } while (0)
#define SX_ODD() asm volatile("s_waitcnt vmcnt(0)" ::: "memory")
#define SX_SM(t_) do { const int t__ = (t_); if (t__ >= tf) sbweights(w, rr, SX_LIM(t__), lane); } while (0)
#define SX_VOTE(t_) ((t_) < n - 1 ? (rr < -127.f) : false)
    if (grp == 0) {
        if (0 >= tf) fx::qk(w, qf, lds, 0, lane);
        __syncthreads();
        for (int t = 0; ; ++t) {
            SX_SM(t); SX_ODD();
            const bool last = fx::block_and(lds, SX_VOTE(t), wv, lane) || t == n - 1;
            if (!last) SX_EVEN(t + 1);
            if (t >= tf) fx::pv(w, lds, t & 1, lane);
            if (!last && t + 1 >= tf) fx::qk(w, qf, lds, (t + 1) & 1, lane);
            __syncthreads();
            if (last) break;
        }
        SX_ODD();
        (void)fx::block_and(lds, false, wv, lane);
    } else {
        __syncthreads();
        if (0 >= tf) fx::qk(w, qf, lds, 0, lane);
        SX_ODD();
        bool last = fx::block_and(lds, SX_VOTE(0), wv, lane);
        for (int t = 0; ; ++t) {
            if (!last) SX_EVEN(t + 1);
            SX_SM(t);
            __syncthreads();
            if (t >= tf) fx::pv(w, lds, t & 1, lane);
            if (!last && t + 1 >= tf) fx::qk(w, qf, lds, (t + 1) & 1, lane);
            SX_ODD();
            const bool stop_next = fx::block_and(lds, SX_VOTE(t + 1), wv, lane);
            if (last) break;
            last = stop_next || (t + 1 == n - 1);
        }
    }
#undef SX_EVEN
#undef SX_ODD
#undef SX_SM
#undef SX_VOTE
#undef SX_JT
#undef SX_LIM
    int tz = tid; asm volatile("" : "+v"(tz));
    const unsigned ooff = (unsigned)WS_PROJ + ((unsigned)(b * S + 256 * qb + 32 * wv + (tz & 31)) * PC + qcol + ((tz >> 5) & 1) * 4) * 2u;
#pragma unroll
    for (int db = 0; db < 4; ++db)
#pragma unroll
        for (int g = 0; g < 4; ++g) {
            uint2 o; o.x = g8::cvt_pk_bf16(w.O[db][4 * g], w.O[db][4 * g + 1]); o.y = g8::cvt_pk_bf16(w.O[db][4 * g + 2], w.O[db][4 * g + 3]);
            *(uint2*)(wsb + (ooff + (32 * db + 8 * g) * 2)) = o;
        }
}
}

__device__ __forceinline__ void phase_attn_main(const Ctx& c, int layer, LAS unsigned char* lds) {
    char* wsb = (char*)c.a->ws;
    {
        unsigned* ctr = (unsigned*)(c.a->ws + WS_FOXQ) + layer * 16;
        LAS int* slot = (LAS int*)(lds + 65536 + 1024 + 32);
        for (;;) {
            __syncthreads();
            if (c.tid == 0) *slot = (int)__hip_atomic_fetch_add(ctr, 1u, __ATOMIC_RELAXED, __HIP_MEMORY_SCOPE_AGENT);
            __syncthreads();
            const int it = *slot;
            if (it >= 512) break;
            const int bh = it & 15, qb = 31 - (it >> 4);
            fx::qblock(wsb, lds, bh >> 2, bh & 3, qb, c.tid);
        }
    }
    for (int it = blockIdx.x; it < 512; it += gridDim.x) {
        const int bh = it >> 5, qb = it & 31;
        sx::qblock(wsb, lds, bh >> 2, bh & 3, qb, c.tid);
    }
    __syncthreads();
}

namespace mg {
typedef short bf16x8 __attribute__((ext_vector_type(8)));
typedef float f32x4 __attribute__((ext_vector_type(4)));
__device__ __forceinline__ void mma16(f32x4& acc, const bf16_t* ap, const bf16_t* bp, int k0, int klen) {
#pragma unroll 4
    for (int k = k0; k < k0 + klen; k += 32) {
        const bf16x8 a = *(const bf16x8*)(ap + k), b = *(const bf16x8*)(bp + k);
        acc = __builtin_amdgcn_mfma_f32_16x16x32_bf16(a, b, acc, 0, 0, 0);
    }
}
template <int SLOTS>
__device__ __forceinline__ void put_partial(float* red, int slot, const f32x4& acc, int tid) {
    const int wv = tid >> 6, lane = tid & 63, fr = lane & 15, fq = lane >> 4;
#pragma unroll
    for (int j = 0; j < 4; ++j) red[((slot * 8 + wv) * 16 + 4 * fq + j) * 16 + fr] = acc[j];
}
__device__ __forceinline__ float get_sum(const float* red, int slot, int tid) {
    float v = 0.f;
#pragma unroll
    for (int w = 0; w < 8; ++w) v += red[(slot * 8 + w) * 256 + tid];
    return v;
}
__device__ __forceinline__ int item0() { return (int)gridDim.x - 1 - (int)blockIdx.x; }
}

__device__ __forceinline__ void meta_proj(const Ctx& c, int layer) {
    const int tid = c.tid, wv = tid >> 6, lane = tid & 63, fr = lane & 15, fq = lane >> 4;
    const bf16_t* A = c.XN() + (size_t)(R + fr) * D + fq * 8;
    const bf16_t* W = (const bf16_t*)(c.a->ws + WS_WB + layer * WB_LAYER + WB_IN);
    float* red = c.smem;
    for (int g = mg::item0(); g < PC / 16; g += gridDim.x) {
        mg::f32x4 acc = {0.f, 0.f, 0.f, 0.f};
        mg::mma16(acc, A, W + (size_t)(g * 16 + fr) * D + fq * 8, wv * (D / 8), D / 8);
        __syncthreads();
        mg::put_partial<1>(red, 0, acc, tid);
        __syncthreads();
        if (tid < 256) c.PROJ()[(size_t)(R + (tid >> 4)) * PC + g * 16 + (tid & 15)] = f2bf(mg::get_sum(red, 0, tid));
    }
}
__device__ __forceinline__ void meta_merge(const Ctx& c, int layer) {
    const int tid = c.tid, wv = tid >> 6, lane = tid & 63, fr = lane & 15, fq = lane >> 4;
    const unsigned char* wb = c.a->ws + WS_WB + layer * WB_LAYER;
    float* red = c.smem;
    for (int g = mg::item0(); g < D / 16; g += gridDim.x) {
        const int n = g * 16 + fr;
        mg::f32x4 ga[3], ya[3];
#pragma unroll
        for (int j3 = 0; j3 < 3; ++j3) {
            ga[j3] = (mg::f32x4){0.f, 0.f, 0.f, 0.f}; ya[j3] = (mg::f32x4){0.f, 0.f, 0.f, 0.f};
            mg::mma16(ga[j3], c.XN() + (size_t)(R + fr) * D + fq * 8, (const bf16_t*)(wb + WB_G) + (size_t)(j3 * D + n) * D + fq * 8, wv * (D / 8), D / 8);
            const int acol = j3 == 0 ? C_FQ : j3 == 1 ? C_SQ : C_LG;
            const bf16_t* Wo = (const bf16_t*)(wb + (j3 == 0 ? WB_FO : j3 == 1 ? WB_SO : WB_LO));
            mg::mma16(ya[j3], c.PROJ() + (size_t)(R + fr) * PC + acol + fq * 8, Wo + (size_t)n * 512 + fq * 8, wv * 64, 64);
        }
        __syncthreads();
#pragma unroll
        for (int j3 = 0; j3 < 3; ++j3) { mg::put_partial<6>(red, 2 * j3, ga[j3], tid); mg::put_partial<6>(red, 2 * j3 + 1, ya[j3], tid); }
        __syncthreads();
        if (tid < 256) {
            const int col = g * 16 + (tid & 15);
            float m = 0.f;
#pragma unroll
            for (int j3 = 0; j3 < 3; ++j3) {
                const float gv = mg::get_sum(red, 2 * j3, tid) + c.b_gate()[layer * 3 * D + j3 * D + col];
                m += mg::get_sum(red, 2 * j3 + 1, tid) * __builtin_amdgcn_rcpf(1.f + __builtin_amdgcn_exp2f(-1.4426950408889634f * gv));
            }
            c.PROJ()[(size_t)(R + (tid >> 4)) * PC + C_MRG + col] = f2bf(m);
        }
    }
}
__device__ __forceinline__ void meta_resid(const Ctx& c, const float* src, const bf16_t* A, int lda, const bf16_t* Wt, int K) {
    const int tid = c.tid, wv = tid >> 6, lane = tid & 63, fr = lane & 15, fq = lane >> 4;
    float* red = c.smem;
    const int kl = K / 8;
    for (int g = mg::item0(); g < D / 16; g += gridDim.x) {
        const int n = g * 16 + fr;
        mg::f32x4 acc = {0.f, 0.f, 0.f, 0.f};
        mg::mma16(acc, A + (size_t)(R + fr) * lda + fq * 8, Wt + (size_t)n * K + fq * 8, wv * kl, kl);
        __syncthreads();
        mg::put_partial<1>(red, 0, acc, tid);
        __syncthreads();
        if (tid < 256) { const size_t o = (size_t)(tid >> 4) * D + g * 16 + (tid & 15); c.hmeta()[o] = src[o] + mg::get_sum(red, 0, tid); }
    }
}
__device__ __forceinline__ void meta_ffn_up(const Ctx& c) {
    const int tid = c.tid, wv = tid >> 6, lane = tid & 63, fr = lane & 15, fq = lane >> 4;
    const bf16_t* W = (const bf16_t*)(c.a->ws + WS_WGU);
    const bf16_t* A = c.XN() + (size_t)(R + fr) * D + fq * 8;
    float* red = c.smem;
    for (int g = mg::item0(); g < DFF / 16; g += gridDim.x) {
        const int h = g * 16 + fr; const int rg = 8 * (h >> 2) + (h & 3);
        mg::f32x4 ga = {0.f, 0.f, 0.f, 0.f}, ua = {0.f, 0.f, 0.f, 0.f};
        mg::mma16(ga, A, W + (size_t)rg * D + fq * 8, wv * (D / 8), D / 8);
        mg::mma16(ua, A, W + (size_t)(rg + 4) * D + fq * 8, wv * (D / 8), D / 8);
        __syncthreads();
        mg::put_partial<2>(red, 0, ga, tid); mg::put_partial<2>(red, 1, ua, tid);
        __syncthreads();
        if (tid < 256) {
            const float gs = mg::get_sum(red, 0, tid), us = mg::get_sum(red, 1, tid);
            c.PROJ()[(size_t)(R + (tid >> 4)) * DFF + g * 16 + (tid & 15)] = f2bf(gs * us * __builtin_amdgcn_rcpf(1.f + __builtin_amdgcn_exp2f(-1.4426950408889634f * gs)));
        }
    }
}

struct CvtJob { const float* src; bf16_t* dst; int ldw, K, N, mode; };
__device__ __forceinline__ void cvt_load(const CvtJob& j, int t, int nk, int g, int ko, float4 (&v)[8]) {
    const int kt = t % nk, ntile = t / nk;
    const float* sp = j.src + (size_t)(kt * 128 + ko * 8) * j.ldw + ntile * 128 + g * 4;
#pragma unroll
    for (int i = 0; i < 8; ++i) v[i] = *(const float4*)(sp + (size_t)i * j.ldw);
}
__device__ __forceinline__ void cvt_store(const CvtJob& j, int t, int nk, int g, int ko, const float4 (&v)[8], uint4* img, int tid) {
    const int kt = t % nk, ntile = t / nk;
    lds_barrier();
#pragma unroll
    for (int q = 0; q < 4; ++q) {
        float e[8];
#pragma unroll
        for (int i = 0; i < 8; ++i) e[i] = q == 0 ? v[i].x : q == 1 ? v[i].y : q == 2 ? v[i].z : v[i].w;
        uint4 o; o.x = pack2(e[0], e[1]); o.y = pack2(e[2], e[3]); o.z = pack2(e[4], e[5]); o.w = pack2(e[6], e[7]);
        img[(4 * g + q) * 16 + (ko ^ (g & 15))] = o;
    }
    lds_barrier();
    const int c16 = tid & 15, r0 = tid >> 4;
#pragma unroll
    for (int i = 0; i < 4; ++i) {
        const int r = r0 + 32 * i;
        const uint4 o = img[r * 16 + (c16 ^ ((r >> 2) & 15))];
        const int ng = ntile * 128 + r;
        const int row = j.mode == 0 ? ng : (8 * (ng >> 2) + (ng & 3) + (j.mode == 2 ? 4 : 0));
        *(uint4*)(j.dst + (size_t)row * j.K + kt * 128 + c16 * 8) = o;
    }
}
__device__ __forceinline__ void cvt_tiles(const CvtJob& j, int& base, float* lds, int tid) {
    const int nk = j.K / 128, nn = j.N / 128, nt = nk * nn;
    const int G = gridDim.x;
    const int g = tid & 31, ko = tid >> 5;
    uint4* img = (uint4*)lds;
    const int first = ((int)blockIdx.x - base % G + G) % G;
    float4 va[8], vb[8];
    if (first < nt) cvt_load(j, first, nk, g, ko, va);
    for (int t = first; t < nt; t += 2 * G) {
        if (t + G < nt) cvt_load(j, t + G, nk, g, ko, vb);
        cvt_store(j, t, nk, g, ko, va, img, tid);
        if (t + G < nt) {
            if (t + 2 * G < nt) cvt_load(j, t + 2 * G, nk, g, ko, va);
            cvt_store(j, t + G, nk, g, ko, vb, img, tid);
        }
    }
    base += nt;
}
__device__ __forceinline__ void phase_cvt_dense(const Ctx& c) {
    int base = 0; float* tile = c.smem; unsigned char* ws = c.a->ws;
#pragma unroll 1
    for (int l = 0; l < 2; ++l) {
        const float* win = c.w_in() + (size_t)l * D * INC; unsigned char* wb = ws + WS_WB + l * WB_LAYER;
        cvt_tiles(CvtJob{win, (bf16_t*)(wb + WB_IN), INC, D, 1536, 0}, base, tile, c.tid);
        cvt_tiles(CvtJob{win + 1540, (bf16_t*)(wb + WB_IN) + (size_t)1536 * D, INC, D, 2560, 0}, base, tile, c.tid);
        cvt_tiles(CvtJob{win + WI_GATES, (bf16_t*)(wb + WB_G), INC, D, 3 * D, 0}, base, tile, c.tid);
        cvt_tiles(CvtJob{c.w_fox_o() + (size_t)l * 512 * D, (bf16_t*)(wb + WB_FO), D, 512, D, 0}, base, tile, c.tid);
        cvt_tiles(CvtJob{c.w_sb_o() + (size_t)l * 512 * D, (bf16_t*)(wb + WB_SO), D, 512, D, 0}, base, tile, c.tid);
        cvt_tiles(CvtJob{c.w_lru_o() + (size_t)l * 512 * D, (bf16_t*)(wb + WB_LO), D, 512, D, 0}, base, tile, c.tid);
        cvt_tiles(CvtJob{c.w_out() + (size_t)l * D * D, (bf16_t*)(wb + WB_OUT), D, D, D, 0}, base, tile, c.tid);
    }
    cvt_tiles(CvtJob{c.ffn_wg(), (bf16_t*)(ws + WS_WGU), DFF, D, DFF, 1}, base, tile, c.tid);
    cvt_tiles(CvtJob{c.ffn_wu(), (bf16_t*)(ws + WS_WGU), DFF, D, DFF, 2}, base, tile, c.tid);
    cvt_tiles(CvtJob{c.ffn_wd(), (bf16_t*)(ws + WS_WD), D, DFF, D, 0}, base, tile, c.tid);
}
__device__ __forceinline__ void phase_cvt_moe(const Ctx& c) {
    int base = 0; float* tile = c.smem; unsigned char* ws = c.a->ws;
#pragma unroll 1
    for (int e = 0; e < NE; ++e) {
        cvt_tiles(CvtJob{c.moe_wg() + (size_t)e * D * DFE, (bf16_t*)(ws + WS_MOE_GU) + (size_t)e * 2 * DFE * D, DFE, D, DFE, 1}, base, tile, c.tid);
        cvt_tiles(CvtJob{c.moe_wu() + (size_t)e * D * DFE, (bf16_t*)(ws + WS_MOE_GU) + (size_t)e * 2 * DFE * D, DFE, D, DFE, 2}, base, tile, c.tid);
        cvt_tiles(CvtJob{c.moe_wd() + (size_t)e * DFE * D, (bf16_t*)(ws + WS_MOE_D) + (size_t)e * D * DFE, D, DFE, D, 0}, base, tile, c.tid);
    }
}

__device__ __forceinline__ void final_row(const Ctx& c, const float4 (&gv)[4], int rr, const bf16_t* y0, const bf16_t* y1, float w0, float w1, int lane) {
    float* hrow = c.out() + (size_t)rr * D;
    float v[16];
    float ss = 0.f;
#pragma unroll
    for (int i = 0; i < 4; ++i) {
        const float4 t = *(const float4*)(hrow + i * 256 + lane * 4);
        const uint2 a = *(const uint2*)(y0 + i * 256 + lane * 4), bq = *(const uint2*)(y1 + i * 256 + lane * 4);
        v[4 * i] = t.x + w0 * bflo(a.x) + w1 * bflo(bq.x); v[4 * i + 1] = t.y + w0 * bfhi(a.x) + w1 * bfhi(bq.x);
        v[4 * i + 2] = t.z + w0 * bflo(a.y) + w1 * bflo(bq.y); v[4 * i + 3] = t.w + w0 * bfhi(a.y) + w1 * bfhi(bq.y);
    }
#pragma unroll
    for (int k = 0; k < 16; ++k) ss += v[k] * v[k];
    ss = wave_sum(ss);
    const float rstd = rsqrtf(ss * (1.f / D) + RMS_EPS);
#pragma unroll
    for (int i = 0; i < 4; ++i) {
        const float4 g = gv[i];
        float4 o; o.x = v[4 * i] * rstd * g.x; o.y = v[4 * i + 1] * rstd * g.y; o.z = v[4 * i + 2] * rstd * g.z; o.w = v[4 * i + 3] * rstd * g.w;
        *(float4*)(hrow + i * 256 + lane * 4) = o;
    }
}
__device__ __forceinline__ void phase_final(const Ctx& c, int part) {
    MoeMap m; moe_map(c, m);
    const int lane = c.lane;
    float4 gv[4]; gain_load(c.g_final(), gv, lane);
    constexpr int SLOT_LIM = (MOE_NCH - 1) * MOE_CH;
    int nlast = (m.ebase[8] - SLOT_LIM) / 256; nlast = nlast < 0 ? 0 : (nlast > MOE_CH / 256 ? MOE_CH / 256 : nlast);
    int nbusy = nlast * (D / 256);
    if (nbusy > (int)gridDim.x - 64) nbusy = (int)gridDim.x - 64;
    int wgi = blockIdx.x, nwg = gridDim.x;
    if (part == 0) { wgi = (int)blockIdx.x - nbusy; nwg = (int)gridDim.x - nbusy; if (wgi < 0) return; }
    const int rfirst = wgi * 8 + c.wave, rstep = nwg * 8;
    int mp0 = 0, mp1 = 0;
    { const int rl = rfirst + lane * rstep; if (rl < R) { mp0 = c.PAIR()[(size_t)rl * 2]; mp1 = c.PAIR()[(size_t)rl * 2 + 1]; } }
    int ri = 0;
    for (int rr = rfirst; rr < R; rr += rstep, ++ri) {
        const int p0 = __shfl(mp0, ri), p1 = __shfl(mp1, ri);
        int b0 = 0, b1 = 0;
#pragma unroll
        for (int k = 0; k < 8; ++k) { if (k == (p0 >> 20)) b0 = m.ebase[k]; if (k == (p1 >> 20)) b1 = m.ebase[k]; }
        const int s0 = b0 + (p0 & 0xFFFFF), s1 = b1 + (p1 & 0xFFFFF);
        const bool early = s0 < SLOT_LIM && s1 < SLOT_LIM;
        if (early != (part == 0)) continue;
        const float w0 = c.TOPW()[(size_t)rr * 2], w1 = c.TOPW()[(size_t)rr * 2 + 1];
        final_row(c, gv, rr, c.Y() + (size_t)s0 * D, c.Y() + (size_t)s1 * D, w0, w1, lane);
    }
}

constexpr int LDS_BYTES = 147456;
__global__ void __launch_bounds__(NTHR, 2) fwd(Args args) {
    extern __shared__ __attribute__((aligned(16))) unsigned char lds[];
    if (threadIdx.x < 4) ((unsigned*)(lds + 131072))[threadIdx.x] = 0u;
    __syncthreads();
    XcdBarrier bar = xcd_barrier_post((unsigned*)(args.ws + WS_BAR), (volatile LAS unsigned*)(lds + 131072));
#if defined(PROBE_G1)
    unsigned long long pr_t = __builtin_amdgcn_s_memrealtime(), pr_a1 = 0, pr_a2 = 0; int pr_k = 0;
#define SEAM_N(nk) do { xcd_barrier(bar); if (blockIdx.x == 0) { const unsigned long long t_ = __builtin_amdgcn_s_memrealtime(); \
        if ((PROBE_G1 >> pr_k) & 1u) pr_a1 += t_ - pr_t; if ((PROBE_G2 >> pr_k) & 1u) pr_a2 += t_ - pr_t; pr_t = t_; } pr_k = (nk); } while (0)
#define SEAM() SEAM_N(pr_k + 1)
#define MIDSEAM(k2) SEAM_N(k2)
#else
#define MIDSEAM(k2)
#define SEAM() xcd_barrier(bar)
#define SEAM_N(nk) xcd_barrier(bar)
#endif
#ifndef PHMASK
#define PHMASK 0xFFFFFFFFu
#endif
#define PH(k) (((PHMASK & args.phmask) >> (k)) & 1u)
#define MKCTX() Ctx c; c.a = &args; c.smem = (float*)lds; { int t_ = threadIdx.x; asm volatile("" : "+v"(t_)); c.tid = t_; c.lane = t_ & 63; c.wave = __builtin_amdgcn_readfirstlane(t_ >> 6); }
    LAS unsigned char* L = (LAS unsigned char*)lds;
    if (PH(0)) { MKCTX(); phase_cvt_dense(c); }
    if (PH(0)) { MKCTX(); phase_norm(c, 0, 0); }
    SEAM();
    if (PH(1)) { MKCTX(); side_cumsum(c); }
    if (PH(1)) { MKCTX(); meta_proj(c, 0); }
    if (PH(1)) { MKCTX(); phase_proj_main(c, 0, L); }
    SEAM();
    if (PH(2)) { MKCTX(); phase_attn_main(c, 0, L); }
    if (PH(2)) { MKCTX(); phase_attn(c, 0); }
    SEAM();
    if (PH(3)) { MKCTX(); phase_lru_carry(c); }
    SEAM();
    if (PH(4)) { MKCTX(); phase_lru(c, 0, 1); }
    SEAM();
    if (PH(5)) { MKCTX(); meta_merge(c, 0); }
    if (PH(5)) { MKCTX(); phase_merge_main(c, 0, L); }
    SEAM();
    if (PH(6)) { MKCTX(); meta_resid(c, c.meta(), c.PROJ() + C_MRG, PC, (const bf16_t*)(args.ws + WS_WB + WB_OUT), D); }
    if (PH(6)) { MKCTX(); phase_resid_main(c, c.x(), (unsigned)(WS_PROJ + C_MRG * 2), PC * 2, (unsigned)(WS_WB + WB_OUT), D, L); }
    SEAM();
    if (PH(7)) { MKCTX(); phase_norm(c, 0, 1); }
    SEAM();
    if (PH(8)) { MKCTX(); meta_ffn_up(c); }
    if (PH(8)) { MKCTX(); phase_ffn_up_main(c, L); }
    SEAM();
    if (PH(9)) { MKCTX(); meta_resid(c, c.hmeta(), c.PROJ(), DFF, (const bf16_t*)(args.ws + WS_WD), DFF); }
    if (PH(9)) { MKCTX(); phase_resid_main(c, c.out(), (unsigned)WS_PROJ, DFF * 2, (unsigned)WS_WD, DFF, L); }
    SEAM();
    if (PH(10)) { MKCTX(); phase_norm(c, 1, 0); }
    SEAM();
    if (PH(11)) { MKCTX(); side_cumsum(c); }
    if (PH(11)) { MKCTX(); meta_proj(c, 1); }
    if (PH(11)) { MKCTX(); phase_proj_main(c, 1, L); }
    SEAM();
    if (PH(12)) { MKCTX(); phase_attn_main(c, 1, L); }
    if (PH(12)) { MKCTX(); phase_attn(c, 1); }
    SEAM();
    if (PH(13)) { MKCTX(); phase_lru_carry(c); }
    SEAM();
    if (PH(14)) { MKCTX(); phase_lru(c, 1, 1); }
    SEAM();
    if (PH(15)) { MKCTX(); phase_merge_main(c, 1, L); }
    SEAM();
    if (PH(16)) { MKCTX(); phase_resid_main(c, c.out(), (unsigned)(WS_PROJ + C_MRG * 2), PC * 2, (unsigned)(WS_WB + WB_LAYER + WB_OUT), D, L); }
    SEAM();
    if (PH(17)) { MKCTX(); phase_cvt_moe(c); }
    if (PH(17)) { MKCTX(); phase_norm(c, 1, 1); }
    SEAM();
#pragma unroll 1
    for (int ch = 0; ch < MOE_NCH; ++ch) {
        if (PH(18)) { MKCTX(); phase_moe_up(c, ch, L); }
        SEAM_N(19);
        if (PH(19)) { MKCTX(); phase_moe_down(c, ch, L); }
        if (ch < MOE_NCH - 1) SEAM_N(18);
    }
    if (PH(20)) { MKCTX(); phase_final(c, 0); }
    SEAM_N(20);
    if (PH(20)) { MKCTX(); phase_final(c, 1); }
#if defined(PROBE_G1)
    if (blockIdx.x == 0) {
        __syncthreads();
        if (threadIdx.x == 0) {
            const unsigned long long t_ = __builtin_amdgcn_s_memrealtime();
            if ((PROBE_G1 >> 20) & 1u) pr_a1 += t_ - pr_t; if ((PROBE_G2 >> 20) & 1u) pr_a2 += t_ - pr_t;
            const unsigned long long wait = 16ull * pr_a1 + 0ull * pr_a2;
            while (__builtin_amdgcn_s_memrealtime() - t_ < wait) __builtin_amdgcn_s_sleep(32);
        }
    }
#endif
}

extern "C" void kernel_launch(void* const* d_in, const int* in_sizes, int n_in, void* d_out, int out_size, void* d_ws, size_t ws_size, hipStream_t stream) {
    static int grid = 0;
    if (grid == 0) {
        if (n_in != 26 || out_size != R * D || ws_size < WS_END) { fprintf(stderr, "kernel_launch: unexpected problem (n_in %d out %d ws %zu)\n", n_in, out_size, ws_size); grid = -1; return; }
        int dev = 0, cus = 0, per_cu = 0;
        if (hipGetDevice(&dev) != hipSuccess || hipDeviceGetAttribute(&cus, hipDeviceAttributeMultiprocessorCount, dev) != hipSuccess) { grid = -1; return; }
        if (hipFuncSetAttribute((const void*)fwd, hipFuncAttributeMaxDynamicSharedMemorySize, LDS_BYTES) != hipSuccess) { grid = -1; return; }
        if (hipOccupancyMaxActiveBlocksPerMultiprocessor(&per_cu, (const void*)fwd, NTHR, LDS_BYTES) != hipSuccess || per_cu < 1) { fprintf(stderr, "occupancy query: %d\n", per_cu); }
        (void)hipGetLastError();
        grid = cus;
    }
    if (grid < 0) return;
    (void)hipMemsetAsync(d_ws, 0, WS_ZERO_BYTES, stream);
    Args a{};
    for (int i = 0; i < 26; ++i) a.in[i] = (const float*)d_in[i];
    a.out = (float*)d_out; a.ws = (unsigned char*)d_ws; a.phmask = 0xFFFFFFFFu; a.pad = 0u;
    hipLaunchKernelGGL(fwd, dim3(grid), dim3(NTHR), LDS_BYTES, stream, a);
}
```
